# Optimizing an MI355X kernel written in HIP

```python
import math
import jax, jax.numpy as jnp
from jax import lax
import numpy as np

D_MODEL = 2048
BATCH = 2
SEQ = 4096
DEPTH = 2

GRID_W = 64
CTX_LEN = 256
N_MIXERS = 2
N_MLA_LAYERS = (DEPTH + N_MIXERS - 1) // N_MIXERS
N_HYENA_LAYERS = DEPTH // N_MIXERS
NORM_EPS = 1e-6
MLA_HEADS = 16
MLA_Q_RANK = 512
MLA_KV_RANK = 256
MLA_NOPE_DIM = 128
MLA_ROPE_DIM = 64
MLA_V_DIM = 128
MLA_IN_DIM = MLA_Q_RANK + MLA_KV_RANK + MLA_ROPE_DIM
ROPE_THETA = 10000.0
Q_BLOCK = 128
HYENA_ORDER = 2
HYENA_SHORT = 3
HYENA_BANDS = 16
HYENA_EMB = 1 + 2 * HYENA_BANDS
HYENA_FILTER_WIDTH = 64
HYENA_TARGET = 1e-2
HYENA_FAST_PCT = 0.3
HYENA_SLOW_PCT = 1.5
N_EXPERTS = 16
EC_CAPACITY_FACTOR = 2
EXPERT_FF = 1024

kernel_name = 'hybrid_mla_hyena_ec_moe_diffusion'

F32 = jnp.float32


def rmsnorm(x, g):
    x32 = x.astype(F32)
    y = x32 * lax.rsqrt(jnp.mean(x32 * x32, axis=-1, keepdims=True) + NORM_EPS)
    return (y * g.astype(F32)).astype(x.dtype)


def ada_modulation(cvec, w, b):
    m = jax.nn.silu(cvec) @ w + b
    return m.reshape(cvec.shape[0], 6, D_MODEL)


def modulate(h, shift, scale):
    return h * (1 + scale[:, None, :]) + shift[:, None, :]


def axial_rope_tables(rows):
    row = jnp.broadcast_to(jnp.arange(rows)[:, None], (rows, GRID_W)).reshape(-1).astype(F32)
    col = jnp.broadcast_to(jnp.arange(GRID_W)[None, :], (rows, GRID_W)).reshape(-1).astype(F32)
    n_freq = MLA_ROPE_DIM // 4
    inv = ROPE_THETA ** (-jnp.arange(n_freq, dtype=F32) / n_freq)
    ang = jnp.concatenate([row[:, None] * inv, col[:, None] * inv], axis=-1)
    return jnp.cos(ang), jnp.sin(ang)


def apply_rope(x, cos, sin):
    half = MLA_ROPE_DIM // 2
    x32 = x.astype(F32)
    x1, x2 = x32[..., :half], x32[..., half:]
    out = jnp.concatenate([x1 * cos - x2 * sin, x2 * cos + x1 * sin], axis=-1)
    return out.astype(x.dtype)


def mla_latents(h, w_in, g_q, g_kv, w_uq, w_ukv, with_queries):
    B, L, _ = h.shape
    if with_queries:
        proj = h @ w_in
        cq, rest = proj[..., :MLA_Q_RANK], proj[..., MLA_Q_RANK:]
    else:
        rest = h @ w_in[:, MLA_Q_RANK:]
    ckv, k_rope = rest[..., :MLA_KV_RANK], rest[..., MLA_KV_RANK:]
    kv = (rmsnorm(ckv, g_kv) @ w_ukv).reshape(B, L, MLA_HEADS, MLA_NOPE_DIM + MLA_V_DIM)
    k_nope, v = kv[..., :MLA_NOPE_DIM], kv[..., MLA_NOPE_DIM:]
    if with_queries:
        q = (rmsnorm(cq, g_q) @ w_uq).reshape(B, L, MLA_HEADS, MLA_NOPE_DIM + MLA_ROPE_DIM)
        return k_nope, k_rope, v, q[..., :MLA_NOPE_DIM], q[..., MLA_NOPE_DIM:]
    return k_nope, k_rope, v


def block_attention(q_nope, q_rope, k_nope, k_rope, v):
    B, L = q_nope.shape[:2]
    nb = L // Q_BLOCK
    scale = (MLA_NOPE_DIM + MLA_ROPE_DIM) ** -0.5

    def split(t):
        return jnp.moveaxis(t.reshape((B, nb, Q_BLOCK) + t.shape[2:]), 1, 0)

    def one_block(args):
        qn, qr = args
        s = jnp.einsum('bqhd,bkhd->bhqk', qn, k_nope) + jnp.einsum('bqhr,bkr->bhqk', qr, k_rope)
        p = jax.nn.softmax(s.astype(F32) * scale, axis=-1).astype(v.dtype)
        return jnp.einsum('bhqk,bkhd->bqhd', p, v)

    o = lax.map(one_block, (split(q_nope), split(q_rope)))
    return jnp.moveaxis(o, 0, 1).reshape(B, L, MLA_HEADS * MLA_V_DIM)


def mla_mixer(h, h_c, rows, ctx_out, w_in, g_q, g_kv, w_uq, w_ukv, w_o):
    cos, sin = axial_rope_tables(rows)
    kn, kr, v, qn, qr = mla_latents(h, w_in, g_q, g_kv, w_uq, w_ukv, True)
    qr = apply_rope(qr, cos[:, None, :], sin[:, None, :])
    kr = apply_rope(kr, cos, sin)
    ctx_side = mla_latents(h_c, w_in, g_q, g_kv, w_uq, w_ukv, ctx_out)
    kn_c, kr_c, v_c = ctx_side[0], ctx_side[1], ctx_side[2]
    o = block_attention(qn, qr,
                        jnp.concatenate([kn, kn_c], axis=1),
                        jnp.concatenate([kr, kr_c], axis=1),
                        jnp.concatenate([v, v_c], axis=1))
    y = o @ w_o
    y_c = None
    if ctx_out:
        y_c = block_attention(ctx_side[3], ctx_side[4], kn_c, kr_c, v_c) @ w_o
    return y, y_c


def hyena_filters(L, w1, b1, w2, b2, w3, b3, freq):
    t = jnp.arange(L, dtype=F32) / L
    w = 2 * math.pi * jnp.arange(L, dtype=F32) / L
    bands = jnp.linspace(1e-4, HYENA_BANDS - 1, HYENA_BANDS, dtype=F32)
    ang = w[:, None] * bands[None, :]
    z = jnp.concatenate([t[:, None], jnp.cos(ang), -jnp.sin(ang)], axis=-1)
    fr = freq.astype(F32)
    a = jnp.sin(fr * (z @ w1.astype(F32) + b1.astype(F32)))
    a = jnp.sin(fr * (a @ w2.astype(F32) + b2.astype(F32)))
    hf = (a @ w3.astype(F32) + b3.astype(F32)).reshape(L, HYENA_ORDER, 2, D_MODEL)
    max_decay = math.log(HYENA_TARGET) / HYENA_FAST_PCT
    min_decay = math.log(HYENA_TARGET) / HYENA_SLOW_PCT
    deltas = jnp.linspace(min_decay, max_decay, D_MODEL, dtype=F32)
    hf = hf * jnp.exp(-t[:, None] * jnp.abs(deltas))[:, None, None, :]
    fwd = hf[:, :, 0]
    bwd = hf[1:, :, 1][::-1]
    k2 = jnp.concatenate([fwd, jnp.zeros((1, HYENA_ORDER, D_MODEL), F32), bwd], axis=0)
    k2 = k2 * lax.rsqrt(jnp.sum(k2 * k2, axis=0, keepdims=True) + NORM_EPS)
    return jnp.fft.rfft(k2, axis=0)


def short_conv(u, w, b):
    L = u.shape[1]
    up = jnp.pad(u, ((0, 0), (1, 1), (0, 0)))
    return up[:, :L] * w[0] + up[:, 1:L + 1] * w[1] + up[:, 2:] * w[2] + b


def long_conv(z, kf, skip):
    L = z.shape[1]
    z32 = z.astype(F32)
    zf = jnp.fft.rfft(z32, n=2 * L, axis=1)
    y = jnp.fft.irfft(zf * kf[None], n=2 * L, axis=1)[:, :L]
    return (y + skip.astype(F32) * z32).astype(z.dtype)


def hyena_mixer(h, w_in, conv_w, conv_b, f_w1, f_b1, f_w2, f_b2, f_w3, f_b3, f_freq, skip, w_out):
    L = h.shape[1]
    u = short_conv(h @ w_in, conv_w, conv_b)
    v, x1, x2 = u[..., :D_MODEL], u[..., D_MODEL:2 * D_MODEL], u[..., 2 * D_MODEL:]
    kf = hyena_filters(L, f_w1, f_b1, f_w2, f_b2, f_w3, f_b3, f_freq)
    z = x1 * long_conv(v, kf[:, 0], skip[0])
    z = x2 * long_conv(z, kf[:, 1], skip[1])
    return z @ w_out


def expert_choice_ffn(h, w_router, w_gate, w_up, w_down):
    B, T, D = h.shape
    cap = EC_CAPACITY_FACTOR * T // N_EXPERTS
    aff = jax.nn.softmax((h @ w_router).astype(F32), axis=-1)
    g, idx = lax.top_k(jnp.swapaxes(aff, 1, 2), cap)
    xg = jax.vmap(lambda hb, ib: hb[ib])(h, idx)
    a = jnp.einsum('becd,edf->becf', xg, w_gate)
    u = jnp.einsum('becd,edf->becf', xg, w_up)
    y = jnp.einsum('becf,efd->becd', jax.nn.silu(a) * u, w_down) * g[..., None].astype(h.dtype)
    return jax.vmap(lambda ib, yb: jnp.zeros((T, D), h.dtype).at[ib.reshape(-1)].add(yb.reshape(-1, D)))(idx, y)


def setup_inputs(seed: int = 0) -> dict:
    key = jax.random.key(seed)
    ks = jax.random.split(key, 32)
    D, E, F = D_MODEL, N_EXPERTS, EXPERT_FF
    nm, nh = N_MLA_LAYERS, N_HYENA_LAYERS

    def nrm(k, shape, scale):
        return jax.random.normal(k, shape, F32) * scale

    return {
        'x': nrm(ks[0], (BATCH, SEQ, D), 1.0),
        'c': nrm(ks[1], (BATCH, D), 1.0),
        'ctx': nrm(ks[2], (BATCH, CTX_LEN, D), 1.0),
        'c_ctx': nrm(ks[3], (D,), 1.0),
        'ada_w': nrm(ks[4], (DEPTH, D, 6 * D), 0.5 * D ** -0.5),
        'ada_b': nrm(ks[5], (DEPTH, 6 * D), 0.01),
        'norm_g': 1.0 + nrm(ks[6], (DEPTH, 2, D), 0.01),
        'final_g': 1.0 + nrm(ks[7], (D,), 0.01),
        'mla_w_in': nrm(ks[8], (nm, D, MLA_IN_DIM), D ** -0.5),
        'mla_g_q': 1.0 + nrm(ks[9], (nm, MLA_Q_RANK), 0.01),
        'mla_g_kv': 1.0 + nrm(ks[10], (nm, MLA_KV_RANK), 0.01),
        'mla_w_uq': nrm(ks[11], (nm, MLA_Q_RANK, MLA_HEADS * (MLA_NOPE_DIM + MLA_ROPE_DIM)), MLA_Q_RANK ** -0.5),
        'mla_w_ukv': nrm(ks[12], (nm, MLA_KV_RANK, MLA_HEADS * (MLA_NOPE_DIM + MLA_V_DIM)), MLA_KV_RANK ** -0.5),
        'mla_w_o': nrm(ks[13], (nm, MLA_HEADS * MLA_V_DIM, D), (MLA_HEADS * MLA_V_DIM) ** -0.5),
        'hy_w_in': nrm(ks[14], (nh, D, 3 * D), D ** -0.5),
        'hy_conv_w': nrm(ks[15], (nh, HYENA_SHORT, 3 * D), 0.6),
        'hy_conv_b': nrm(ks[16], (nh, 3 * D), 0.01),
        'hy_f_w1': nrm(ks[17], (nh, HYENA_EMB, HYENA_FILTER_WIDTH), HYENA_EMB ** -0.5),
        'hy_f_b1': nrm(ks[18], (nh, HYENA_FILTER_WIDTH), 0.1),
        'hy_f_w2': nrm(ks[19], (nh, HYENA_FILTER_WIDTH, HYENA_FILTER_WIDTH), HYENA_FILTER_WIDTH ** -0.5),
        'hy_f_b2': nrm(ks[20], (nh, HYENA_FILTER_WIDTH), 0.1),
        'hy_f_w3': nrm(ks[21], (nh, HYENA_FILTER_WIDTH, HYENA_ORDER * 2 * D), HYENA_FILTER_WIDTH ** -0.5),
        'hy_f_b3': nrm(ks[22], (nh, HYENA_ORDER * 2 * D), 0.01),
        'hy_f_freq': 1.0 + nrm(ks[23], (nh, HYENA_FILTER_WIDTH), 0.1),
        'hy_skip': nrm(ks[24], (nh, HYENA_ORDER, D), 0.5),
        'hy_w_out': nrm(ks[25], (nh, D, D), D ** -0.5),
        'moe_w_router': nrm(ks[26], (DEPTH, D, E), D ** -0.5),
        'moe_w_gate': nrm(ks[27], (DEPTH, E, D, F), D ** -0.5),
        'moe_w_up': nrm(ks[28], (DEPTH, E, D, F), D ** -0.5),
        'moe_w_down': nrm(ks[29], (DEPTH, E, F, D), F ** -0.5),
    }


def reference(x, c, ctx, c_ctx, ada_w, ada_b, norm_g, final_g,
              mla_w_in, mla_g_q, mla_g_kv, mla_w_uq, mla_w_ukv, mla_w_o,
              hy_w_in, hy_conv_w, hy_conv_b, hy_f_w1, hy_f_b1, hy_f_w2, hy_f_b2,
              hy_f_w3, hy_f_b3, hy_f_freq, hy_skip, hy_w_out,
              moe_w_router, moe_w_gate, moe_w_up, moe_w_down):
    ROWS = x.shape[1] // GRID_W
    for i in range(DEPTH):
        kind = i % N_MIXERS
        m = i // N_MIXERS
        ctx_out = any(j % N_MIXERS == 0 for j in range(i + 1, DEPTH))
        ctx_in = ctx_out or kind == 0
        mod = ada_modulation(c, ada_w[i], ada_b[i])
        h = modulate(rmsnorm(x, norm_g[i, 0]), mod[:, 0], mod[:, 1])
        h_c, mod_c = None, None
        if ctx_in:
            mod_c = ada_modulation(c_ctx[None], ada_w[i], ada_b[i])
            h_c = modulate(rmsnorm(ctx, norm_g[i, 0]), mod_c[:, 0], mod_c[:, 1])
        if kind == 0:
            y, y_c = mla_mixer(h, h_c, ROWS, ctx_out, mla_w_in[m], mla_g_q[m], mla_g_kv[m],
                               mla_w_uq[m], mla_w_ukv[m], mla_w_o[m])
        else:
            hp = (hy_w_in[m], hy_conv_w[m], hy_conv_b[m], hy_f_w1[m], hy_f_b1[m], hy_f_w2[m],
                  hy_f_b2[m], hy_f_w3[m], hy_f_b3[m], hy_f_freq[m], hy_skip[m], hy_w_out[m])
            y = hyena_mixer(h, *hp)
            y_c = hyena_mixer(h_c, *hp) if ctx_out else None
        x = x + mod[:, 2][:, None, :] * y
        hm = modulate(rmsnorm(x, norm_g[i, 1]), mod[:, 3], mod[:, 4])
        x = x + mod[:, 5][:, None, :] * expert_choice_ffn(hm, moe_w_router[i], moe_w_gate[i],
                                                          moe_w_up[i], moe_w_down[i])
        if ctx_out:
            ctx = ctx + mod_c[:, 2][:, None, :] * y_c
            hmc = modulate(rmsnorm(ctx, norm_g[i, 1]), mod_c[:, 3], mod_c[:, 4])
            ctx = ctx + mod_c[:, 5][:, None, :] * expert_choice_ffn(hmc, moe_w_router[i], moe_w_gate[i],
                                                                    moe_w_up[i], moe_w_down[i])
    return rmsnorm(x, final_g)
```

```cpp
#include <hip/hip_runtime.h>
#include <cstdio>
#include <cstdint>
namespace pg8 {
#define PG8_LAS __attribute__((address_space(3)))
typedef unsigned short bf16_t;
typedef short bf16x8 __attribute__((ext_vector_type(8)));
typedef float f32x4 __attribute__((ext_vector_type(4)));
typedef unsigned u32x4 __attribute__((ext_vector_type(4)));
constexpr int BM = 256, BK = 64, HALF = 128, HTB = HALF * BK * 2  , STAGE_BYTES = 8 * HTB, NXCD = 8, WGM = 8;

__host__ __device__ __forceinline__ int lds_byte(int r, int c) { const int st = (r >> 4) * 2 + (c >> 5), rr = r & 15, cc = c & 31, ob = rr * 64 + cc * 2; return st * 1024 + (ob ^ (((ob >> 9) & 1) << 5)); }
__host__ __device__ __forceinline__ void stage_rc(int b, int& R, int& C) { const int st = b / 1024, sb = b % 1024, swz = sb ^ (((sb >> 9) & 1) << 5); R = (st >> 1) * 16 + swz / 64; C = (st & 1) * 32 + (swz % 64) / 2; }
__host__ __device__ __forceinline__ int perm32(int rho) { const int n = rho >> 4, i = rho & 15; return 8 * (i >> 2) + 4 * n + (i & 3); }

struct Unit { int pm, pn; };
struct Gemm { const bf16_t* A; const bf16_t* Bt; int M, N, K; };

struct StaticOrder {
    int nM, nN, nwg, G, c;
    __host__ __device__ void init(int M, int N, int G_, int c_) { nM = M / BM; nN = N / BM; nwg = nM * nN; G = G_; c = c_; }
    __host__ __device__ bool next(int i, Unit& u) const {
        const long L = (long)i * G + c; if (L >= nwg) return false;
        int wgid = (int)L; { const int q = nwg / NXCD, r = nwg % NXCD, xcd = wgid % NXCD, off = wgid / NXCD; wgid = (xcd < r ? xcd * (q + 1) : r * (q + 1) + (xcd - r) * q) + off; }
        const int nig = WGM * nN, gid = wgid / nig, fm = gid * WGM, gsz = (nM - fm) < WGM ? (nM - fm) : WGM;
        u.pm = fm + ((wgid % nig) % gsz); u.pn = (wgid % nig) / gsz; return true;
    }
    __device__ __forceinline__ void a_ready(const Unit&) const {}
    __device__ __forceinline__ void done(const Unit&) const {}
};

__device__ __forceinline__ unsigned cvt_pk_bf16(float lo, float hi) { unsigned r; asm volatile("v_cvt_pk_bf16_f32 %0, %1, %2" : "=v"(r) : "v"(lo), "v"(hi)); return r; }
typedef float f32x2 __attribute__((ext_vector_type(2)));
struct EpiF32Plain {
    static constexpr bool PERM = false, AFTER_DRAIN = false;
    float* C; int ldc;
    __device__ __forceinline__ void operator()(const f32x4 (&acc)[2][2][4][2], const Unit& u, int wr, int wc, int fr, int fq) const {
        const int row0 = u.pm * BM + wr * 64 + fr, col0 = u.pn * BM + wc * 32 + 4 * fq;
#pragma unroll
        for (int ai = 0; ai < 2; ++ai)
#pragma unroll
            for (int m = 0; m < 4; ++m) { float* rowp = C + (size_t)(row0 + ai * HALF + m * 16) * ldc + col0;
#pragma unroll
                for (int bj = 0; bj < 2; ++bj)
#pragma unroll
                    for (int n = 0; n < 2; ++n) *(f32x4*)(rowp + bj * HALF + n * 16) = acc[ai][bj][m][n]; }
    }
};
struct EpiBf16Plain {
    static constexpr bool PERM = true, AFTER_DRAIN = false;
    bf16_t* O; int ldc; int pn_mask;
    __device__ __forceinline__ void operator()(const f32x4 (&acc)[2][2][4][2], const Unit& u, int wr, int wc, int fr, int fq) const {
        const int row0 = u.pm * BM + wr * 64 + fr, col0 = (u.pn & pn_mask) * BM + wc * 32 + 8 * fq;
#pragma unroll
        for (int ai = 0; ai < 2; ++ai)
#pragma unroll
            for (int m = 0; m < 4; ++m) { bf16_t* rowp = O + (size_t)(row0 + ai * HALF + m * 16) * ldc + col0;
#pragma unroll
                for (int bj = 0; bj < 2; ++bj) { const f32x4 v0 = acc[ai][bj][m][0], v1 = acc[ai][bj][m][1];
                    u32x4 w; w.x = cvt_pk_bf16(v0[0], v0[1]); w.y = cvt_pk_bf16(v0[2], v0[3]); w.z = cvt_pk_bf16(v1[0], v1[1]); w.w = cvt_pk_bf16(v1[2], v1[3]);
                    *(u32x4*)(rowp + bj * HALF) = w; } }
    }
};
struct EpiQRope {
    static constexpr bool PERM = true, AFTER_DRAIN = false;
    bf16_t* O; const float* cs;
    __device__ __forceinline__ void operator()(const f32x4 (&acc)[2][2][4][2], const Unit& u, int wr, int wc, int fr, int fq) const {
        const int row0 = u.pm * BM + wr * 64 + fr;
#pragma unroll
        for (int ai = 0; ai < 2; ++ai)
#pragma unroll
            for (int m = 0; m < 4; ++m) { const int row = row0 + ai * HALF + m * 16; const int bb = row >= 4352 ? 1 : 0; const int l = row - bb * 4352; const bool lat = l < 4096; const int lp = lat ? l : 0;
#pragma unroll
                for (int bj = 0; bj < 2; ++bj) { const int c0 = u.pn * BM + bj * HALF + wc * 32 + 8 * fq; const int hh = c0 / 192, jj = c0 - hh * 192;
                    f32x4 v0 = acc[ai][bj][m][0], v1 = acc[ai][bj][m][1];
                    if (jj >= 128 && lat) { const f32x4* cp = (const f32x4*)(cs + ((size_t)lp * 32 + ((jj - 128) >> 1)) * 2); const f32x4 ca = cp[0], cb = cp[1];
                        const f32x4 a = v0, b = v1;
                        v0[0] = a[0] * ca[0] - a[1] * ca[1]; v0[1] = a[1] * ca[0] + a[0] * ca[1]; v0[2] = a[2] * ca[2] - a[3] * ca[3]; v0[3] = a[3] * ca[2] + a[2] * ca[3];
                        v1[0] = b[0] * cb[0] - b[1] * cb[1]; v1[1] = b[1] * cb[0] + b[0] * cb[1]; v1[2] = b[2] * cb[2] - b[3] * cb[3]; v1[3] = b[3] * cb[2] + b[2] * cb[3]; }
                    u32x4 w; w.x = cvt_pk_bf16(v0[0], v0[1]); w.y = cvt_pk_bf16(v0[2], v0[3]); w.z = cvt_pk_bf16(v1[0], v1[1]); w.w = cvt_pk_bf16(v1[2], v1[3]);
                    *(u32x4*)(O + (size_t)row * 3072 + c0) = w; } }
    }
};
struct EpiResid {
    static constexpr bool PERM = false, AFTER_DRAIN = false;
    const float* base; float* out; const float* gate; int gstride;
    __device__ __forceinline__ void operator()(const f32x4 (&acc)[2][2][4][2], const Unit& u, int wr, int wc, int fr, int fq) const {
        const int row0 = u.pm * BM + wr * 64 + fr, col0 = u.pn * BM + wc * 32 + 4 * fq; const float* gp = gate + (size_t)(u.pm >> 4) * gstride + col0;
        f32x4 gv[2][2];
#pragma unroll
        for (int bj = 0; bj < 2; ++bj)
#pragma unroll
            for (int n = 0; n < 2; ++n) gv[bj][n] = *(const f32x4*)(gp + bj * HALF + n * 16);
#pragma unroll
        for (int ai = 0; ai < 2; ++ai)
#pragma unroll
            for (int m = 0; m < 4; ++m) { const size_t off = (size_t)(row0 + ai * HALF + m * 16) * 2048 + col0;
#pragma unroll
                for (int bj = 0; bj < 2; ++bj)
#pragma unroll
                    for (int n = 0; n < 2; ++n) { const f32x4 bs = *(const f32x4*)(base + off + bj * HALF + n * 16); *(f32x4*)(out + off + bj * HALF + n * 16) = bs + gv[bj][n] * acc[ai][bj][m][n]; }
                asm volatile("" ::: "memory"); }
    }
};
struct EpiSwiGLU {
    static constexpr bool PERM = true, AFTER_DRAIN = false;
    bf16_t* O;
    __device__ __forceinline__ float silu(float g) const { return g * __builtin_amdgcn_rcpf(1.0f + __builtin_amdgcn_exp2f(-1.4426950408889634f * g)); }
    __device__ __forceinline__ void operator()(const f32x4 (&acc)[2][2][4][2], const Unit& u, int wr, int wc, int fr, int fq) const {
        const int row0 = u.pm * BM + wr * 64 + fr, col0 = (u.pn & 7) * 128 + wc * 32 + 8 * fq;
#pragma unroll
        for (int ai = 0; ai < 2; ++ai)
#pragma unroll
            for (int m = 0; m < 4; ++m) { const f32x4 g0 = acc[ai][0][m][0], g1 = acc[ai][0][m][1], u0 = acc[ai][1][m][0], u1 = acc[ai][1][m][1];
                u32x4 w; w.x = cvt_pk_bf16(silu(g0[0]) * u0[0], silu(g0[1]) * u0[1]); w.y = cvt_pk_bf16(silu(g0[2]) * u0[2], silu(g0[3]) * u0[3]);
                w.z = cvt_pk_bf16(silu(g1[0]) * u1[0], silu(g1[1]) * u1[1]); w.w = cvt_pk_bf16(silu(g1[2]) * u1[2], silu(g1[3]) * u1[3]);
                *(u32x4*)(O + (size_t)(row0 + ai * HALF + m * 16) * 1024 + col0) = w; }
    }
};
struct MoeOrder {
    int G, c;
    __device__ __forceinline__ bool next(int i, Unit& u) const {
        int e, j;
        if (G == 256) { if (i >= 2) return false; e = i * 8 + (c & 7); j = c >> 3; }
        else { const int L = i * G + c; if (L >= 512) return false; e = L >> 5; j = L & 31; }
        u.pm = e * 4 + (j & 3); u.pn = e * 8 + (j >> 2); return true;
    }
    __device__ __forceinline__ void a_ready(const Unit&) const {}
    __device__ __forceinline__ void done(const Unit&) const {}
};

template <class Epi, class Sched, bool ALIGN_EPI = false, bool SP2 = false>
__device__ __forceinline__ void gemm_phase(PG8_LAS unsigned char* lds, const Gemm g, const Sched& S, const Epi& E) {
    const int tid = threadIdx.x, wid = __builtin_amdgcn_readfirstlane(tid >> 6), lane = tid & 63, wr = wid >> 2, wc = wid & 3, fr = lane & 15, fq = lane >> 4;
    const int K = g.K, nt = K / BK;
    unsigned voffA[2], voffB[2];
#pragma unroll
    for (int i = 0; i < 2; ++i) { int R, C; stage_rc(tid * 16 + i * 8192, R, C); const int Rb = Epi::PERM ? ((R & ~31) + perm32(R & 31)) : R;
        voffA[i] = (unsigned)(R * K + C) * 2u; voffB[i] = (unsigned)(Rb * K + C) * 2u; }
    const size_t kstep = (size_t)(BK * 2);
    const size_t hstep = (size_t)HALF * K * 2;
    const size_t tstep = 2 * hstep;
    const unsigned ldsw = (unsigned)wid * 1024u;
    const int aoff = lds_byte(wr * 64 + fr, fq * 8), boff = lds_byte(wc * 32 + fr, fq * 8);
#define PG8_SA(b, h) (((b) * 2 + (h)) * HTB)
#define PG8_SB(b, h) ((4 + (b) * 2 + (h)) * HTB)
#define PG8_STAGE(bufoff, gbase, voff) do { _Pragma("unroll") for (int _i = 0; _i < 2; ++_i) \
        __builtin_amdgcn_global_load_lds((const unsigned*)((const char*)(gbase) + (voff)[_i]), (PG8_LAS unsigned*)(lds + (bufoff) + ldsw + _i * 8192), 16, 0, 0); } while (0)
#define PG8_LDA(dst, b, h) do { _Pragma("unroll") for (int m = 0; m < 4; ++m) _Pragma("unroll") for (int k = 0; k < 2; ++k) dst[m][k] = *(const PG8_LAS bf16x8*)(lds + PG8_SA(b, h) + aoff + m * 2048 + k * 1024); } while (0)
#define PG8_LDB(dst, b, h) do { _Pragma("unroll") for (int n = 0; n < 2; ++n) _Pragma("unroll") for (int k = 0; k < 2; ++k) dst[n][k] = *(const PG8_LAS bf16x8*)(lds + PG8_SB(b, h) + boff + n * 2048 + k * 1024); } while (0)
#define PG8_MMA(ai, bj, At, Bt) do { __builtin_amdgcn_s_setprio(1); _Pragma("unroll") for (int m = 0; m < 4; ++m) _Pragma("unroll") for (int n = 0; n < 2; ++n) _Pragma("unroll") for (int k = 0; k < 2; ++k) \
        acc[ai][bj][m][n] = __builtin_amdgcn_mfma_f32_16x16x32_bf16(Bt[n][k], At[m][k], acc[ai][bj][m][n], 0, 0, 0); __builtin_amdgcn_s_setprio(0); } while (0)
#define PG8_WAIT_V(n) asm volatile("s_waitcnt vmcnt(" #n ")" ::: "memory")
#define PG8_WAIT_L(n) asm volatile("s_waitcnt lgkmcnt(" #n ")" ::: "memory")
#define PG8_BAR __builtin_amdgcn_s_barrier()
#define PG8_SCHED __builtin_amdgcn_sched_barrier(0)
    Unit cur, nxt; int ui = 0;
    if (!S.next(0, cur)) return;
    f32x4 acc[2][2][4][2];
#pragma unroll
    for (int a = 0; a < 2; ++a)
#pragma unroll
        for (int b = 0; b < 2; ++b)
#pragma unroll
            for (int m = 0; m < 4; ++m)
#pragma unroll
                for (int n = 0; n < 2; ++n) acc[a][b][m][n] = (f32x4){0.f, 0.f, 0.f, 0.f};
    bf16x8 At[4][2], B0[2][2], B1[2][2];
    const char* cA = (const char*)g.A + (size_t)cur.pm * tstep; const char* cB = (const char*)g.Bt + (size_t)cur.pn * tstep;
    S.a_ready(cur);
    if constexpr (SP2) {
        PG8_STAGE(PG8_SB(0, 0), cB, voffB); PG8_STAGE(PG8_SB(0, 1), cB + hstep, voffB); PG8_STAGE(PG8_SA(0, 0), cA, voffA); PG8_STAGE(PG8_SA(0, 1), cA + hstep, voffA);
        if (wr == 1) PG8_BAR;
        PG8_WAIT_V(2); PG8_BAR;
        PG8_STAGE(PG8_SB(1, 0), cB + kstep, voffB); PG8_STAGE(PG8_SA(1, 0), cA + kstep, voffA); PG8_STAGE(PG8_SB(1, 1), cB + hstep + kstep, voffB);
        PG8_WAIT_V(6); PG8_BAR;
    } else {
        PG8_STAGE(PG8_SB(0, 0), cB, voffB); PG8_STAGE(PG8_SA(0, 0), cA, voffA); PG8_STAGE(PG8_SB(0, 1), cB + hstep, voffB); PG8_STAGE(PG8_SA(0, 1), cA + hstep, voffA);
        if (wr == 1) PG8_BAR;
        PG8_WAIT_V(4); PG8_BAR;
        PG8_STAGE(PG8_SB(1, 0), cB + kstep, voffB); PG8_STAGE(PG8_SA(1, 0), cA + kstep, voffA); PG8_STAGE(PG8_SB(1, 1), cB + hstep + kstep, voffB);
        PG8_WAIT_V(6); PG8_BAR;
    }
    for (;;) {
        const bool has_next = S.next(ui + 1, nxt);
        const char* nA = has_next ? (const char*)g.A + (size_t)nxt.pm * tstep : cA; const char* nB = has_next ? (const char*)g.Bt + (size_t)nxt.pn * tstep : cB;
        for (int t = 0; t < nt; t += 2) {
            const bool last = (t == nt - 2);
            const char* a1 = cA + (size_t)(t + 1) * kstep;
            const char* a2 = last ? nA : cA + (size_t)(t + 2) * kstep; const char* b2 = last ? nB : cB + (size_t)(t + 2) * kstep;
            const char* a3 = a2 + kstep; const char* b3 = b2 + kstep;
            if (last && has_next) S.a_ready(nxt);
            if constexpr (SP2) {
            PG8_LDB(B0, 0, 0); PG8_LDB(B1, 0, 1); PG8_SCHED; PG8_LDA(At, 0, 0); PG8_STAGE(PG8_SA(1, 1), a1 + hstep, voffA);
            PG8_WAIT_V(8); PG8_WAIT_L(0); PG8_BAR; PG8_MMA(0, 0, At, B0); PG8_MMA(0, 1, At, B1); PG8_BAR; PG8_SCHED;
            PG8_LDA(At, 0, 1); PG8_STAGE(PG8_SB(0, 0), b2, voffB); PG8_STAGE(PG8_SB(0, 1), b2 + hstep, voffB); PG8_STAGE(PG8_SA(0, 0), a2, voffA);
            PG8_WAIT_V(8); PG8_WAIT_L(0); PG8_BAR; PG8_MMA(1, 0, At, B0); PG8_MMA(1, 1, At, B1); PG8_BAR; PG8_SCHED;
            PG8_LDB(B0, 1, 0); PG8_LDB(B1, 1, 1); PG8_SCHED; PG8_LDA(At, 1, 0); PG8_STAGE(PG8_SA(0, 1), a2 + hstep, voffA);
            PG8_WAIT_V(8); PG8_WAIT_L(0); PG8_BAR; PG8_MMA(0, 0, At, B0); PG8_MMA(0, 1, At, B1); PG8_BAR; PG8_SCHED;
            PG8_LDA(At, 1, 1); PG8_STAGE(PG8_SB(1, 0), b3, voffB); PG8_STAGE(PG8_SB(1, 1), b3 + hstep, voffB); PG8_STAGE(PG8_SA(1, 0), a3, voffA);
            PG8_WAIT_V(8); PG8_WAIT_L(0); PG8_BAR; PG8_MMA(1, 0, At, B0); PG8_MMA(1, 1, At, B1); PG8_BAR; PG8_SCHED;
            } else {
            PG8_LDB(B0, 0, 0); PG8_SCHED; PG8_LDA(At, 0, 0); PG8_STAGE(PG8_SA(1, 1), a1 + hstep, voffA);
            PG8_WAIT_L(8); PG8_BAR; PG8_WAIT_L(0); PG8_MMA(0, 0, At, B0); PG8_BAR; PG8_SCHED;
            PG8_LDB(B1, 0, 1); PG8_STAGE(PG8_SB(0, 0), b2, voffB);
            PG8_BAR; PG8_WAIT_L(0); PG8_MMA(0, 1, At, B1); PG8_BAR;
            PG8_LDA(At, 0, 1); PG8_STAGE(PG8_SA(0, 0), a2, voffA);
            PG8_BAR; PG8_WAIT_L(0); PG8_MMA(1, 0, At, B0); PG8_BAR; PG8_SCHED;
            PG8_STAGE(PG8_SB(0, 1), b2 + hstep, voffB);
            PG8_WAIT_V(6); PG8_BAR; PG8_MMA(1, 1, At, B1); PG8_BAR;
            PG8_LDB(B0, 1, 0); PG8_SCHED; PG8_LDA(At, 1, 0); PG8_STAGE(PG8_SA(0, 1), a2 + hstep, voffA);
            PG8_WAIT_L(8); PG8_BAR; PG8_WAIT_L(0); PG8_MMA(0, 0, At, B0); PG8_BAR; PG8_SCHED;
            PG8_LDB(B1, 1, 1); PG8_STAGE(PG8_SB(1, 0), b3, voffB);
            PG8_BAR; PG8_WAIT_L(0); PG8_MMA(0, 1, At, B1); PG8_BAR;
            PG8_LDA(At, 1, 1); PG8_STAGE(PG8_SA(1, 0), a3, voffA);
            PG8_BAR; PG8_WAIT_L(0); PG8_MMA(1, 0, At, B0); PG8_BAR; PG8_SCHED;
            PG8_STAGE(PG8_SB(1, 1), b3 + hstep, voffB);
            PG8_WAIT_V(6); PG8_BAR; PG8_MMA(1, 1, At, B1); PG8_BAR;
            }
        }
        if constexpr (ALIGN_EPI) { if (wr == 0) PG8_BAR; }
        if constexpr (!Epi::AFTER_DRAIN) { E(acc, cur, wr, wc, fr, fq); S.done(cur); }
        if (!has_next) break;
#pragma unroll
        for (int a = 0; a < 2; ++a)
#pragma unroll
            for (int b = 0; b < 2; ++b)
#pragma unroll
                for (int m = 0; m < 4; ++m)
#pragma unroll
                    for (int n = 0; n < 2; ++n) acc[a][b][m][n] = (f32x4){0.f, 0.f, 0.f, 0.f};
        cur = nxt; cA = nA; cB = nB; ++ui;
        if constexpr (ALIGN_EPI) { if (wr == 1) PG8_BAR; }
    }
    PG8_WAIT_V(0);
    if constexpr (!ALIGN_EPI) { if (wr == 0) PG8_BAR; }
    PG8_BAR;
    if constexpr (Epi::AFTER_DRAIN) { E.fused(acc, cur, wr, wc, fr, fq, lds, wid, lane); S.done(cur); }
#undef PG8_SA
#undef PG8_SB
#undef PG8_STAGE
#undef PG8_LDA
#undef PG8_LDB
#undef PG8_MMA
#undef PG8_WAIT_V
#undef PG8_WAIT_L
#undef PG8_BAR
#undef PG8_SCHED
}
}
#define GAS __attribute__((address_space(1)))
#define LAS __attribute__((address_space(3)))
typedef unsigned short bf16;
typedef unsigned v4u __attribute__((ext_vector_type(4)));
typedef unsigned v2u __attribute__((ext_vector_type(2)));
typedef float f32x4 __attribute__((ext_vector_type(4)));
typedef float f32x2 __attribute__((ext_vector_type(2)));
typedef float f32x16 __attribute__((ext_vector_type(16)));
typedef short bf16x8 __attribute__((ext_vector_type(8)));
typedef short s16x4 __attribute__((ext_vector_type(4)));
typedef GAS unsigned gu32;
#define RLX_AGENT __ATOMIC_RELAXED, __HIP_MEMORY_SCOPE_AGENT
#define LDS_WAIT() asm volatile("s_waitcnt lgkmcnt(0)" ::: "memory")
#define VM_WAIT() asm volatile("s_waitcnt vmcnt(0)" ::: "memory")
__device__ __forceinline__ unsigned pk2(float lo, float hi) { unsigned r; asm volatile("v_cvt_pk_bf16_f32 %0, %1, %2" : "=v"(r) : "v"(lo), "v"(hi)); return r; }
__device__ __forceinline__ float bf_lo(unsigned w) { return __uint_as_float(w << 16); }
__device__ __forceinline__ float bf_hi(unsigned w) { return __uint_as_float(w & 0xffff0000u); }
__device__ __forceinline__ float bf1(bf16 h) { return __uint_as_float(((unsigned)h) << 16); }
__device__ __forceinline__ float wave_sum(float v) {
#pragma unroll
    for (int o = 1; o < 64; o <<= 1) v += __shfl_xor(v, o);
    return v;
}
__device__ __forceinline__ int wave_sum_i(int v) {
#pragma unroll
    for (int o = 1; o < 64; o <<= 1) v += __shfl_xor(v, o);
    return v;
}

#define XB_TMO      128
#define XB_XCNT(j)  (256  + 64 * (j))
#define XB_XSUB(j)  (1280 + 64 * (j))
#define XB_XGEN(j)  (2304 + 64 * (j))
#define XB_TOP      3328
#define XB_TOPGEN   3392
#define XCD_BAR_WORDS 3456
#define XB_SPIN_CAP (1u << 18)

__device__ __forceinline__ unsigned xb_ld(unsigned* p)              { return __hip_atomic_load(p, __ATOMIC_RELAXED, __HIP_MEMORY_SCOPE_AGENT); }
__device__ __forceinline__ unsigned xb_add(unsigned* p, unsigned v) { return __hip_atomic_fetch_add(p, v, __ATOMIC_RELAXED, __HIP_MEMORY_SCOPE_AGENT); }
__device__ __forceinline__ unsigned xb_xcc_id() { return (unsigned)__builtin_amdgcn_s_getreg((3 << 11) | 20) & 0xFu; }
#define XB_SPIN(cond, bar) do { unsigned _sp = 0; while (cond) { __builtin_amdgcn_s_sleep(1); \
    if ((++_sp & 255u) == 0u) { if (xb_ld(&(bar)[XB_TMO])) break; if (_sp > XB_SPIN_CAP) { atomicAdd(&(bar)[XB_TMO], 1u); break; } } } } while (0)

struct XcdBarrier {
    unsigned* bar; unsigned x;
    volatile LAS unsigned* st;
};

__device__ __forceinline__ XcdBarrier xcd_barrier_post(unsigned* bar, volatile LAS unsigned* st) {
    XcdBarrier b; b.bar = bar; b.x = xb_xcc_id(); b.st = st;
    if (threadIdx.x == 0) (void)xb_add(&bar[XB_XCNT(b.x)], 1u);
    return b;
}
__device__ __forceinline__ void xcd_barrier_complete(unsigned* bar, unsigned x, unsigned& nloc, unsigned& nx) {
    const unsigned G = gridDim.x * gridDim.y * gridDim.z;
    unsigned sum, cnt, mine, sp = 0u;
    for (;;) {
        sum = 0u; cnt = 0u; mine = 0u;
#pragma unroll
        for (unsigned j = 0; j < 16; ++j) { const unsigned c = xb_ld(&bar[XB_XCNT(j)]); sum += c; cnt += (c > 0u) ? 1u : 0u; mine = (j == x) ? c : mine; }
        if (sum == G) break;
        __builtin_amdgcn_s_sleep(1);
        if ((++sp & 255u) == 0u) { if (xb_ld(&bar[XB_TMO])) break; if (sp > XB_SPIN_CAP) { atomicAdd(&bar[XB_TMO], 1u); break; } }
    }
    nloc = mine > 0u ? mine : 1u; nx = cnt > 0u ? cnt : 1u;
}

__device__ __forceinline__ void xcd_barrier(const XcdBarrier& b) {
    asm volatile("s_waitcnt vmcnt(0)" ::: "memory");
    __syncthreads();
    if (threadIdx.x == 0) {
        unsigned* bar = b.bar;
        __builtin_amdgcn_s_waitcnt(0);
        unsigned nloc = b.st[0], nx = b.st[1];
        if (nloc == 0u) { xcd_barrier_complete(bar, b.x, nloc, nx); b.st[0] = nloc; b.st[1] = nx; }
        const unsigned old = xb_add(&bar[XB_XSUB(b.x)], 1u);
        const unsigned gen = old / nloc;
        if (old + 1u == (gen + 1u) * nloc) {
            __builtin_amdgcn_fence(__ATOMIC_RELEASE, "agent");
            asm volatile("s_waitcnt vmcnt(0)" ::: "memory");
            const unsigned og = xb_add(&bar[XB_TOP], 1u);
            const unsigned tg = og / nx;
            if (og + 1u == (tg + 1u) * nx) xb_add(&bar[XB_TOPGEN], 1u);
            else XB_SPIN(xb_ld(&bar[XB_TOPGEN]) == tg, bar);
            __builtin_amdgcn_fence(__ATOMIC_ACQUIRE, "agent");
            xb_add(&bar[XB_XGEN(b.x)], 1u);
            asm volatile("s_waitcnt vmcnt(0)" ::: "memory");
        } else {
            XB_SPIN(xb_ld(&bar[XB_XGEN(b.x)]) == gen, bar);
            __builtin_amdgcn_fence(__ATOMIC_ACQUIRE, "agent");
            asm volatile("s_waitcnt vmcnt(0)" ::: "memory");
        }
    }
    __syncthreads();
}

constexpr int NWAVES = 8;
constexpr int DM = 2048, NB = 2, SEQ = 4096, CTXL = 256, LT = SEQ + CTXL  , MT = NB * LT  , MX = NB * SEQ  ;
constexpr int NH = 16, QRANK = 512, KVRANK = 256, INDIM = 832, INPAD = 1024, QW = NH * 192  , KVW = NH * 256  ;
constexpr int NE = 16, CAP = 512, FFD = 1024, MROWS = NB * NE * CAP  ;
constexpr float EPS = 1e-6f;
constexpr size_t MiB = 1u << 20;
constexpr size_t WS_CTL = 0, CTL_ZERO_BYTES = 1 * MiB;
constexpr size_t WS_MOD = 64 * 1024;
constexpr size_t WS_CS = 1 * MiB, WS_A2T = 2 * MiB, WS_A2R = 3 * MiB, WS_TW = 4 * MiB  , WS_AFF = 5 * MiB  , WS_TOK = 5 * MiB + 512 * 1024  ;
constexpr size_t WS_WIN = 8 * MiB, WS_WUQ = 12 * MiB, WS_WUKV = 15 * MiB, WS_WO = 17 * MiB, WS_HYWOUT = 25 * MiB, WS_HYWIN = 33 * MiB;
constexpr size_t WS_WGU = 64 * MiB  , WS_WD = 320 * MiB  ;
constexpr size_t WS_H = 448 * MiB  , WS_PROJ = 482 * MiB  , WS_CQN = 516 * MiB, WS_CKVN = 525 * MiB, WS_KROPE = 530 * MiB;
constexpr size_t WS_Q = 532 * MiB, WS_KV = 583 * MiB, WS_O = 651 * MiB, WS_X1 = 683 * MiB  , WS_XG = 747 * MiB, WS_ACT = 811 * MiB, WS_Y = 843 * MiB, WS_END = 907 * MiB;
constexpr size_t WS_U = 532 * MiB  , WS_ZT = 628 * MiB  , WS_Z = 482 * MiB  ;
constexpr int CW_TMO = 0, CW_BAR = 4096;
constexpr int LDS_BYTES = 155648, MISC_OFF = 153600;
constexpr int NPHASE = 21;

struct Frame {
    LAS unsigned char* lds; unsigned char* ldsg;
    int tid, lane, wave, vcu, G;
    float* out; unsigned char* ws;
};
__device__ __forceinline__ const float* arg_in(int i) {
    const __attribute__((address_space(4))) unsigned long long* ka = (const __attribute__((address_space(4))) unsigned long long*)__builtin_amdgcn_kernarg_segment_ptr();
    asm volatile("" : "+s"(ka));
    return (const float*)(const __attribute__((address_space(1))) float*)ka[i];
}
#define WSP(T, off) ((T*)(F.ws + (off)))

__device__ __forceinline__ int uq_srccol(int n) { const int hh = n / 192, jj = n - hh * 192; if (jj < 128) return n; const int r = jj - 128; return hh * 192 + 128 + (r >> 1) + 32 * (r & 1); }
template <bool VEC>
__device__ __forceinline__ void transpose_item(const float* src, int N, int c0, int k0, bf16* dst, int K, LAS float* scr, int lane) {
    if constexpr (VEC) {
        const float* s = src + (size_t)k0 * N + c0 + (lane & 15) * 4;
        f32x4 v[16];
#pragma unroll
        for (int i = 0; i < 16; ++i) v[i] = *(const f32x4*)(s + (size_t)(4 * i + (lane >> 4)) * N);
#pragma unroll
        for (int i = 0; i < 16; ++i) { LAS float* d = scr + (4 * i + (lane >> 4)) * 65 + (lane & 15) * 4; d[0] = v[i][0]; d[1] = v[i][1]; d[2] = v[i][2]; d[3] = v[i][3]; }
    } else {
        const int sc = uq_srccol(c0 + lane);
        const float* s = src + (size_t)k0 * N + sc;
#pragma unroll 16
        for (int kk = 0; kk < 64; ++kk) scr[kk * 65 + lane] = s[(size_t)kk * N];
    }
    LDS_WAIT(); asm volatile("" ::: "memory");
    const int c = lane & 7;
#pragma unroll
    for (int jj = 0; jj < 8; ++jj) { const int n = (lane >> 3) + 8 * jj; const LAS float* s = scr + (8 * c) * 65 + n;
        v4u o; o.x = pk2(s[0 * 65], s[1 * 65]); o.y = pk2(s[2 * 65], s[3 * 65]); o.z = pk2(s[4 * 65], s[5 * 65]); o.w = pk2(s[6 * 65], s[7 * 65]);
        *(v4u*)(dst + (size_t)n * K + k0 + 8 * c) = o; }
    LDS_WAIT(); asm volatile("" ::: "memory");
}
__device__ __forceinline__ float silu_f(float x) { return x / (1.0f + __expf(-x)); }

__device__ __forceinline__ void p0_prologue(Frame& F) {
    const int gw = F.vcu * NWAVES + F.wave, NGW = F.G * NWAVES;
#ifndef NO_PA
    {
        LAS float* scr = (LAS float*)(F.lds + F.wave * 16640);
        constexpr int I0 = 32 * 13, I1 = 8 * 48, I2 = 4 * 64, I3 = 32 * 32, I4 = 32 * 32, I5 = 32 * 96, I6 = 32 * 1024, I7 = 32 * 512;
        constexpr int NITEMS = I0 + I1 + I2 + I3 + I4 + I5 + I6 + I7;
#pragma unroll 1
        for (int it = gw; it < NITEMS; it += NGW) {
            int r = it; const float* src; int N, c0, k0, K; bf16* dst; bool vec = true;
            if (r < I0) { const int kb = r / 13, nb = r % 13; src = arg_in(8); N = INDIM; c0 = nb * 64; k0 = kb * 64; K = DM; dst = WSP(bf16, WS_WIN) + (size_t)nb * 64 * DM; }
            else if ((r -= I0) < I1) { const int kb = r / 48, nb = r % 48; src = arg_in(11); N = QW; c0 = nb * 64; k0 = kb * 64; K = QRANK; dst = WSP(bf16, WS_WUQ) + (size_t)nb * 64 * QRANK; vec = false; }
            else if ((r -= I1) < I2) { const int kb = r / 64, nb = r % 64; src = arg_in(12); N = KVW; c0 = nb * 64; k0 = kb * 64; K = KVRANK; dst = WSP(bf16, WS_WUKV) + (size_t)nb * 64 * KVRANK; }
            else if ((r -= I2) < I3) { const int kb = r / 32, nb = r % 32; src = arg_in(13); N = DM; c0 = nb * 64; k0 = kb * 64; K = DM; dst = WSP(bf16, WS_WO) + (size_t)nb * 64 * DM; }
            else if ((r -= I3) < I4) { const int kb = r / 32, nb = r % 32; src = arg_in(25); N = DM; c0 = nb * 64; k0 = kb * 64; K = DM; dst = WSP(bf16, WS_HYWOUT) + (size_t)nb * 64 * DM; }
            else if ((r -= I4) < I5) { const int kb = r / 96, nb = r % 96; src = arg_in(14); N = 3 * DM; c0 = nb * 64; k0 = kb * 64; K = DM; dst = WSP(bf16, WS_HYWIN) + (size_t)nb * 64 * DM; }
            else if ((r -= I5) < I6) { const int le = r >> 10, q = r & 1023, kb = q >> 5, nb = q & 31;
                src = (((nb >> 1) & 1) ? arg_in(28) : arg_in(27)) + (size_t)le * DM * FFD; N = FFD; c0 = (nb >> 2) * 128 + (nb & 1) * 64; k0 = kb * 64; K = DM; dst = WSP(bf16, WS_WGU) + ((size_t)le * 2048 + nb * 64) * DM; }
            else { r -= I6; const int le = r >> 9, q = r & 511, kb = q >> 5, nb = q & 31;
                src = arg_in(29) + (size_t)le * FFD * DM; N = DM; c0 = nb * 64; k0 = kb * 64; K = FFD; dst = WSP(bf16, WS_WD) + ((size_t)le * 2048 + nb * 64) * FFD; }
            if (vec) transpose_item<true>(src, N, c0, k0, dst, K, scr, F.lane); else transpose_item<false>(src, N, c0, k0, dst, K, scr, F.lane);
        }
    }
#endif
    __syncthreads();
#ifndef NO_PB
    {
        LAS float* sv = (LAS float*)F.lds;
        LAS float* part = sv + 3 * DM;
        { const float* cin = arg_in(1); const float* cctx = arg_in(3);
        for (int i = F.tid; i < 3 * DM; i += 512) { const float cv = i < 2 * DM ? cin[i] : cctx[i - 2 * DM]; sv[i] = silu_f(cv); } }
        __syncthreads();
        float* mod = WSP(float, WS_MOD); const float* adaw = arg_in(4); const float* adab = arg_in(5);
        const int q = F.tid % 24, kg = F.tid / 24;
        for (int un = F.vcu; un < 256; un += F.G) {
            const int layer = un >> 7, n0 = (un & 127) * 96;
            const float* W = adaw + (size_t)layer * DM * 6 * DM + n0 + q * 4;
            f32x4 a0 = {0.f, 0.f, 0.f, 0.f}, a1 = a0, a2 = a0;
            if (kg < 21) {
#pragma unroll 8
                for (int k = kg; k < DM; k += 21) { const f32x4 w = *(const f32x4*)(W + (size_t)k * (6 * DM)); a0 += sv[k] * w; a1 += sv[DM + k] * w; a2 += sv[2 * DM + k] * w; }
                LAS float* pp = part + kg * 288 + q * 4;
                *(LAS f32x4*)pp = a0; *(LAS f32x4*)(pp + 96) = a1; *(LAS f32x4*)(pp + 192) = a2;
            }
            __syncthreads();
            if (F.tid < 288) { const int m = F.tid / 96, nn = F.tid % 96; float s = adab[(size_t)layer * 6 * DM + n0 + nn];
#pragma unroll
                for (int g = 0; g < 21; ++g) s += part[g * 288 + F.tid];
                mod[((size_t)layer * 3 + m) * 6 * DM + n0 + nn] = s; }
            __syncthreads();
        }
    }
#endif
    __syncthreads();
#ifndef NO_PC
    {
        LAS float* h1s = (LAS float*)F.lds;
        const float* w1 = arg_in(17); const float* b1 = arg_in(18); const float* w2 = arg_in(19); const float* b2 = arg_in(20); const float* fr = arg_in(23);
        float* a2T = WSP(float, WS_A2T); float* a2R = WSP(float, WS_A2R);
        const int lp = F.tid >> 6, j = F.tid & 63;
        for (int un = F.vcu; un < SEQ / 8; un += F.G) {
            const int l = un * 8 + lp;
            const float t = (float)l / (float)SEQ, w = 6.283185307179586f * (float)l / (float)SEQ;
            float pre = b1[j] + t * w1[j];
#pragma unroll
            for (int i = 0; i < 16; ++i) { const float band = 1e-4f + (float)i * ((15.0f - 1e-4f) / 15.0f); const float ang = w * band;
                pre += cosf(ang) * w1[(1 + i) * 64 + j] - sinf(ang) * w1[(17 + i) * 64 + j]; }
            const float f = fr[j];
            __syncthreads();
            h1s[lp * 64 + j] = sinf(f * pre);
            __syncthreads();
            float p2 = b2[j];
#pragma unroll 8
            for (int i = 0; i < 64; ++i) p2 += h1s[lp * 64 + i] * w2[i * 64 + j];
            const float a = sinf(f * p2);
            a2T[(size_t)j * SEQ + l] = a;
            if (l >= 1) a2R[(size_t)j * SEQ + (SEQ - l)] = a; else a2R[(size_t)j * SEQ] = 0.f;
        }
    }
#endif
#ifndef NO_PD
    {
        f32x2* cs = WSP(f32x2, WS_CS);
        for (int i = F.vcu * 512 + F.tid; i < SEQ * 32; i += F.G * 512) { const int l = i >> 5, q = i & 31; const float pos = (float)((q < 16) ? (l >> 6) : (l & 63));
            const float inv = powf(10000.0f, -(float)(q & 15) / 16.0f); const float ang = pos * inv; cs[i] = (f32x2){cosf(ang), sinf(ang)}; }
        f32x2* tw = WSP(f32x2, WS_TW);
        for (int i = F.vcu * 512 + F.tid; i < 8192; i += F.G * 512) { float s, c; if (i < 4096) sincospif((float)i / 2048.0f, &s, &c); else sincospif((float)(i - 4096) / 4096.0f, &s, &c); tw[i] = (f32x2){c, -s}; }
    }
#endif
}

__device__ __forceinline__ void norm_store(const f32x4 (&v)[8], float rstd, const float* g, const float* shift, const float* scale, bf16* orow, int lane) {
#pragma unroll
    for (int j = 0; j < 8; ++j) { const int c = 4 * (64 * j + lane); const f32x4 g4 = *(const f32x4*)(g + c), sh = *(const f32x4*)(shift + c), sc = *(const f32x4*)(scale + c);
        const f32x4 y = v[j] * rstd * g4 * (1.0f + sc) + sh; v2u o; o.x = pk2(y[0], y[1]); o.y = pk2(y[2], y[3]); *(v2u*)(orow + c) = o; }
}
__device__ __forceinline__ void p1_norm0(Frame& F) {
    const int gw = F.vcu * NWAVES + F.wave, NGW = F.G * NWAVES;
    const float* mod = WSP(float, WS_MOD); bf16* H = WSP(bf16, WS_H); const float* xin = arg_in(0); const float* cin = arg_in(2); const float* ng = arg_in(6);
    for (int row = gw; row < MT; row += NGW) {
        const int b = row >= LT ? 1 : 0, r = row - b * LT; const bool lat = r < SEQ;
        const float* xr = lat ? xin + ((size_t)b * SEQ + r) * DM : cin + ((size_t)b * CTXL + (r - SEQ)) * DM;
        const float* mr = mod + (size_t)(lat ? b : 2) * 6 * DM;
        f32x4 v[8]; float s = 0.f;
#pragma unroll
        for (int j = 0; j < 8; ++j) { v[j] = *(const f32x4*)(xr + 4 * (64 * j + F.lane)); s += (v[j][0] * v[j][0] + v[j][1] * v[j][1]) + (v[j][2] * v[j][2] + v[j][3] * v[j][3]); }
        const float rstd = 1.0f / sqrtf(wave_sum(s) * (1.0f / DM) + EPS);
        norm_store(v, rstd, ng, mr, mr + DM, H + (size_t)row * DM, F.lane);
    }
}
__device__ __forceinline__ void p3_latent(Frame& F) {
    const int gw = F.vcu * NWAVES + F.wave, NGW = F.G * NWAVES;
    const float* proj = WSP(float, WS_PROJ); bf16* cqn = WSP(bf16, WS_CQN); bf16* ckvn = WSP(bf16, WS_CKVN); bf16* kro = WSP(bf16, WS_KROPE); const f32x2* cs = WSP(f32x2, WS_CS);
    const float* gq = arg_in(9); const float* gkv = arg_in(10);
    for (int row = gw; row < MT; row += NGW) {
        const float* pr = proj + (size_t)row * INPAD; const int l = row % LT;
        const f32x4 q0 = *(const f32x4*)(pr + 4 * F.lane), q1 = *(const f32x4*)(pr + 256 + 4 * F.lane), kv = *(const f32x4*)(pr + 512 + 4 * F.lane);
        float sq = (q0[0] * q0[0] + q0[1] * q0[1]) + (q0[2] * q0[2] + q0[3] * q0[3]) + (q1[0] * q1[0] + q1[1] * q1[1]) + (q1[2] * q1[2] + q1[3] * q1[3]);
        float sk = (kv[0] * kv[0] + kv[1] * kv[1]) + (kv[2] * kv[2] + kv[3] * kv[3]);
        const float rq = 1.0f / sqrtf(wave_sum(sq) * (1.0f / QRANK) + EPS), rk = 1.0f / sqrtf(wave_sum(sk) * (1.0f / KVRANK) + EPS);
        { const f32x4 g0 = *(const f32x4*)(gq + 4 * F.lane), g1 = *(const f32x4*)(gq + 256 + 4 * F.lane), g2 = *(const f32x4*)(gkv + 4 * F.lane);
          const f32x4 y0 = q0 * rq * g0, y1 = q1 * rq * g1, y2 = kv * rk * g2;
          v2u o; o.x = pk2(y0[0], y0[1]); o.y = pk2(y0[2], y0[3]); *(v2u*)(cqn + (size_t)row * QRANK + 4 * F.lane) = o;
          o.x = pk2(y1[0], y1[1]); o.y = pk2(y1[2], y1[3]); *(v2u*)(cqn + (size_t)row * QRANK + 256 + 4 * F.lane) = o;
          o.x = pk2(y2[0], y2[1]); o.y = pk2(y2[2], y2[3]); *(v2u*)(ckvn + (size_t)row * KVRANK + 4 * F.lane) = o; }
        if (F.lane < 32) { const float x1 = pr[768 + F.lane], x2 = pr[800 + F.lane]; float o1 = x1, o2 = x2;
            if (l < SEQ) { const f32x2 c = cs[(size_t)l * 32 + F.lane]; o1 = x1 * c.x - x2 * c.y; o2 = x2 * c.x + x1 * c.y; }
            ((unsigned*)(kro + (size_t)row * 64))[F.lane] = pk2(o1, o2); }
    }
}
__device__ __forceinline__ void p8_norm_router(Frame& F, int layer) {
    const int gw = F.vcu * NWAVES + F.wave, NGW = F.G * NWAVES;
    const float* X = WSP(float, WS_X1); bf16* H = WSP(bf16, WS_H); float* aff = WSP(float, WS_AFF);
    const float* mod = WSP(float, WS_MOD) + (size_t)layer * 3 * 6 * DM; const float* g = arg_in(6) + (size_t)(layer * 2 + 1) * DM;
    LAS float* wr = (LAS float*)F.lds;
    __syncthreads();
    { const float* W = arg_in(26) + (size_t)layer * DM * NE;
      for (int i = F.tid; i < DM * NE / 4; i += 512) { const int c = i >> 2, q = i & 3; *(LAS f32x4*)(wr + c * 16 + (c >> 2) * 4 + q * 4) = *(const f32x4*)(W + (size_t)i * 4); } }
    __syncthreads();
    for (int row = gw; row < MX; row += NGW) {
        const int b = row >> 12, t = row & 4095; const float* xr = X + (size_t)row * DM; const float* shift = mod + (size_t)b * 6 * DM + 3 * DM; const float* scale = shift + DM;
        f32x4 v[8]; float s = 0.f;
#pragma unroll
        for (int j = 0; j < 8; ++j) { v[j] = *(const f32x4*)(xr + 4 * (64 * j + F.lane)); s += (v[j][0] * v[j][0] + v[j][1] * v[j][1]) + (v[j][2] * v[j][2] + v[j][3] * v[j][3]); }
        const float rstd = 1.0f / sqrtf(wave_sum(s) * (1.0f / DM) + EPS);
        f32x4 lg[4] = {{0.f, 0.f, 0.f, 0.f}, {0.f, 0.f, 0.f, 0.f}, {0.f, 0.f, 0.f, 0.f}, {0.f, 0.f, 0.f, 0.f}};
#pragma unroll
        for (int j = 0; j < 8; ++j) { const int c = 4 * (64 * j + F.lane); const f32x4 g4 = *(const f32x4*)(g + c), sh = *(const f32x4*)(shift + c), sc = *(const f32x4*)(scale + c);
            const f32x4 y = v[j] * rstd * g4 * (1.0f + sc) + sh; v2u o; o.x = pk2(y[0], y[1]); o.y = pk2(y[2], y[3]); *(v2u*)(H + (size_t)row * DM + c) = o;
            const LAS float* wp = wr + c * 16 + (c >> 2) * 4;
#pragma unroll
            for (int q = 0; q < 4; ++q) {
#pragma unroll
                for (int e4 = 0; e4 < 4; ++e4) lg[e4] += y[q] * *(const LAS f32x4*)(wp + q * 16 + e4 * 4); } }
        float lv[16];
#pragma unroll
        for (int e = 0; e < 16; ++e) lv[e] = wave_sum(lg[e >> 2][e & 3]);
        float mx = lv[0];
#pragma unroll
        for (int e = 1; e < 16; ++e) mx = fmaxf(mx, lv[e]);
        float den = 0.f;
#pragma unroll
        for (int e = 0; e < 16; ++e) { lv[e] = __expf(lv[e] - mx); den += lv[e]; }
        float mine = 0.f;
#pragma unroll
        for (int e = 0; e < 16; ++e) mine = (F.lane == e) ? lv[e] : mine;
        if (F.lane < 16) aff[((size_t)b * NE + F.lane) * SEQ + t] = mine / den;
    }
    __syncthreads();
}
__device__ __forceinline__ void p9_select_gather(Frame& F) {
    const float* aff = WSP(float, WS_AFF); int* tok = WSP(int, WS_TOK); const bf16* H = WSP(bf16, WS_H); bf16* XG = WSP(bf16, WS_XG);
    LAS int* red = (LAS int*)F.lds;
    LAS int* sel = (LAS int*)(F.lds + 256);
    for (int un = F.vcu; un < NB * NE * 8; un += F.G) {
        const int be = un >> 3, part = un & 7, b = be >> 4, e = be & 15;
        const float* ar = aff + (size_t)be * SEQ + 8 * F.tid;
        const f32x4 a0 = *(const f32x4*)ar, a1 = *(const f32x4*)(ar + 4);
        unsigned key[8] = {__float_as_uint(a0[0]), __float_as_uint(a0[1]), __float_as_uint(a0[2]), __float_as_uint(a0[3]), __float_as_uint(a1[0]), __float_as_uint(a1[1]), __float_as_uint(a1[2]), __float_as_uint(a1[3])};
        __syncthreads();
        unsigned prefix = 0u;
        for (int bit = 30; bit >= 0; --bit) {
            const unsigned cand = prefix | (1u << bit); int c = 0;
#pragma unroll
            for (int i = 0; i < 8; ++i) c += (key[i] >= cand) ? 1 : 0;
            c = wave_sum_i(c);
            LAS int* slot = red + (bit & 1) * 8;
            if (F.lane == 0) slot[F.wave] = c;
            __syncthreads();
            int tot = 0;
#pragma unroll
            for (int w = 0; w < 8; ++w) tot += slot[w];
            if (tot >= CAP) prefix = cand;
        }
        int cgt = 0, ceq = 0;
#pragma unroll
        for (int i = 0; i < 8; ++i) { cgt += (key[i] > prefix) ? 1 : 0; ceq += (key[i] == prefix) ? 1 : 0; }
        int pk = (ceq << 16) | cgt, inc = pk;
#pragma unroll
        for (int o = 1; o < 64; o <<= 1) { const int y = __shfl_up(inc, o); if (F.lane >= o) inc += y; }
        __syncthreads();
        if (F.lane == 63) red[16 + F.wave] = inc;
        __syncthreads();
        int wpre = 0, total = 0;
#pragma unroll
        for (int w = 0; w < 8; ++w) { const int x = red[16 + w]; if (w < F.wave) wpre += x; total += x; }
        const int exc = wpre + inc - pk;
        const int need = CAP - (total & 0xffff);
        int eqb = exc >> 16, gtb = exc & 0xffff;
        int slotv[8];
#pragma unroll
        for (int i = 0; i < 8; ++i) { const bool gt = key[i] > prefix, eq = key[i] == prefix; const bool s = gt || (eq && eqb < need);
            const int before = gtb + (eqb < need ? eqb : need);
            slotv[i] = s ? before : -1; gtb += gt ? 1 : 0; eqb += eq ? 1 : 0; }
#pragma unroll
        for (int i = 0; i < 8; ++i) if (slotv[i] >= 0) sel[slotv[i]] = 8 * F.tid + i;
        if (part == 0) { int* tr = tok + (size_t)be * SEQ + 8 * F.tid; *(int4*)tr = make_int4(slotv[0], slotv[1], slotv[2], slotv[3]); *(int4*)(tr + 4) = make_int4(slotv[4], slotv[5], slotv[6], slotv[7]); }
        __syncthreads();
#pragma unroll
        for (int i = 0; i < 8; ++i) { const int sl = part * 64 + F.wave * 8 + i; const int t = sel[sl];
            const v4u* src = (const v4u*)(H + ((size_t)b * SEQ + t) * DM) + F.lane; v4u* dst = (v4u*)(XG + ((size_t)e * 1024 + b * CAP + sl) * DM) + F.lane;
            const v4u r0 = src[0], r1 = src[64], r2 = src[128], r3 = src[192]; dst[0] = r0; dst[64] = r1; dst[128] = r2; dst[192] = r3; }
        __syncthreads();
    }
}
template <bool FINAL>
__device__ __forceinline__ void p12_combine_norm(Frame& F, int layer) {
    const int gw = F.vcu * NWAVES + F.wave, NGW = F.G * NWAVES;
    float* X = WSP(float, WS_X1); bf16* H = WSP(bf16, WS_H); const float* aff = WSP(float, WS_AFF); const int* tok = WSP(int, WS_TOK); const bf16* Y = WSP(bf16, WS_Y);
    const float* modl = WSP(float, WS_MOD) + (size_t)layer * 3 * 6 * DM; const float* gfin = FINAL ? arg_in(7) : arg_in(6) + (size_t)((layer + 1) * 2) * DM;
    for (int row = gw; row < MX; row += NGW) {
        const int b = row >> 12, t = row & 4095; float* xr = X + (size_t)row * DM; const float* g5 = modl + (size_t)b * 6 * DM + 5 * DM;
        f32x4 v[8], acc[8];
#pragma unroll
        for (int j = 0; j < 8; ++j) { v[j] = *(const f32x4*)(xr + 4 * (64 * j + F.lane)); acc[j] = (f32x4){0.f, 0.f, 0.f, 0.f}; }
        int sv = -1; float av = 0.f;
        if (F.lane < 16) { sv = tok[((size_t)b * NE + F.lane) * SEQ + t]; av = aff[((size_t)b * NE + F.lane) * SEQ + t]; }
#pragma unroll
        for (int e = 0; e < 16; ++e) { const int s = __builtin_amdgcn_readlane(sv, e); const float a = __builtin_bit_cast(float, __builtin_amdgcn_readlane(__builtin_bit_cast(int, av), e));
            if (s >= 0) { const bf16* yr = Y + ((size_t)e * 1024 + b * CAP + s) * DM;
#pragma unroll
                for (int j = 0; j < 8; ++j) { const v2u w = *(const v2u*)(yr + 4 * (64 * j + F.lane)); acc[j] += a * (f32x4){bf_lo(w.x), bf_hi(w.x), bf_lo(w.y), bf_hi(w.y)}; } } }
        float s2 = 0.f;
#pragma unroll
        for (int j = 0; j < 8; ++j) { const f32x4 g4 = *(const f32x4*)(g5 + 4 * (64 * j + F.lane)); v[j] += g4 * acc[j]; s2 += (v[j][0] * v[j][0] + v[j][1] * v[j][1]) + (v[j][2] * v[j][2] + v[j][3] * v[j][3]); }
        const float rstd = 1.0f / sqrtf(wave_sum(s2) * (1.0f / DM) + EPS);
        if constexpr (FINAL) {
#pragma unroll
            for (int j = 0; j < 8; ++j) { const int c = 4 * (64 * j + F.lane); *(f32x4*)(F.out + (size_t)row * DM + c) = v[j] * rstd * *(const f32x4*)(gfin + c); }
        } else {
#pragma unroll
            for (int j = 0; j < 8; ++j) *(f32x4*)(xr + 4 * (64 * j + F.lane)) = v[j];
            const float* m1 = WSP(float, WS_MOD) + (size_t)(layer + 1) * 3 * 6 * DM + (size_t)b * 6 * DM;
            norm_store(v, rstd, gfin, m1, m1 + DM, H + (size_t)row * DM, F.lane);
        }
    }
}
__device__ __forceinline__ void p15_transpose(Frame& F) {
    const int gw = F.vcu * NWAVES + F.wave, NGW = F.G * NWAVES;
    const bf16* ZT = WSP(bf16, WS_ZT); bf16* Z = WSP(bf16, WS_Z);
    LAS bf16* scr = (LAS bf16*)(F.lds + F.wave * 8704);
    for (int tl = gw; tl < (DM / 64) * (MX / 64); tl += NGW) {
        const int dt = tl & 31, tt = tl >> 5;
#pragma unroll
        for (int i = 0; i < 8; ++i) { const int d = 8 * i + (F.lane >> 3); const v4u w = *(const v4u*)(ZT + (size_t)(dt * 64 + d) * MX + tt * 64 + (F.lane & 7) * 8);
            LAS bf16* p = scr + d * 68 + (F.lane & 7) * 8; *(LAS v2u*)p = (v2u){w.x, w.y}; *(LAS v2u*)(p + 4) = (v2u){w.z, w.w}; }
        LDS_WAIT(); asm volatile("" ::: "memory");
#pragma unroll
        for (int i = 0; i < 8; ++i) { const int tk = 8 * i + (F.lane >> 3), d0 = (F.lane & 7) * 8; unsigned short h[8];
#pragma unroll
            for (int q = 0; q < 8; ++q) h[q] = scr[(d0 + q) * 68 + tk];
            v4u o; o.x = h[0] | ((unsigned)h[1] << 16); o.y = h[2] | ((unsigned)h[3] << 16); o.z = h[4] | ((unsigned)h[5] << 16); o.w = h[6] | ((unsigned)h[7] << 16);
            *(v4u*)(Z + (size_t)(tt * 64 + tk) * DM + dt * 64 + d0) = o; }
        LDS_WAIT(); asm volatile("" ::: "memory");
    }
}

namespace att {
constexpr int NW = 8, QBLK = 32, KVBLK = 64, KROW = 384  ;
constexpr float SCALE = 0.07216878364870322f;
constexpr float THR = 8.f;
#ifndef ATT_SDEPTH
#define ATT_SDEPTH 1
#endif
constexpr int SDEPTH = ATT_SDEPTH;
constexpr int SHM_V = KVBLK * 128 * 2, SHM_K = KVBLK * KROW, SHM_QR = 2 * SHM_V + 2 * SHM_K + NW * 64 * 4  , SHM_ATTN = SHM_QR + NW * 4096;
#define KSWZ(row, colB) ((row) * 384 + ((colB) ^ (((row) & 7) << 4)))
#define SBAR() __builtin_amdgcn_sched_barrier(0)
__device__ __forceinline__ int crow(int r, int hi) { return (r & 3) + 8 * (r >> 2) + 4 * hi; }
__device__ __forceinline__ void partialSM(f32x16& p0, f32x16& p1, float& m_reg, float& mn, float& alpha) {
  constexpr float C = SCALE * 1.4426950408889634f;
  float pmax = p0[0];
#pragma unroll
  for (int r = 1; r < 16; ++r) pmax = fmaxf(pmax, p0[r]);
#pragma unroll
  for (int r = 0; r < 16; ++r) pmax = fmaxf(pmax, p1[r]);
  { auto rr = __builtin_amdgcn_permlane32_swap(__float_as_uint(pmax), __float_as_uint(pmax), false, false);
    pmax = fmaxf(__uint_as_float(rr[0]), __uint_as_float(rr[1])); }
  if (__builtin_expect(__all(pmax - m_reg <= THR / SCALE), 1)) { mn = m_reg; alpha = 1.f; }
  else { mn = fmaxf(m_reg, pmax); alpha = __builtin_amdgcn_exp2f((m_reg - mn) * C); m_reg = mn; }
  const float mnC = -mn * C;
#pragma unroll
  for (int r = 0; r < 16; ++r) p0[r] = fmaf(p0[r], C, mnC);
#pragma unroll
  for (int r = 0; r < 16; ++r) p1[r] = fmaf(p1[r], C, mnC);
#pragma unroll
  for (int r = 0; r < 16; ++r) p0[r] = __builtin_amdgcn_exp2f(p0[r]);
}
__device__ __forceinline__ void finishSM(f32x16& p0, f32x16& p1, float alpha, float& l_reg, bf16x8& pa0, bf16x8& pa1, bf16x8& pa2, bf16x8& pa3) {
#pragma unroll
  for (int r = 0; r < 16; ++r) p1[r] = __builtin_amdgcn_exp2f(p1[r]);
  float ps = 0;
#pragma unroll
  for (int r = 0; r < 16; ++r) ps += p0[r];
#pragma unroll
  for (int r = 0; r < 16; ++r) ps += p1[r];
  { auto rr = __builtin_amdgcn_permlane32_swap(__float_as_uint(ps), __float_as_uint(ps), false, false);
    ps = __uint_as_float(rr[0]) + __uint_as_float(rr[1]); }
  l_reg = l_reg * alpha + ps;
#define PK4(P, BASE, OUT) do { unsigned a0 = pk2(P[BASE + 0], P[BASE + 1]), a1 = pk2(P[BASE + 2], P[BASE + 3]);   \
    unsigned b0 = pk2(P[BASE + 4], P[BASE + 5]), b1 = pk2(P[BASE + 6], P[BASE + 7]);                              \
    auto r0 = __builtin_amdgcn_permlane32_swap(a0, b0, false, false); auto r1 = __builtin_amdgcn_permlane32_swap(a1, b1, false, false); \
    v4u w = {r0[0], r1[0], r0[1], r1[1]}; OUT = *reinterpret_cast<bf16x8*>(&w); } while (0)
  PK4(p0, 0, pa0); PK4(p0, 8, pa1); PK4(p1, 0, pa2); PK4(p1, 8, pa3);
#undef PK4
}
__device__ __forceinline__ void qkt(f32x16& p0, f32x16& p1, const char* Ks, const bf16x8* qr, const char* qL, const int (&kb)[4]) {
  p0 = f32x16{}; p1 = f32x16{};
#pragma unroll
  for (int d0 = 0; d0 < 12; ++d0) {
    const bf16x8 qf = d0 < 8 ? qr[d0 < 8 ? d0 : 0] : *reinterpret_cast<const bf16x8*>(qL + (d0 - 8) * 1024);
    const bf16x8 b0 = *reinterpret_cast<const bf16x8*>(Ks + kb[d0 & 3] + (d0 >> 2) * 128);
    const bf16x8 b1 = *reinterpret_cast<const bf16x8*>(Ks + kb[d0 & 3] + (d0 >> 2) * 128 + 32 * 384);
    p0 = __builtin_amdgcn_mfma_f32_32x32x16_bf16(b0, qf, p0, 0, 0, 0);
    p1 = __builtin_amdgcn_mfma_f32_32x32x16_bf16(b1, qf, p1, 0, 0, 0); }
}
__device__ __forceinline__ int v_st(int k, int c) { const int kk = (k & ~0xC) | ((k & 4) << 1) | ((k & 8) >> 1); return ((kk >> 3) * 4 + (c >> 5)) * 512 + ((kk & 7) * 32 + (c & 31)) * 2; }
__device__ __forceinline__ int v_rd_base(int lane) { return ((lane & 3) << 3) | (((lane >> 2) & 3) << 6) | (((lane >> 4) & 1) << 5) | (((lane >> 5) & 1) << 8); }
constexpr int v_rd_off(int d0, int ks, int half) { return d0 * 512 + ks * 4096 + half * 2048; }
template <int OFF> __device__ __forceinline__ s16x4 tr_read(int vb) {
  s16x4 r; asm volatile("ds_read_b64_tr_b16 %0, %1 offset:%2" : "=&v"(r) : "v"(vb), "i"(OFF) : "memory"); return r;
}
template <int D0> __device__ __forceinline__ void pv_one(f32x16& od, int vb, bf16x8 pa0, bf16x8 pa1, bf16x8 pa2, bf16x8 pa3) {
  const s16x4 l0 = tr_read<v_rd_off(D0, 0, 0)>(vb), h0 = tr_read<v_rd_off(D0, 0, 1)>(vb), l1 = tr_read<v_rd_off(D0, 1, 0)>(vb), h1 = tr_read<v_rd_off(D0, 1, 1)>(vb);
  const s16x4 l2 = tr_read<v_rd_off(D0, 2, 0)>(vb), h2 = tr_read<v_rd_off(D0, 2, 1)>(vb), l3 = tr_read<v_rd_off(D0, 3, 0)>(vb), h3 = tr_read<v_rd_off(D0, 3, 1)>(vb);
  asm volatile("s_waitcnt lgkmcnt(0)" ::: "memory"); SBAR();
#define PKV(L, H) (bf16x8){L[0], L[1], L[2], L[3], H[0], H[1], H[2], H[3]}
  od = __builtin_amdgcn_mfma_f32_32x32x16_bf16(pa0, PKV(l0, h0), od, 0, 0, 0);
  od = __builtin_amdgcn_mfma_f32_32x32x16_bf16(pa1, PKV(l1, h1), od, 0, 0, 0);
  od = __builtin_amdgcn_mfma_f32_32x32x16_bf16(pa2, PKV(l2, h2), od, 0, 0, 0);
  od = __builtin_amdgcn_mfma_f32_32x32x16_bf16(pa3, PKV(l3, h3), od, 0, 0, 0);
#undef PKV
}
__device__ __forceinline__ void pv_d0(f32x16* o, int vb, bf16x8 pa0, bf16x8 pa1, bf16x8 pa2, bf16x8 pa3) {
  pv_one<0>(o[0], vb, pa0, pa1, pa2, pa3); pv_one<1>(o[1], vb, pa0, pa1, pa2, pa3); pv_one<2>(o[2], vb, pa0, pa1, pa2, pa3); pv_one<3>(o[3], vb, pa0, pa1, pa2, pa3);
}
__device__ __forceinline__ void attn_body(const bf16* __restrict__ Qb, const bf16* __restrict__ Kn, const bf16* __restrict__ Kr, const bf16* __restrict__ Vh, bf16* __restrict__ Ob, int seq, char* lds) {
  constexpr int LDQ = 3072, LDK = 4096, LDR = 64, LDO = 2048;
  const int tid = threadIdx.x, wid = tid >> 6, lane = tid & 63, r32 = lane & 31, hi = lane >> 5;
  char* V_lds = lds; char* K_lds = lds + 2 * SHM_V;
  float* ws = (float*)(lds + 2 * SHM_V + 2 * SHM_K) + wid * 64; float* li_l = ws; float* al_l = ws + 32;
  float m_reg = -1e30f, l_reg = 0; f32x16 o[4] = {}; bf16x8 qr[8];
  char* qL = lds + SHM_QR + wid * 4096 + lane * 16;
  const bf16* Qw = Qb + (unsigned)((wid * QBLK + r32) * LDQ + hi * 8);
#pragma unroll
  for (int d0 = 0; d0 < 8; ++d0) qr[d0] = *reinterpret_cast<const bf16x8*>(Qw + d0 * 16);
#pragma unroll
  for (int d0 = 8; d0 < 12; ++d0) *reinterpret_cast<bf16x8*>(qL + (d0 - 8) * 1024) = *reinterpret_cast<const bf16x8*>(Qw + d0 * 16);
  const int sr = tid >> 4, sc = (tid & 15) * 8, vst0 = v_st(sr, sc), vst1 = v_st(32 + sr, sc);
  const int rr = tid >> 3, rc = (tid & 7) * 8;
  const unsigned o_s0 = (unsigned)(sr * LDK + sc), o_s1 = (unsigned)((32 + sr) * LDK + sc), o_r = (unsigned)(rr * LDR + rc);
  int kb[4];
#pragma unroll
  for (int q = 0; q < 4; ++q) kb[q] = r32 * 384 + ((q * 32 + hi * 16) ^ ((r32 & 7) << 4));
  const int vb0 = (int)(uintptr_t)V_lds + v_rd_base(lane);
  struct { bf16x8 vs0, vs1, ks0, ks1, kr0; } sr_[SDEPTH];
#define SLOAD(i, k0) do { const bf16* Vt = Vh + (size_t)(k0) * LDK; const bf16* Kt = Kn + (size_t)(k0) * LDK; const bf16* Rt = Kr + (size_t)(k0) * LDR; \
    sr_[i].vs0 = *(const bf16x8*)(Vt + o_s0); sr_[i].vs1 = *(const bf16x8*)(Vt + o_s1); sr_[i].ks0 = *(const bf16x8*)(Kt + o_s0); sr_[i].ks1 = *(const bf16x8*)(Kt + o_s1); \
    sr_[i].kr0 = *(const bf16x8*)(Rt + o_r); } while (0)
#define SWRITE(b, i) do { *(bf16x8*)(V_lds + (b) * SHM_V + vst0) = sr_[i].vs0; *(bf16x8*)(V_lds + (b) * SHM_V + vst1) = sr_[i].vs1; const int kc = sc * 2;               \
    *(bf16x8*)(K_lds + (b) * SHM_K + KSWZ(sr, kc)) = sr_[i].ks0; *(bf16x8*)(K_lds + (b) * SHM_K + KSWZ(32 + sr, kc)) = sr_[i].ks1;                       \
    *(bf16x8*)(K_lds + (b) * SHM_K + KSWZ(rr, 256 + rc * 2)) = sr_[i].kr0; } while (0)
#define SWAIT() do { if constexpr (SDEPTH == 2) asm volatile("s_waitcnt vmcnt(5)" ::: "memory"); else asm volatile("s_waitcnt vmcnt(0)" ::: "memory"); } while (0)
#define RESC(a) do { if (__any((a) < 1.f)) { if (hi == 0) al_l[r32] = (a); asm volatile("s_waitcnt lgkmcnt(0)" ::: "memory"); \
    _Pragma("unroll") for (int d = 0; d < 4; ++d) _Pragma("unroll") for (int r = 0; r < 16; ++r) o[d][r] *= al_l[crow(r, hi)]; } } while (0)
  f32x16 pA0, pA1, pB0, pB1; float mnA, mnB, alA, alB; bf16x8 pa0, pa1, pa2, pa3; const int NT = seq / KVBLK;
  constexpr int SE = 0, SO = SDEPTH - 1;
  SLOAD(SE, 0); asm volatile("s_waitcnt vmcnt(0)" ::: "memory"); SWRITE(0, SE); __syncthreads();
  qkt(pA0, pA1, K_lds, qr, qL, kb); partialSM(pA0, pA1, m_reg, mnA, alA);
  SLOAD(SO, KVBLK); if constexpr (SDEPTH == 2) { if (2 < NT) SLOAD(SE, 2 * KVBLK); }
  SWAIT(); SWRITE(1, SO); __syncthreads();
  for (int j = 1; j + 1 < NT; j += 2) {
    SBAR(); qkt(pB0, pB1, K_lds + SHM_K, qr, qL, kb);
    finishSM(pA0, pA1, alA, l_reg, pa0, pa1, pa2, pa3); SBAR();
    SLOAD(SO, (j + SDEPTH) * KVBLK); SBAR();
    pv_d0(o, vb0, pa0, pa1, pa2, pa3); partialSM(pB0, pB1, m_reg, mnB, alB);
    __syncthreads(); SWAIT(); SWRITE(0, SE);
    RESC(alB); __syncthreads();
    SBAR(); qkt(pA0, pA1, K_lds, qr, qL, kb);
    finishSM(pB0, pB1, alB, l_reg, pa0, pa1, pa2, pa3); SBAR();
    if (SDEPTH == 1 || j + 3 < NT) SLOAD(SE, (j + 1 + SDEPTH) * KVBLK); SBAR();
    pv_d0(o, vb0 + SHM_V, pa0, pa1, pa2, pa3); partialSM(pA0, pA1, m_reg, mnA, alA);
    __syncthreads(); SWAIT(); SWRITE(1, SO);
    RESC(alA); __syncthreads();
  }
  SBAR(); qkt(pB0, pB1, K_lds + SHM_K, qr, qL, kb);
  finishSM(pA0, pA1, alA, l_reg, pa0, pa1, pa2, pa3); SBAR();
  pv_d0(o, vb0, pa0, pa1, pa2, pa3); partialSM(pB0, pB1, m_reg, mnB, alB);
  __syncthreads(); RESC(alB);
  finishSM(pB0, pB1, alB, l_reg, pa0, pa1, pa2, pa3); SBAR();
  pv_d0(o, vb0 + SHM_V, pa0, pa1, pa2, pa3);
  if (hi == 0) li_l[r32] = l_reg; asm volatile("s_waitcnt lgkmcnt(0)" ::: "memory");
  float rli[16];
#pragma unroll
  for (int r = 0; r < 16; ++r) rli[r] = __builtin_amdgcn_rcpf(li_l[crow(r, hi)]);
  bf16* Ow = Ob + (size_t)(wid * QBLK) * LDO;
#pragma unroll
  for (int r = 0; r < 16; ++r) { const int orow = crow(r, hi);
#pragma unroll
    for (int d0 = 0; d0 < 4; ++d0) Ow[(unsigned)(orow * LDO + d0 * 32 + r32)] = (bf16)(pk2(o[d0][r] * rli[r], 0.f) & 0xffffu); }
#undef SLOAD
#undef SWRITE
#undef SWAIT
#undef RESC
}
}
__device__ __forceinline__ void p6_attention(Frame& F) {
    const bf16* Q = WSP(bf16, WS_Q); const bf16* KV = WSP(bf16, WS_KV); const bf16* KR = WSP(bf16, WS_KROPE); bf16* O = WSP(bf16, WS_O);
    const int nun = NB * NH * (SEQ / 256);
    for (int i = 0; ; ++i) {
        int bh, qb;
        if (F.G == 256) { if (i >= 2) break; const int x = blockIdx.x & 7, j = blockIdx.x >> 3; bh = (i * 8 + x) * 2 + (j >> 4); qb = j & 15; }
        else { const int L = i * F.G + (int)blockIdx.x; if (L >= nun) break; bh = L >> 4; qb = L & 15; }
        const int b = bh >> 4, h = bh & 15;
        __syncthreads();
        att::attn_body(Q + ((size_t)b * LT + qb * 256) * QW + h * 192, KV + (size_t)b * LT * KVW + h * 256, KR + (size_t)b * LT * 64, KV + (size_t)b * LT * KVW + h * 256 + 128,
                       O + ((size_t)b * SEQ + qb * 256) * DM + h * 128, LT, (char*)F.ldsg);
    }
    __syncthreads();
}

namespace hy {
typedef float cpx __attribute__((ext_vector_type(2)));
__device__ __forceinline__ cpx cmul(cpx a, cpx b) { return (cpx){a.x * b.x - a.y * b.y, a.x * b.y + a.y * b.x}; }
__device__ __forceinline__ cpx cmulc(cpx a, cpx b) { return (cpx){a.x * b.x + a.y * b.y, a.y * b.x - a.x * b.y}; }
__device__ __forceinline__ cpx cadd(cpx a, cpx b) { return a + b; }
__device__ __forceinline__ cpx csub(cpx a, cpx b) { return a - b; }
template <int S> __device__ __forceinline__ cpx mul_i(cpx a) { return S < 0 ? (cpx){a.y, -a.x} : (cpx){-a.y, a.x}; }
template <int S> __device__ __forceinline__ void dft4(cpx& x0, cpx& x1, cpx& x2, cpx& x3) {
    const cpx t0 = cadd(x0, x2), t1 = csub(x0, x2), t2 = cadd(x1, x3), t3 = mul_i<S>(csub(x1, x3));
    x0 = cadd(t0, t2); x2 = csub(t0, t2); x1 = cadd(t1, t3); x3 = csub(t1, t3);
}
template <int S> __device__ __forceinline__ cpx tw16(cpx a, int m) {
    constexpr float C1 = 0.9238795325112867f, S1 = 0.3826834323650898f, R = 0.7071067811865476f;
    cpx w;
    switch (m) { case 0: return a; case 1: w = (cpx){C1, -S1}; break; case 2: w = (cpx){R, -R}; break; case 3: w = (cpx){S1, -C1}; break; case 4: w = (cpx){0.f, -1.f}; break; case 6: w = (cpx){-R, -R}; break; default: w = (cpx){-C1, S1}; break; }
    if (S > 0) w.y = -w.y;
    return cmul(a, w);
}
template <int S> __device__ __forceinline__ void dft16(cpx (&v)[16]) {
#pragma unroll
    for (int a = 0; a < 4; ++a) { dft4<S>(v[a], v[a + 4], v[a + 8], v[a + 12]);
#pragma unroll
        for (int d = 1; d < 4; ++d) v[a + 4 * d] = tw16<S>(v[a + 4 * d], a * d); }
#pragma unroll
    for (int d = 0; d < 4; ++d) dft4<S>(v[4 * d], v[4 * d + 1], v[4 * d + 2], v[4 * d + 3]);
}
__device__ __forceinline__ constexpr int SL(int k) { return 4 * (k & 3) + (k >> 2); }
__device__ __forceinline__ int PI(int i) { return i + (i >> 4); }
typedef LAS cpx* lbuf;
__device__ __forceinline__ void fwd12(lbuf buf, int j, const cpx* __restrict__ TW) {
    cpx v[16]; asm volatile("" : "+v"(j));
#pragma unroll
    for (int n = 0; n < 16; ++n) v[n] = buf[PI(n * 256 + j)];
    dft16<-1>(v);
#pragma unroll
    for (int k = 0; k < 16; ++k) buf[PI(k * 256 + j)] = k ? cmul(v[SL(k)], TW[(j * k) & 4095]) : v[SL(k)];
    __syncthreads(); asm volatile("" : "+v"(j));
    const int k1 = j >> 4, n3 = j & 15;
#pragma unroll
    for (int n = 0; n < 16; ++n) v[n] = buf[PI(k1 * 256 + n * 16 + n3)];
    dft16<-1>(v);
#pragma unroll
    for (int k = 0; k < 16; ++k) buf[PI(k1 * 256 + k * 16 + n3)] = k ? cmul(v[SL(k)], TW[(16 * n3 * k) & 4095]) : v[SL(k)];
    __syncthreads();
}
__device__ __forceinline__ void inv21(lbuf buf, int j, const cpx* __restrict__ TW) {
    cpx v[16]; asm volatile("" : "+v"(j));
    const int k1 = j >> 4, n3 = j & 15;
#pragma unroll
    for (int k = 0; k < 16; ++k) { const cpx x = buf[PI(k1 * 256 + k * 16 + n3)]; v[k] = k ? cmulc(x, TW[(16 * n3 * k) & 4095]) : x; }
    dft16<1>(v);
#pragma unroll
    for (int n = 0; n < 16; ++n) buf[PI(k1 * 256 + n * 16 + n3)] = v[SL(n)];
    __syncthreads(); asm volatile("" : "+v"(j));
#pragma unroll
    for (int k = 0; k < 16; ++k) { const cpx x = buf[PI(k * 256 + j)]; v[k] = k ? cmulc(x, TW[(j * k) & 4095]) : x; }
    dft16<1>(v);
#pragma unroll
    for (int n = 0; n < 16; ++n) buf[PI(n * 256 + j)] = v[SL(n)];
    __syncthreads();
}
template <int ORDER> __device__ __forceinline__ void conv_core(lbuf bufX, lbuf bufW, int e, int j, float scale, const cpx* __restrict__ TW) {
    lbuf bx = bufX + e * 4352; lbuf bw = bufW + e * 4352;
    fwd12(bx, j, TW);
    cpx v[16], u[16]; asm volatile("" : "+v"(j));
#pragma unroll
    for (int n = 0; n < 16; ++n) v[n] = bx[PI(j * 16 + n)];
    dft16<-1>(v);
    const int k1 = j >> 4, k2 = j & 15; const float hs = 0.5f * scale;
#pragma unroll
    for (int k3 = 0; k3 < 16; ++k3) { const int k = k1 + 16 * k2 + 256 * k3; const int kp = e ? 4095 - k : ((4096 - k) & 4095);
        const int posp = (kp & 15) * 256 + ((kp >> 4) & 15) * 16 + (kp >> 8);
        const cpx wf = bw[PI(j * 16 + k3)], wp = bw[PI(posp)];
        const cpx K = ORDER == 0 ? (cpx){(wf.x + wp.x) * hs, (wf.y - wp.y) * hs} : (cpx){(wf.y + wp.y) * hs, -(wf.x - wp.x) * hs};
        u[k3] = cmul(v[SL(k3)], K); }
    dft16<1>(u);
#pragma unroll
    for (int n = 0; n < 16; ++n) bx[PI(j * 16 + n)] = u[SL(n)];
    __syncthreads();
    inv21(bx, j, TW);
}
}

__device__ __forceinline__ void p14_hyena_conv(Frame& F) {
    using namespace hy;
    lbuf bufX = (lbuf)F.lds; lbuf bufW = (lbuf)(F.lds + 69632);
    LAS float* w3s = (LAS float*)(F.lds + 139264);
    LAS float* red = w3s + 260;
    const cpx* TW = (const cpx*)(F.ws + WS_TW); const cpx* TW8 = TW + 4096;
    const float* a2T = WSP(float, WS_A2T); const float* a2R = WSP(float, WS_A2R);
    const bf16* U = WSP(bf16, WS_U); bf16* ZT = WSP(bf16, WS_ZT);
    const float* w3 = arg_in(21); const float* b3 = arg_in(22); const float* cw = arg_in(15); const float* cb = arg_in(16); const float* skip = arg_in(24);
#pragma unroll 1
    for (int d = F.vcu; d < DM; d += F.G) {
        int t = F.tid; asm volatile("" : "+v"(t));
        const int e = t >> 8, j = t & 255, n0 = 8 * t;
        const int p0 = n0 + (t >> 1);
        __syncthreads();
        if (t < 64) {
#pragma unroll
            for (int q = 0; q < 4; ++q) w3s[t * 4 + q] = w3[(size_t)t * 8192 + q * 2048 + d]; }
        if (t >= 64 && t < 68) w3s[256 + (t - 64)] = b3[(t - 64) * 2048 + d];
        __syncthreads();
        {
            float f00[8], f10[8], f01[8], f11[8];
            const float bb00 = w3s[256], bb01 = w3s[257], bb10 = w3s[258], bb11 = w3s[259];
#pragma unroll
            for (int i = 0; i < 8; ++i) { f00[i] = bb00; f01[i] = bb01; f10[i] = bb10; f11[i] = bb11; }
#pragma unroll 4
            for (int jj = 0; jj < 64; ++jj) {
                const f32x4 wq = *(const LAS f32x4*)(w3s + jj * 4);
                const f32x4 fa = *(const f32x4*)(a2T + (size_t)jj * SEQ + n0), fb = *(const f32x4*)(a2T + (size_t)jj * SEQ + n0 + 4);
                const f32x4 ra = *(const f32x4*)(a2R + (size_t)jj * SEQ + n0), rb = *(const f32x4*)(a2R + (size_t)jj * SEQ + n0 + 4);
#pragma unroll
                for (int i = 0; i < 4; ++i) { f00[i] += fa[i] * wq[0]; f10[i] += fa[i] * wq[2]; f00[4 + i] += fb[i] * wq[0]; f10[4 + i] += fb[i] * wq[2];
                    f01[i] += ra[i] * wq[1]; f11[i] += ra[i] * wq[3]; f01[4 + i] += rb[i] * wq[1]; f11[4 + i] += rb[i] * wq[3]; }
            }
            const float adel = 3.0701134573253944f + (float)d * ((15.350567286626972f - 3.0701134573253944f) / 2047.0f);
            float ss0 = 0.f, ss1 = 0.f;
#pragma unroll
            for (int i = 0; i < 8; ++i) { const int n = n0 + i; const float df = __expf(-((float)n * (1.0f / 4096.0f)) * adel), db = __expf(-((float)(4096 - n) * (1.0f / 4096.0f)) * adel);
                const float a0 = f00[i] * df, a1 = f10[i] * df;
                const float c0 = n ? f01[i] * db : 0.f, c1 = n ? f11[i] * db : 0.f;
                ss0 += a0 * a0 + c0 * c0; ss1 += a1 * a1 + c1 * c1;
                bufW[p0 + i] = (cpx){a0 + c0, a1 + c1};
                bufW[4352 + p0 + i] = cmul((cpx){a0 - c0, a1 - c1}, TW8[n]); }
            ss0 = wave_sum(ss0); ss1 = wave_sum(ss1);
            if (F.lane == 0) { red[F.wave * 2] = ss0; red[F.wave * 2 + 1] = ss1; }
        }
        __syncthreads();
        float rs0 = 0.f, rs1 = 0.f;
#pragma unroll
        for (int w = 0; w < 8; ++w) { rs0 += red[w * 2]; rs1 += red[w * 2 + 1]; }
        rs0 = (1.0f / sqrtf(rs0 + EPS)) * (1.0f / 8192.0f); rs1 = (1.0f / sqrtf(rs1 + EPS)) * (1.0f / 8192.0f);
        { lbuf bw = bufW + e * 4352; fwd12(bw, j, TW); cpx v[16];
#pragma unroll
          for (int n = 0; n < 16; ++n) v[n] = bw[PI(j * 16 + n)];
          dft16<-1>(v);
#pragma unroll
          for (int k = 0; k < 16; ++k) bw[PI(j * 16 + k)] = v[SL(k)]; }
        cpx vv[8];
#define HY_LOAD(T, dst) do { const int ch = (T) * DM + d; const float w0 = cw[ch], w1 = cw[3 * DM + ch], w2 = cw[6 * DM + ch], bs = cb[ch]; \
        _Pragma("unroll") for (int b = 0; b < 2; ++b) { const bf16* pr = U + (size_t)ch * MX + b * SEQ + n0; const v4u m = *(const v4u*)pr; \
            const float lft = t > 0 ? bf1(pr[-1]) : 0.f, rgt = t < 511 ? bf1(pr[8]) : 0.f; \
            const float p[10] = {lft, bf_lo(m.x), bf_hi(m.x), bf_lo(m.y), bf_hi(m.y), bf_lo(m.z), bf_hi(m.z), bf_lo(m.w), bf_hi(m.w), rgt}; \
            _Pragma("unroll") for (int i = 0; i < 8; ++i) { const float uu = w0 * p[i] + w1 * p[i + 1] + w2 * p[i + 2] + bs; if (b == 0) dst[i].x = uu; else dst[i].y = uu; } } } while (0)
        HY_LOAD(0, vv);
        const float sk0 = skip[d], sk1 = skip[DM + d];
#pragma unroll
        for (int i = 0; i < 8; ++i) { bufX[p0 + i] = vv[i]; bufX[4352 + p0 + i] = cmul(vv[i], TW8[n0 + i]); }
        __syncthreads();
        conv_core<0>(bufX, bufW, e, j, rs0, TW);
        { cpx x1c[8]; HY_LOAD(1, x1c);
#pragma unroll
        for (int i = 0; i < 8; ++i) { const cpx ye = bufX[p0 + i], yo = bufX[4352 + p0 + i]; const cpx y = cadd(ye, cmulc(yo, TW8[n0 + i]));
            vv[i] = (cpx){x1c[i].x * (y.x + sk0 * vv[i].x), x1c[i].y * (y.y + sk0 * vv[i].y)};
            bufX[p0 + i] = vv[i]; bufX[4352 + p0 + i] = cmul(vv[i], TW8[n0 + i]); } }
        __syncthreads();
        conv_core<1>(bufX, bufW, e, j, rs1, TW);
        cpx x2c[8]; HY_LOAD(2, x2c);
        unsigned ob0[4], ob1[4];
#pragma unroll
        for (int i = 0; i < 8; i += 2) { float z0[2], z1[2];
#pragma unroll
            for (int q = 0; q < 2; ++q) { const cpx ye = bufX[p0 + i + q], yo = bufX[4352 + p0 + i + q]; const cpx y = cadd(ye, cmulc(yo, TW8[n0 + i + q]));
                z0[q] = x2c[i + q].x * (y.x + sk1 * vv[i + q].x); z1[q] = x2c[i + q].y * (y.y + sk1 * vv[i + q].y); }
            ob0[i >> 1] = pk2(z0[0], z0[1]); ob1[i >> 1] = pk2(z1[0], z1[1]); }
        *(v4u*)(ZT + (size_t)d * MX + n0) = (v4u){ob0[0], ob0[1], ob0[2], ob0[3]};
        *(v4u*)(ZT + (size_t)d * MX + SEQ + n0) = (v4u){ob1[0], ob1[1], ob1[2], ob1[3]};
    }
    __syncthreads();
}

#ifndef MK_SINGLE
#define MK_SINGLE 0
#endif
struct Args { const float* in[30]; float* out; unsigned char* ws; int ph_lo, ph_hi; };
__global__ void __launch_bounds__(NWAVES * 64, 2) mk_fwd(Args args) {
    extern __shared__ __attribute__((aligned(16))) unsigned char lds[];
    Frame F;
    F.lds = (LAS unsigned char*)lds; F.ldsg = lds;
    F.tid = threadIdx.x; F.lane = F.tid & 63; F.wave = __builtin_amdgcn_readfirstlane(F.tid >> 6);
    F.G = gridDim.x; { const int bx = blockIdx.x; F.vcu = (F.G % 8 == 0) ? (bx % 8) * (F.G / 8) + bx / 8 : bx; }
    F.out = args.out; F.ws = args.ws;
    volatile LAS unsigned* MISC = (volatile LAS unsigned*)(F.lds + MISC_OFF);
    if (F.tid < 32) MISC[F.tid] = 0u;
    __syncthreads();
    unsigned* ctl = (unsigned*)(F.ws + WS_CTL);
    XcdBarrier bar; bar.bar = ctl + CW_BAR; bar.x = 0; bar.st = nullptr;
    if (MK_SINGLE) bar = xcd_barrier_post(ctl + CW_BAR, MISC + 8);
    const int lo = args.ph_lo, hi = args.ph_hi;
#ifndef PH_MASK
#define PH_MASK 0x1fffff
#endif
#define IN(k) (((PH_MASK >> (k)) & 1) && lo <= (k) && (k) < hi)
#define SEAM(k) do { if (MK_SINGLE && IN(k) && IN((k) + 1)) xcd_barrier(bar); } while (0)
    using namespace pg8;
    const bf16_t* Hb = WSP(bf16_t, WS_H);
    float* mod = WSP(float, WS_MOD);

    if (IN(0)) { p0_prologue(F); } SEAM(0);
    if (IN(1)) { p1_norm0(F); } SEAM(1);
    if (IN(2)) {
        Gemm g{Hb, WSP(bf16_t, WS_WIN), MT, INPAD, DM}; StaticOrder S; S.init(MT, INPAD, F.G, (int)blockIdx.x);
        EpiF32Plain E{WSP(float, WS_PROJ), INPAD};
        gemm_phase<EpiF32Plain, StaticOrder, true, true>(F.lds, g, S, E);
    } SEAM(2);
    if (IN(3)) { p3_latent(F); } SEAM(3);
    if (IN(4)) {
        { Gemm g{WSP(bf16_t, WS_CQN), WSP(bf16_t, WS_WUQ), MT, QW, QRANK}; StaticOrder S; S.init(MT, QW, F.G, (int)blockIdx.x);
          EpiQRope E{WSP(bf16_t, WS_Q), WSP(float, WS_CS)};
          gemm_phase<EpiQRope, StaticOrder, true, true>(F.lds, g, S, E); }
        __syncthreads();
        { Gemm g{WSP(bf16_t, WS_CKVN), WSP(bf16_t, WS_WUKV), MT, KVW, KVRANK}; StaticOrder S; S.init(MT, KVW, F.G, (int)blockIdx.x);
          EpiBf16Plain E{WSP(bf16_t, WS_KV), KVW, 0x7fffffff};
          gemm_phase<EpiBf16Plain, StaticOrder, true, true>(F.lds, g, S, E); }
    } SEAM(4);
    if (IN(5)) { p6_attention(F); } SEAM(5);
    if (IN(6)) {
        Gemm g{WSP(bf16_t, WS_O), WSP(bf16_t, WS_WO), MX, DM, DM}; StaticOrder S; S.init(MX, DM, F.G, (int)blockIdx.x);
        EpiResid E{arg_in(0), WSP(float, WS_X1), mod + 2 * DM, 6 * DM};
        gemm_phase<EpiResid, StaticOrder, true, true>(F.lds, g, S, E);
    } SEAM(6);
#define MOE_PHASES(layer, pb) \
    if (IN(pb)) { p8_norm_router(F, layer); } SEAM(pb); \
    if (IN((pb) + 1)) { p9_select_gather(F); } SEAM((pb) + 1); \
    if (IN((pb) + 2)) {     \
        Gemm g{WSP(bf16_t, WS_XG), WSP(bf16_t, WS_WGU) + (size_t)(layer) * NE * 2048 * DM, MROWS, 2048, DM}; MoeOrder S{F.G, (int)blockIdx.x}; \
        EpiSwiGLU E{WSP(bf16_t, WS_ACT)}; \
        gemm_phase<EpiSwiGLU, MoeOrder, true, true>(F.lds, g, S, E); \
    } SEAM((pb) + 2); \
    if (IN((pb) + 3)) {     \
        Gemm g{WSP(bf16_t, WS_ACT), WSP(bf16_t, WS_WD) + (size_t)(layer) * NE * 2048 * FFD, MROWS, 2048, FFD}; MoeOrder S{F.G, (int)blockIdx.x}; \
        EpiBf16Plain E{WSP(bf16_t, WS_Y), DM, 7}; \
        gemm_phase<EpiBf16Plain, MoeOrder, true, true>(F.lds, g, S, E); \
    } SEAM((pb) + 3);
    MOE_PHASES(0, 7)
    if (IN(11)) { p12_combine_norm<false>(F, 0); } SEAM(11);
    if (IN(12)) {
        Gemm g{WSP(bf16_t, WS_HYWIN), Hb, 3 * DM, MX, DM}; StaticOrder S; S.init(3 * DM, MX, F.G, (int)blockIdx.x);
        EpiBf16Plain E{WSP(bf16_t, WS_U), MX, 0x7fffffff};
        gemm_phase<EpiBf16Plain, StaticOrder, true, true>(F.lds, g, S, E);
    } SEAM(12);
    if (IN(13)) { p14_hyena_conv(F); } SEAM(13);
    if (IN(14)) { p15_transpose(F); } SEAM(14);
    if (IN(15)) {
        Gemm g{WSP(bf16_t, WS_Z), WSP(bf16_t, WS_HYWOUT), MX, DM, DM}; StaticOrder S; S.init(MX, DM, F.G, (int)blockIdx.x);
        EpiResid E{WSP(float, WS_X1), WSP(float, WS_X1), mod + 3 * 6 * DM + 2 * DM, 6 * DM};
        gemm_phase<EpiResid, StaticOrder, true, true>(F.lds, g, S, E);
    } SEAM(15);
    MOE_PHASES(1, 16)
    if (IN(20)) { p12_combine_norm<true>(F, 1); }
#undef MOE_PHASES
#undef IN
#undef SEAM
}

extern "C" void kernel_launch(void* const* d_in, const int* in_sizes, int n_in, void* d_out, int out_size, void* d_ws, size_t ws_size, hipStream_t stream) {
    static int grid = 0;
    if (grid == 0) {
        if (n_in != 30 || out_size != MX * DM || ws_size < WS_END) { fprintf(stderr, "kernel_launch: shape/workspace mismatch: n_in %d out %d ws %zu (need %zu)\n", n_in, out_size, ws_size, (size_t)WS_END); grid = -1; return; }
        int dev = 0, cus = 0, per_cu = 0;
        if (hipGetDevice(&dev) != hipSuccess || hipDeviceGetAttribute(&cus, hipDeviceAttributeMultiprocessorCount, dev) != hipSuccess) { grid = -1; return; }
        if (hipFuncSetAttribute((const void*)mk_fwd, hipFuncAttributeMaxDynamicSharedMemorySize, LDS_BYTES) != hipSuccess) { fprintf(stderr, "kernel_launch: hipFuncSetAttribute failed\n"); grid = -1; return; }
        if (hipOccupancyMaxActiveBlocksPerMultiprocessor(&per_cu, (const void*)mk_fwd, NWAVES * 64, LDS_BYTES) != hipSuccess || per_cu < 1) { fprintf(stderr, "kernel_launch: occupancy query says %d blocks per CU\n", per_cu); }
        (void)hipGetLastError();
        grid = cus;
    }
    if (grid < 0) return;
    if (hipMemsetAsync((char*)d_ws + WS_CTL, 0, CTL_ZERO_BYTES, stream) != hipSuccess) return;
    Args a{};
    for (int i = 0; i < 30; ++i) a.in[i] = (const float*)d_in[i];
    a.out = (float*)d_out; a.ws = (unsigned char*)d_ws;
#if MK_SINGLE
    a.ph_lo = 0; a.ph_hi = NPHASE;
    hipLaunchKernelGGL(mk_fwd, dim3(grid), dim3(NWAVES * 64), LDS_BYTES, stream, a);
#else
    for (int p = 0; p < NPHASE; ++p) { a.ph_lo = p; a.ph_hi = p + 1; hipLaunchKernelGGL(mk_fwd, dim3(grid), dim3(NWAVES * 64), LDS_BYTES, stream, a); }
#endif
    const hipError_t le = hipPeekAtLastError();
    if (le != hipSuccess) fprintf(stderr, "kernel_launch: launch failed: %s\n", hipGetErrorName(le));
}
```

```cpp
#include <hip/hip_runtime.h>
#include <cstdio>
#include <cstdint>
namespace pg8 {
#define PG8_LAS __attribute__((address_space(3)))
typedef unsigned short bf16_t;
typedef short bf16x8 __attribute__((ext_vector_type(8)));
typedef float f32x4 __attribute__((ext_vector_type(4)));
typedef unsigned u32x4 __attribute__((ext_vector_type(4)));
constexpr int BM = 256, BK = 64, HALF = 128, HTB = HALF * BK * 2  , STAGE_BYTES = 8 * HTB, NXCD = 8, WGM = 8;

__host__ __device__ __forceinline__ int lds_byte(int r, int c) { const int st = (r >> 4) * 2 + (c >> 5), rr = r & 15, cc = c & 31, ob = rr * 64 + cc * 2; return st * 1024 + (ob ^ (((ob >> 9) & 1) << 5)); }
__host__ __device__ __forceinline__ void stage_rc(int b, int& R, int& C) { const int st = b / 1024, sb = b % 1024, swz = sb ^ (((sb >> 9) & 1) << 5); R = (st >> 1) * 16 + swz / 64; C = (st & 1) * 32 + (swz % 64) / 2; }
__host__ __device__ __forceinline__ int perm32(int rho) { const int n = rho >> 4, i = rho & 15; return 8 * (i >> 2) + 4 * n + (i & 3); }

struct Unit { int pm, pn; };
struct Gemm { const bf16_t* A; const bf16_t* Bt; int M, N, K; };

struct StaticOrder {
    int nM, nN, nwg, G, c;
    __host__ __device__ void init(int M, int N, int G_, int c_) { nM = M / BM; nN = N / BM; nwg = nM * nN; G = G_; c = c_; }
    __host__ __device__ bool next(int i, Unit& u) const {
        const long L = (long)i * G + c; if (L >= nwg) return false;
        int wgid = (int)L; { const int q = nwg / NXCD, r = nwg % NXCD, xcd = wgid % NXCD, off = wgid / NXCD; wgid = (xcd < r ? xcd * (q + 1) : r * (q + 1) + (xcd - r) * q) + off; }
        const int nig = WGM * nN, gid = wgid / nig, fm = gid * WGM, gsz = (nM - fm) < WGM ? (nM - fm) : WGM;
        u.pm = fm + ((wgid % nig) % gsz); u.pn = (wgid % nig) / gsz; return true;
    }
    __device__ __forceinline__ void a_ready(const Unit&) const {}
    __device__ __forceinline__ void done(const Unit&) const {}
};

__device__ __forceinline__ unsigned cvt_pk_bf16(float lo, float hi) { unsigned r; asm volatile("v_cvt_pk_bf16_f32 %0, %1, %2" : "=v"(r) : "v"(lo), "v"(hi)); return r; }
typedef float f32x2 __attribute__((ext_vector_type(2)));
struct EpiF32Plain {
    static constexpr bool PERM = false, AFTER_DRAIN = false;
    float* C; int ldc; int pn_mask;
    __device__ __forceinline__ void operator()(const f32x4 (&acc)[2][2][4][2], const Unit& u, int wr, int wc, int fr, int fq) const {
        const int row0 = u.pm * BM + wr * 64 + fr, col0 = (u.pn & pn_mask) * BM + wc * 32 + 4 * fq;
#pragma unroll
        for (int ai = 0; ai < 2; ++ai)
#pragma unroll
            for (int m = 0; m < 4; ++m) { float* rowp = C + (size_t)(row0 + ai * HALF + m * 16) * ldc + col0;
#pragma unroll
                for (int bj = 0; bj < 2; ++bj)
#pragma unroll
                    for (int n = 0; n < 2; ++n) *(f32x4*)(rowp + bj * HALF + n * 16) = acc[ai][bj][m][n]; }
    }
};
struct EpiBf16Plain {
    static constexpr bool PERM = true, AFTER_DRAIN = false;
    bf16_t* O; int ldc; int pn_mask;
    __device__ __forceinline__ void operator()(const f32x4 (&acc)[2][2][4][2], const Unit& u, int wr, int wc, int fr, int fq) const {
        const int row0 = u.pm * BM + wr * 64 + fr, col0 = (u.pn & pn_mask) * BM + wc * 32 + 8 * fq;
#pragma unroll
        for (int ai = 0; ai < 2; ++ai)
#pragma unroll
            for (int m = 0; m < 4; ++m) { bf16_t* rowp = O + (size_t)(row0 + ai * HALF + m * 16) * ldc + col0;
#pragma unroll
                for (int bj = 0; bj < 2; ++bj) { const f32x4 v0 = acc[ai][bj][m][0], v1 = acc[ai][bj][m][1];
                    u32x4 w; w.x = cvt_pk_bf16(v0[0], v0[1]); w.y = cvt_pk_bf16(v0[2], v0[3]); w.z = cvt_pk_bf16(v1[0], v1[1]); w.w = cvt_pk_bf16(v1[2], v1[3]);
                    *(u32x4*)(rowp + bj * HALF) = w; } }
    }
};
struct EpiQRope {
    static constexpr bool PERM = true, AFTER_DRAIN = false;
    bf16_t* O; const float* cs;
    __device__ __forceinline__ void operator()(const f32x4 (&acc)[2][2][4][2], const Unit& u, int wr, int wc, int fr, int fq) const {
        const int row0 = u.pm * BM + wr * 64 + fr;
#pragma unroll
        for (int ai = 0; ai < 2; ++ai)
#pragma unroll
            for (int m = 0; m < 4; ++m) { const int row = row0 + ai * HALF + m * 16; const int bb = row >= 4352 ? 1 : 0; const int l = row - bb * 4352; const bool lat = l < 4096; const int lp = lat ? l : 0;
#pragma unroll
                for (int bj = 0; bj < 2; ++bj) { const int c0 = u.pn * BM + bj * HALF + wc * 32 + 8 * fq; const int hh = c0 / 192, jj = c0 - hh * 192;
                    f32x4 v0 = acc[ai][bj][m][0], v1 = acc[ai][bj][m][1];
                    if (jj >= 128 && lat) { const f32x4* cp = (const f32x4*)(cs + ((size_t)lp * 32 + ((jj - 128) >> 1)) * 2); const f32x4 ca = cp[0], cb = cp[1];
                        const f32x4 a = v0, b = v1;
                        v0[0] = a[0] * ca[0] - a[1] * ca[1]; v0[1] = a[1] * ca[0] + a[0] * ca[1]; v0[2] = a[2] * ca[2] - a[3] * ca[3]; v0[3] = a[3] * ca[2] + a[2] * ca[3];
                        v1[0] = b[0] * cb[0] - b[1] * cb[1]; v1[1] = b[1] * cb[0] + b[0] * cb[1]; v1[2] = b[2] * cb[2] - b[3] * cb[3]; v1[3] = b[3] * cb[2] + b[2] * cb[3]; }
                    u32x4 w; w.x = cvt_pk_bf16(v0[0], v0[1]); w.y = cvt_pk_bf16(v0[2], v0[3]); w.z = cvt_pk_bf16(v1[0], v1[1]); w.w = cvt_pk_bf16(v1[2], v1[3]);
                    *(u32x4*)(O + (size_t)row * 3072 + c0) = w; } }
    }
};
struct EpiResid {
    static constexpr bool PERM = false, AFTER_DRAIN = false;
    const float* base; float* out; const float* gate; int gstride;
    __device__ __forceinline__ void operator()(const f32x4 (&acc)[2][2][4][2], const Unit& u, int wr, int wc, int fr, int fq) const {
        const int row0 = u.pm * BM + wr * 64 + fr, col0 = u.pn * BM + wc * 32 + 4 * fq; const float* gp = gate + (size_t)(u.pm >> 4) * gstride + col0;
        f32x4 gv[2][2];
#pragma unroll
        for (int bj = 0; bj < 2; ++bj)
#pragma unroll
            for (int n = 0; n < 2; ++n) gv[bj][n] = *(const f32x4*)(gp + bj * HALF + n * 16);
#pragma unroll
        for (int ai = 0; ai < 2; ++ai)
#pragma unroll
            for (int m = 0; m < 4; ++m) { const size_t off = (size_t)(row0 + ai * HALF + m * 16) * 2048 + col0;
#pragma unroll
                for (int bj = 0; bj < 2; ++bj)
#pragma unroll
                    for (int n = 0; n < 2; ++n) { const f32x4 bs = *(const f32x4*)(base + off + bj * HALF + n * 16); *(f32x4*)(out + off + bj * HALF + n * 16) = bs + gv[bj][n] * acc[ai][bj][m][n]; }
                asm volatile("" ::: "memory"); }
    }
};
struct EpiSwiGLU {
    static constexpr bool PERM = true, AFTER_DRAIN = false;
    bf16_t* O;
    __device__ __forceinline__ float silu(float g) const { return g * __builtin_amdgcn_rcpf(1.0f + __builtin_amdgcn_exp2f(-1.4426950408889634f * g)); }
    __device__ __forceinline__ void operator()(const f32x4 (&acc)[2][2][4][2], const Unit& u, int wr, int wc, int fr, int fq) const {
        const int row0 = u.pm * BM + wr * 64 + fr, col0 = (u.pn & 7) * 128 + wc * 32 + 8 * fq;
#pragma unroll
        for (int ai = 0; ai < 2; ++ai)
#pragma unroll
            for (int m = 0; m < 4; ++m) { const f32x4 g0 = acc[ai][0][m][0], g1 = acc[ai][0][m][1], u0 = acc[ai][1][m][0], u1 = acc[ai][1][m][1];
                u32x4 w; w.x = cvt_pk_bf16(silu(g0[0]) * u0[0], silu(g0[1]) * u0[1]); w.y = cvt_pk_bf16(silu(g0[2]) * u0[2], silu(g0[3]) * u0[3]);
                w.z = cvt_pk_bf16(silu(g1[0]) * u1[0], silu(g1[1]) * u1[1]); w.w = cvt_pk_bf16(silu(g1[2]) * u1[2], silu(g1[3]) * u1[3]);
                *(u32x4*)(O + (size_t)(row0 + ai * HALF + m * 16) * 1024 + col0) = w; }
    }
};
struct HfOrder {
    int G, c, skip;
    __device__ __forceinline__ bool next(int i, Unit& u) const {
        int L;
        if (G > skip + 8) { if (c < skip) return false; L = (c - skip) + i * (G - skip); } else L = i * G + c;
        if (L >= 512) return false;
        const int dir = L >> 8, w = L & 255; u.pm = dir * 16 + (w & 15); u.pn = dir * 16 + (w >> 4); return true;
    }
    __device__ __forceinline__ void a_ready(const Unit&) const {}
    __device__ __forceinline__ void done(const Unit&) const {}
};
struct MoeOrder {
    int G, c;
    __device__ __forceinline__ bool next(int i, Unit& u) const {
        int e, j;
        if (G == 256) { if (i >= 2) return false; e = i * 8 + (c & 7); j = c >> 3; }
        else { const int L = i * G + c; if (L >= 512) return false; e = L >> 5; j = L & 31; }
        u.pm = e * 4 + (j & 3); u.pn = e * 8 + (j >> 2); return true;
    }
    __device__ __forceinline__ void a_ready(const Unit&) const {}
    __device__ __forceinline__ void done(const Unit&) const {}
};

template <class Epi, class Sched, bool ALIGN_EPI = false, bool SP2 = false>
__device__ __forceinline__ void gemm_phase(PG8_LAS unsigned char* lds, const Gemm g, const Sched& S, const Epi& E) {
    const int tid = threadIdx.x, wid = __builtin_amdgcn_readfirstlane(tid >> 6), lane = tid & 63, wr = wid >> 2, wc = wid & 3, fr = lane & 15, fq = lane >> 4;
    const int K = g.K, nt = K / BK;
    unsigned voffA[2], voffB[2];
#pragma unroll
    for (int i = 0; i < 2; ++i) { int R, C; stage_rc(tid * 16 + i * 8192, R, C); const int Rb = Epi::PERM ? ((R & ~31) + perm32(R & 31)) : R;
        voffA[i] = (unsigned)(R * K + C) * 2u; voffB[i] = (unsigned)(Rb * K + C) * 2u; }
    const size_t kstep = (size_t)(BK * 2);
    const size_t hstep = (size_t)HALF * K * 2;
    const size_t tstep = 2 * hstep;
    const unsigned ldsw = (unsigned)wid * 1024u;
    const int aoff = lds_byte(wr * 64 + fr, fq * 8), boff = lds_byte(wc * 32 + fr, fq * 8);
#define PG8_SA(b, h) (((b) * 2 + (h)) * HTB)
#define PG8_SB(b, h) ((4 + (b) * 2 + (h)) * HTB)
#define PG8_STAGE(bufoff, gbase, voff) do { _Pragma("unroll") for (int _i = 0; _i < 2; ++_i) \
        __builtin_amdgcn_global_load_lds((const unsigned*)((const char*)(gbase) + (voff)[_i]), (PG8_LAS unsigned*)(lds + (bufoff) + ldsw + _i * 8192), 16, 0, 0); } while (0)
#define PG8_LDA(dst, b, h) do { _Pragma("unroll") for (int m = 0; m < 4; ++m) _Pragma("unroll") for (int k = 0; k < 2; ++k) dst[m][k] = *(const PG8_LAS bf16x8*)(lds + PG8_SA(b, h) + aoff + m * 2048 + k * 1024); } while (0)
#define PG8_LDB(dst, b, h) do { _Pragma("unroll") for (int n = 0; n < 2; ++n) _Pragma("unroll") for (int k = 0; k < 2; ++k) dst[n][k] = *(const PG8_LAS bf16x8*)(lds + PG8_SB(b, h) + boff + n * 2048 + k * 1024); } while (0)
#define PG8_MMA(ai, bj, At, Bt) do { __builtin_amdgcn_s_setprio(1); _Pragma("unroll") for (int m = 0; m < 4; ++m) _Pragma("unroll") for (int n = 0; n < 2; ++n) _Pragma("unroll") for (int k = 0; k < 2; ++k) \
        acc[ai][bj][m][n] = __builtin_amdgcn_mfma_f32_16x16x32_bf16(Bt[n][k], At[m][k], acc[ai][bj][m][n], 0, 0, 0); __builtin_amdgcn_s_setprio(0); } while (0)
#define PG8_WAIT_V(n) asm volatile("s_waitcnt vmcnt(" #n ")" ::: "memory")
#define PG8_WAIT_L(n) asm volatile("s_waitcnt lgkmcnt(" #n ")" ::: "memory")
#define PG8_BAR __builtin_amdgcn_s_barrier()
#define PG8_SCHED __builtin_amdgcn_sched_barrier(0)
    Unit cur, nxt; int ui = 0;
    if (!S.next(0, cur)) return;
    f32x4 acc[2][2][4][2];
#pragma unroll
    for (int a = 0; a < 2; ++a)
#pragma unroll
        for (int b = 0; b < 2; ++b)
#pragma unroll
            for (int m = 0; m < 4; ++m)
#pragma unroll
                for (int n = 0; n < 2; ++n) acc[a][b][m][n] = (f32x4){0.f, 0.f, 0.f, 0.f};
    bf16x8 At[4][2], B0[2][2], B1[2][2];
    const char* cA = (const char*)g.A + (size_t)cur.pm * tstep; const char* cB = (const char*)g.Bt + (size_t)cur.pn * tstep;
    S.a_ready(cur);
    if constexpr (SP2) {
        PG8_STAGE(PG8_SB(0, 0), cB, voffB); PG8_STAGE(PG8_SB(0, 1), cB + hstep, voffB); PG8_STAGE(PG8_SA(0, 0), cA, voffA); PG8_STAGE(PG8_SA(0, 1), cA + hstep, voffA);
        if (wr == 1) PG8_BAR;
        PG8_WAIT_V(2); PG8_BAR;
        PG8_STAGE(PG8_SB(1, 0), cB + kstep, voffB); PG8_STAGE(PG8_SA(1, 0), cA + kstep, voffA); PG8_STAGE(PG8_SB(1, 1), cB + hstep + kstep, voffB);
        PG8_WAIT_V(6); PG8_BAR;
    } else {
        PG8_STAGE(PG8_SB(0, 0), cB, voffB); PG8_STAGE(PG8_SA(0, 0), cA, voffA); PG8_STAGE(PG8_SB(0, 1), cB + hstep, voffB); PG8_STAGE(PG8_SA(0, 1), cA + hstep, voffA);
        if (wr == 1) PG8_BAR;
        PG8_WAIT_V(4); PG8_BAR;
        PG8_STAGE(PG8_SB(1, 0), cB + kstep, voffB); PG8_STAGE(PG8_SA(1, 0), cA + kstep, voffA); PG8_STAGE(PG8_SB(1, 1), cB + hstep + kstep, voffB);
        PG8_WAIT_V(6); PG8_BAR;
    }
    for (;;) {
        const bool has_next = S.next(ui + 1, nxt);
        const char* nA = has_next ? (const char*)g.A + (size_t)nxt.pm * tstep : cA; const char* nB = has_next ? (const char*)g.Bt + (size_t)nxt.pn * tstep : cB;
        for (int t = 0; t < nt; t += 2) {
            const bool last = (t == nt - 2);
            const char* a1 = cA + (size_t)(t + 1) * kstep;
            const char* a2 = last ? nA : cA + (size_t)(t + 2) * kstep; const char* b2 = last ? nB : cB + (size_t)(t + 2) * kstep;
            const char* a3 = a2 + kstep; const char* b3 = b2 + kstep;
            if (last && has_next) S.a_ready(nxt);
            if constexpr (SP2) {
            PG8_LDB(B0, 0, 0); PG8_LDB(B1, 0, 1); PG8_SCHED; PG8_LDA(At, 0, 0); PG8_STAGE(PG8_SA(1, 1), a1 + hstep, voffA);
            PG8_WAIT_V(8); PG8_WAIT_L(0); PG8_BAR; PG8_MMA(0, 0, At, B0); PG8_MMA(0, 1, At, B1); PG8_BAR; PG8_SCHED;
            PG8_LDA(At, 0, 1); PG8_STAGE(PG8_SB(0, 0), b2, voffB); PG8_STAGE(PG8_SB(0, 1), b2 + hstep, voffB); PG8_STAGE(PG8_SA(0, 0), a2, voffA);
            PG8_WAIT_V(8); PG8_WAIT_L(0); PG8_BAR; PG8_MMA(1, 0, At, B0); PG8_MMA(1, 1, At, B1); PG8_BAR; PG8_SCHED;
            PG8_LDB(B0, 1, 0); PG8_LDB(B1, 1, 1); PG8_SCHED; PG8_LDA(At, 1, 0); PG8_STAGE(PG8_SA(0, 1), a2 + hstep, voffA);
            PG8_WAIT_V(8); PG8_WAIT_L(0); PG8_BAR; PG8_MMA(0, 0, At, B0); PG8_MMA(0, 1, At, B1); PG8_BAR; PG8_SCHED;
            PG8_LDA(At, 1, 1); PG8_STAGE(PG8_SB(1, 0), b3, voffB); PG8_STAGE(PG8_SB(1, 1), b3 + hstep, voffB); PG8_STAGE(PG8_SA(1, 0), a3, voffA);
            PG8_WAIT_V(8); PG8_WAIT_L(0); PG8_BAR; PG8_MMA(1, 0, At, B0); PG8_MMA(1, 1, At, B1); PG8_BAR; PG8_SCHED;
            } else {
            PG8_LDB(B0, 0, 0); PG8_SCHED; PG8_LDA(At, 0, 0); PG8_STAGE(PG8_SA(1, 1), a1 + hstep, voffA);
            PG8_WAIT_L(8); PG8_BAR; PG8_WAIT_L(0); PG8_MMA(0, 0, At, B0); PG8_BAR; PG8_SCHED;
            PG8_LDB(B1, 0, 1); PG8_STAGE(PG8_SB(0, 0), b2, voffB);
            PG8_BAR; PG8_WAIT_L(0); PG8_MMA(0, 1, At, B1); PG8_BAR;
            PG8_LDA(At, 0, 1); PG8_STAGE(PG8_SA(0, 0), a2, voffA);
            PG8_BAR; PG8_WAIT_L(0); PG8_MMA(1, 0, At, B0); PG8_BAR; PG8_SCHED;
            PG8_STAGE(PG8_SB(0, 1), b2 + hstep, voffB);
            PG8_WAIT_V(6); PG8_BAR; PG8_MMA(1, 1, At, B1); PG8_BAR;
            PG8_LDB(B0, 1, 0); PG8_SCHED; PG8_LDA(At, 1, 0); PG8_STAGE(PG8_SA(0, 1), a2 + hstep, voffA);
            PG8_WAIT_L(8); PG8_BAR; PG8_WAIT_L(0); PG8_MMA(0, 0, At, B0); PG8_BAR; PG8_SCHED;
            PG8_LDB(B1, 1, 1); PG8_STAGE(PG8_SB(1, 0), b3, voffB);
            PG8_BAR; PG8_WAIT_L(0); PG8_MMA(0, 1, At, B1); PG8_BAR;
            PG8_LDA(At, 1, 1); PG8_STAGE(PG8_SA(1, 0), a3, voffA);
            PG8_BAR; PG8_WAIT_L(0); PG8_MMA(1, 0, At, B0); PG8_BAR; PG8_SCHED;
            PG8_STAGE(PG8_SB(1, 1), b3 + hstep, voffB);
            PG8_WAIT_V(6); PG8_BAR; PG8_MMA(1, 1, At, B1); PG8_BAR;
            }
        }
        if constexpr (ALIGN_EPI) { if (wr == 0) PG8_BAR; }
        if constexpr (!Epi::AFTER_DRAIN) { E(acc, cur, wr, wc, fr, fq); S.done(cur); }
        if (!has_next) break;
#pragma unroll
        for (int a = 0; a < 2; ++a)
#pragma unroll
            for (int b = 0; b < 2; ++b)
#pragma unroll
                for (int m = 0; m < 4; ++m)
#pragma unroll
                    for (int n = 0; n < 2; ++n) acc[a][b][m][n] = (f32x4){0.f, 0.f, 0.f, 0.f};
        cur = nxt; cA = nA; cB = nB; ++ui;
        if constexpr (ALIGN_EPI) { if (wr == 1) PG8_BAR; }
    }
    PG8_WAIT_V(0);
    if constexpr (!ALIGN_EPI) { if (wr == 0) PG8_BAR; }
    PG8_BAR;
    if constexpr (Epi::AFTER_DRAIN) { E.fused(acc, cur, wr, wc, fr, fq, lds, wid, lane); S.done(cur); }
#undef PG8_SA
#undef PG8_SB
#undef PG8_STAGE
#undef PG8_LDA
#undef PG8_LDB
#undef PG8_MMA
#undef PG8_WAIT_V
#undef PG8_WAIT_L
#undef PG8_BAR
#undef PG8_SCHED
}
}
#define GAS __attribute__((address_space(1)))
#define LAS __attribute__((address_space(3)))
typedef unsigned short bf16;
typedef unsigned v4u __attribute__((ext_vector_type(4)));
typedef unsigned v2u __attribute__((ext_vector_type(2)));
typedef float f32x4 __attribute__((ext_vector_type(4)));
typedef float f32x2 __attribute__((ext_vector_type(2)));
typedef float f32x16 __attribute__((ext_vector_type(16)));
typedef short bf16x8 __attribute__((ext_vector_type(8)));
typedef short s16x4 __attribute__((ext_vector_type(4)));
typedef GAS unsigned gu32;
#define RLX_AGENT __ATOMIC_RELAXED, __HIP_MEMORY_SCOPE_AGENT
#define LDS_WAIT() asm volatile("s_waitcnt lgkmcnt(0)" ::: "memory")
#define VM_WAIT() asm volatile("s_waitcnt vmcnt(0)" ::: "memory")
__device__ __forceinline__ unsigned pk2(float lo, float hi) { unsigned r; asm volatile("v_cvt_pk_bf16_f32 %0, %1, %2" : "=v"(r) : "v"(lo), "v"(hi)); return r; }
__device__ __forceinline__ float bf_lo(unsigned w) { return __uint_as_float(w << 16); }
__device__ __forceinline__ float bf_hi(unsigned w) { return __uint_as_float(w & 0xffff0000u); }
__device__ __forceinline__ float bf1(bf16 h) { return __uint_as_float(((unsigned)h) << 16); }
__device__ __forceinline__ int opq(int x) { asm volatile("" : "+v"(x)); return x; }
__device__ __forceinline__ float wave_sum(float v) {
#pragma unroll
    for (int o = 1; o < 64; o <<= 1) v += __shfl_xor(v, o);
    return v;
}
__device__ __forceinline__ int wave_sum_i(int v) {
#pragma unroll
    for (int o = 1; o < 64; o <<= 1) v += __shfl_xor(v, o);
    return v;
}

#define XB_TMO      128
#define XB_XCNT(j)  (256  + 64 * (j))
#define XB_XSUB(j)  (1280 + 64 * (j))
#define XB_XGEN(j)  (2304 + 64 * (j))
#define XB_TOP      3328
#define XB_TOPGEN   3392
#define XCD_BAR_WORDS 3456
#define XB_SPIN_CAP (1u << 18)

__device__ __forceinline__ unsigned xb_ld(unsigned* p)              { return __hip_atomic_load(p, __ATOMIC_RELAXED, __HIP_MEMORY_SCOPE_AGENT); }
__device__ __forceinline__ unsigned xb_add(unsigned* p, unsigned v) { return __hip_atomic_fetch_add(p, v, __ATOMIC_RELAXED, __HIP_MEMORY_SCOPE_AGENT); }
__device__ __forceinline__ unsigned xb_xcc_id() { return (unsigned)__builtin_amdgcn_s_getreg((3 << 11) | 20) & 0xFu; }
#define XB_SPIN(cond, bar) do { unsigned _sp = 0; while (cond) { __builtin_amdgcn_s_sleep(1); \
    if ((++_sp & 255u) == 0u) { if (xb_ld(&(bar)[XB_TMO])) break; if (_sp > XB_SPIN_CAP) { atomicAdd(&(bar)[XB_TMO], 1u); break; } } } } while (0)

struct XcdBarrier {
    unsigned* bar; unsigned x;
    volatile LAS unsigned* st;
};

__device__ __forceinline__ XcdBarrier xcd_barrier_post(unsigned* bar, volatile LAS unsigned* st) {
    XcdBarrier b; b.bar = bar; b.x = xb_xcc_id(); b.st = st;
    if (threadIdx.x == 0) (void)xb_add(&bar[XB_XCNT(b.x)], 1u);
    return b;
}
__device__ __forceinline__ void xcd_barrier_complete(unsigned* bar, unsigned x, unsigned& nloc, unsigned& nx) {
    const unsigned G = gridDim.x * gridDim.y * gridDim.z;
    unsigned sum, cnt, mine, sp = 0u;
    for (;;) {
        sum = 0u; cnt = 0u; mine = 0u;
#pragma unroll
        for (unsigned j = 0; j < 16; ++j) { const unsigned c = xb_ld(&bar[XB_XCNT(j)]); sum += c; cnt += (c > 0u) ? 1u : 0u; mine = (j == x) ? c : mine; }
        if (sum == G) break;
        __builtin_amdgcn_s_sleep(1);
        if ((++sp & 255u) == 0u) { if (xb_ld(&bar[XB_TMO])) break; if (sp > XB_SPIN_CAP) { atomicAdd(&bar[XB_TMO], 1u); break; } }
    }
    nloc = mine > 0u ? mine : 1u; nx = cnt > 0u ? cnt : 1u;
}

__device__ __forceinline__ void xcd_barrier(const XcdBarrier& b) {
    asm volatile("s_waitcnt vmcnt(0)" ::: "memory");
    __syncthreads();
    if (threadIdx.x == 0) {
        unsigned* bar = b.bar;
        __builtin_amdgcn_s_waitcnt(0);
        unsigned nloc = b.st[0], nx = b.st[1];
        if (nloc == 0u) { xcd_barrier_complete(bar, b.x, nloc, nx); b.st[0] = nloc; b.st[1] = nx; }
        const unsigned old = xb_add(&bar[XB_XSUB(b.x)], 1u);
        const unsigned gen = old / nloc;
        if (old + 1u == (gen + 1u) * nloc) {
            __builtin_amdgcn_fence(__ATOMIC_RELEASE, "agent");
            asm volatile("s_waitcnt vmcnt(0)" ::: "memory");
            const unsigned og = xb_add(&bar[XB_TOP], 1u);
            const unsigned tg = og / nx;
            if (og + 1u == (tg + 1u) * nx) xb_add(&bar[XB_TOPGEN], 1u);
            else XB_SPIN(xb_ld(&bar[XB_TOPGEN]) == tg, bar);
            __builtin_amdgcn_fence(__ATOMIC_ACQUIRE, "agent");
            xb_add(&bar[XB_XGEN(b.x)], 1u);
            asm volatile("s_waitcnt vmcnt(0)" ::: "memory");
        } else {
            XB_SPIN(xb_ld(&bar[XB_XGEN(b.x)]) == gen, bar);
            __builtin_amdgcn_fence(__ATOMIC_ACQUIRE, "agent");
            asm volatile("s_waitcnt vmcnt(0)" ::: "memory");
        }
    }
    __syncthreads();
}

constexpr int NWAVES = 8;
constexpr int DM = 2048, NB = 2, SEQ = 4096, CTXL = 256, LT = SEQ + CTXL  , MT = NB * LT  , MX = NB * SEQ  ;
constexpr int NH = 16, QRANK = 512, KVRANK = 256, INDIM = 832, INPAD = 1024, QW = NH * 192  , KVW = NH * 256  ;
constexpr int NE = 16, CAP = 512, FFD = 1024, MROWS = NB * NE * CAP  ;
constexpr float EPS = 1e-6f;
constexpr size_t MiB = 1u << 20;
constexpr size_t WS_CTL = 0, CTL_ZERO_BYTES = 1 * MiB;
constexpr size_t WS_MOD = 64 * 1024;
constexpr size_t WS_CS = 1 * MiB, WS_A2S = 2 * MiB  , WS_A2RS = 4 * MiB  , WS_W3S = 58 * MiB  , WS_TW = 6 * MiB  , WS_AFF = 7 * MiB  , WS_TOK = 7 * MiB + 512 * 1024  ;
constexpr size_t WS_WIN = 8 * MiB, WS_WUQ = 12 * MiB, WS_WUKV = 15 * MiB, WS_WO = 17 * MiB, WS_HYWOUT = 25 * MiB, WS_HYWIN = 33 * MiB;
constexpr size_t WS_WGU = 64 * MiB  , WS_WD = 320 * MiB  ;
constexpr size_t WS_H = 448 * MiB  , WS_PROJ = 482 * MiB  , WS_CQN = 516 * MiB, WS_CKVN = 525 * MiB, WS_KROPE = 530 * MiB;
constexpr size_t WS_Q = 532 * MiB, WS_KV = 583 * MiB, WS_O = 651 * MiB, WS_X1 = 683 * MiB  , WS_XG = 747 * MiB, WS_ACT = 811 * MiB, WS_Y = 843 * MiB, WS_HF = 907 * MiB  , WS_END = 1035 * MiB;
constexpr size_t WS_U = 532 * MiB  , WS_ZT = 628 * MiB  , WS_Z = 482 * MiB  ;
constexpr int CW_TMO = 0, CW_BAR = 4096;
constexpr int LDS_BYTES = 155648, MISC_OFF = 153600;
constexpr int NPHASE = 21;

struct Frame {
    LAS unsigned char* lds; unsigned char* ldsg;
    int tid, wave, vcu, G;
    float* out; unsigned char* ws;
};
__device__ __forceinline__ const float* arg_in(int i) {
    const __attribute__((address_space(4))) unsigned long long* ka = (const __attribute__((address_space(4))) unsigned long long*)__builtin_amdgcn_kernarg_segment_ptr();
    asm volatile("" : "+s"(ka));
    return (const float*)(const __attribute__((address_space(1))) float*)ka[i];
}
#define WSP(T, off) ((T*)(F.ws + (off)))

__device__ __forceinline__ int uq_srccol(int n) { const int hh = n / 192, jj = n - hh * 192; if (jj < 128) return n; const int r = jj - 128; return hh * 192 + 128 + (r >> 1) + 32 * (r & 1); }
template <bool VEC>
__device__ __forceinline__ void transpose_item(const float* src, int N, int c0, int k0, bf16* dst, int K, LAS float* scr, int lane) {
    if constexpr (VEC) {
        const float* s = src + (size_t)k0 * N + c0 + (lane & 15) * 4;
        f32x4 v[16];
#pragma unroll
        for (int i = 0; i < 16; ++i) v[i] = __builtin_nontemporal_load((const f32x4*)(s + (size_t)(4 * i + (lane >> 4)) * N));
#pragma unroll
        for (int i = 0; i < 16; ++i) { LAS float* d = scr + (4 * i + (lane >> 4)) * 65 + (lane & 15) * 4; d[0] = v[i][0]; d[1] = v[i][1]; d[2] = v[i][2]; d[3] = v[i][3]; }
    } else {
        const int sc = uq_srccol(c0 + lane);
        const float* s = src + (size_t)k0 * N + sc;
#pragma unroll 16
        for (int kk = 0; kk < 64; ++kk) scr[kk * 65 + lane] = s[(size_t)kk * N];
    }
    LDS_WAIT(); asm volatile("" ::: "memory");
    const int c = lane & 7;
#pragma unroll
    for (int jj = 0; jj < 8; ++jj) { const int n = (lane >> 3) + 8 * jj; const LAS float* s = scr + (8 * c) * 65 + n;
        v4u o; o.x = pk2(s[0 * 65], s[1 * 65]); o.y = pk2(s[2 * 65], s[3 * 65]); o.z = pk2(s[4 * 65], s[5 * 65]); o.w = pk2(s[6 * 65], s[7 * 65]);
        *(v4u*)(dst + (size_t)n * K + k0 + 8 * c) = o; }
    LDS_WAIT(); asm volatile("" ::: "memory");
}
__device__ __forceinline__ float silu_f(float x) { return x / (1.0f + __expf(-x)); }

constexpr int CI0 = 32 * 13, CI1 = 8 * 48, CI2 = 4 * 64, CI3 = 32 * 32, CI4 = 32 * 32, CI5 = 32 * 96, CI_DENSE = CI0 + CI1 + CI2 + CI3 + CI4 + CI5, CI_GU = 16 * 1024, CI_D = 16 * 512;
__device__ __forceinline__ void convert_dense(Frame& F) {
    const int lane = opq(F.tid) & 63;
    const int gw = F.vcu * NWAVES + F.wave, NGW = F.G * NWAVES;
    LAS float* scr = (LAS float*)(F.lds + F.wave * 16640);
#pragma unroll 1
    for (int it = gw; it < CI_DENSE; it += NGW) {
        int r = it; const float* src; int N, c0, k0, K; bf16* dst; bool vec = true;
        if (r < CI0) { const int kb = r / 13, nb = r % 13; src = arg_in(8); N = INDIM; c0 = nb * 64; k0 = kb * 64; K = DM; dst = WSP(bf16, WS_WIN) + (size_t)nb * 64 * DM; }
        else if ((r -= CI0) < CI1) { const int kb = r / 48, nb = r % 48; src = arg_in(11); N = QW; c0 = nb * 64; k0 = kb * 64; K = QRANK; dst = WSP(bf16, WS_WUQ) + (size_t)nb * 64 * QRANK; vec = false; }
        else if ((r -= CI1) < CI2) { const int kb = r / 64, nb = r % 64; src = arg_in(12); N = KVW; c0 = nb * 64; k0 = kb * 64; K = KVRANK; dst = WSP(bf16, WS_WUKV) + (size_t)nb * 64 * KVRANK; }
        else if ((r -= CI2) < CI3) { const int kb = r / 32, nb = r % 32; src = arg_in(13); N = DM; c0 = nb * 64; k0 = kb * 64; K = DM; dst = WSP(bf16, WS_WO) + (size_t)nb * 64 * DM; }
        else if ((r -= CI3) < CI4) { const int kb = r / 32, nb = r % 32; src = arg_in(25); N = DM; c0 = nb * 64; k0 = kb * 64; K = DM; dst = WSP(bf16, WS_HYWOUT) + (size_t)nb * 64 * DM; }
        else { r -= CI4; const int kb = r / 96, nb = r % 96; src = arg_in(14); N = 3 * DM; c0 = nb * 64; k0 = kb * 64; K = DM; dst = WSP(bf16, WS_HYWIN) + (size_t)nb * 64 * DM; }
        if (vec) transpose_item<true>(src, N, c0, k0, dst, K, scr, lane); else transpose_item<false>(src, N, c0, k0, dst, K, scr, lane);
    }
}
__device__ __forceinline__ void convert_moe(Frame& F, int layer) {
    const int lane = opq(F.tid) & 63;
    const int gw = F.vcu * NWAVES + F.wave, NGW = F.G * NWAVES;
    LAS float* scr = (LAS float*)(F.lds + F.wave * 16640);
    __syncthreads();
    const float* wg = arg_in(27) + (size_t)layer * NE * DM * FFD; const float* wu = arg_in(28) + (size_t)layer * NE * DM * FFD; const float* wd = arg_in(29) + (size_t)layer * NE * FFD * DM;
    bf16* dgu = WSP(bf16, WS_WGU) + (size_t)layer * NE * 2048 * DM; bf16* dd = WSP(bf16, WS_WD) + (size_t)layer * NE * 2048 * FFD;
#pragma unroll 1
    for (int it = gw; it < CI_GU + CI_D; it += NGW) {
        int r = it; const float* src; int N, c0, k0, K; bf16* dst;
        if (r < CI_GU) { const int ex = r >> 10, q = r & 1023, kb = q >> 5, nb = q & 31;
            src = (((nb >> 1) & 1) ? wu : wg) + (size_t)ex * DM * FFD; N = FFD; c0 = (nb >> 2) * 128 + (nb & 1) * 64; k0 = kb * 64; K = DM; dst = dgu + ((size_t)ex * 2048 + nb * 64) * DM; }
        else { r -= CI_GU; const int ex = r >> 9, q = r & 511, kb = q >> 5, nb = q & 31;
            src = wd + (size_t)ex * FFD * DM; N = DM; c0 = nb * 64; k0 = kb * 64; K = FFD; dst = dd + ((size_t)ex * 2048 + nb * 64) * FFD; }
        transpose_item<true>(src, N, c0, k0, dst, K, scr, lane);
    }
    __syncthreads();
}
__device__ __forceinline__ void p0_prologue(Frame& F) {
    const int lane = opq(F.tid) & 63;
#ifndef NO_PA
    convert_dense(F);
#endif
    __syncthreads();
#ifndef NO_PB
    {
        LAS float* sv = (LAS float*)F.lds;
        LAS float* part = sv + 3 * DM;
        { const float* cin = arg_in(1); const float* cctx = arg_in(3);
        for (int i = F.tid; i < 3 * DM; i += 512) { const float cv = i < 2 * DM ? cin[i] : cctx[i - 2 * DM]; sv[i] = silu_f(cv); } }
        __syncthreads();
        float* mod = WSP(float, WS_MOD); const float* adaw = arg_in(4); const float* adab = arg_in(5);
        const int q = F.tid % 24, kg = F.tid / 24;
        for (int un = F.vcu; un < 256; un += F.G) {
            const int layer = un >> 7, n0 = (un & 127) * 96;
            const float* W = adaw + (size_t)layer * DM * 6 * DM + n0 + q * 4;
            f32x4 a0 = {0.f, 0.f, 0.f, 0.f}, a1 = a0, a2 = a0;
            if (kg < 21) {
#pragma unroll 8
                for (int k = kg; k < DM; k += 21) { const f32x4 w = *(const f32x4*)(W + (size_t)k * (6 * DM)); a0 += sv[k] * w; a1 += sv[DM + k] * w; a2 += sv[2 * DM + k] * w; }
                LAS float* pp = part + kg * 288 + q * 4;
                *(LAS f32x4*)pp = a0; *(LAS f32x4*)(pp + 96) = a1; *(LAS f32x4*)(pp + 192) = a2;
            }
            __syncthreads();
            if (F.tid < 288) { const int m = F.tid / 96, nn = F.tid % 96; float s = adab[(size_t)layer * 6 * DM + n0 + nn];
#pragma unroll
                for (int g = 0; g < 21; ++g) s += part[g * 288 + F.tid];
                mod[((size_t)layer * 3 + m) * 6 * DM + n0 + nn] = s; }
            __syncthreads();
        }
    }
#endif
    __syncthreads();
#ifndef NO_PC
    {
        LAS float* h1s = (LAS float*)F.lds;
        const float* w1 = arg_in(17); const float* b1 = arg_in(18); const float* w2 = arg_in(19); const float* b2 = arg_in(20); const float* fr = arg_in(23);
        bf16* a2s = WSP(bf16, WS_A2S); bf16* a2rs = WSP(bf16, WS_A2RS);
        const int lp = F.tid >> 6, j = F.tid & 63;
        for (int un = F.vcu; un < SEQ / 8; un += F.G) {
            const int l = un * 8 + lp;
            const float t = (float)l / (float)SEQ, w = 6.283185307179586f * (float)l / (float)SEQ;
            float pre = b1[j] + t * w1[j];
#pragma unroll
            for (int i = 0; i < 16; ++i) { const float band = 1e-4f + (float)i * ((15.0f - 1e-4f) / 15.0f); const float ang = w * band;
                pre += cosf(ang) * w1[(1 + i) * 64 + j] - sinf(ang) * w1[(17 + i) * 64 + j]; }
            const float f = fr[j];
            __syncthreads();
            h1s[lp * 64 + j] = sinf(f * pre);
            __syncthreads();
            float p2 = b2[j];
#pragma unroll 8
            for (int i = 0; i < 64; ++i) p2 += h1s[lp * 64 + i] * w2[i * 64 + j];
            const float a = sinf(f * p2);
            const unsigned hi = pk2(a, 0.f) & 0xffffu; const unsigned lo = pk2(a - bf_lo(hi), 0.f) & 0xffffu;
            bf16* r0 = a2s + (size_t)l * 256; r0[j] = (bf16)hi; r0[64 + j] = (bf16)hi; r0[128 + j] = (bf16)lo; r0[192 + j] = 0;
            bf16* r1 = a2rs + (size_t)((SEQ - l) & (SEQ - 1)) * 256;
            if (l >= 1) { r1[j] = (bf16)hi; r1[64 + j] = (bf16)hi; r1[128 + j] = (bf16)lo; r1[192 + j] = 0; } else { r1[j] = 0; r1[64 + j] = 0; r1[128 + j] = 0; r1[192 + j] = 0; }
        }
        const float* w3 = arg_in(21); bf16* w3s = WSP(bf16, WS_W3S);
        for (int r = F.vcu * 512 + F.tid; r < 8192; r += F.G * 512) {
            const int dir = r >> 12, o = (r >> 11) & 1, d = r & 2047; const float* src = w3 + o * 4096 + dir * 2048 + d; bf16* dst = w3s + (size_t)r * 256;
#pragma unroll 4
            for (int j8 = 0; j8 < 8; ++j8) { unsigned h[8], lw[8];
#pragma unroll
                for (int q = 0; q < 8; ++q) { const float v = src[(size_t)(j8 * 8 + q) * 8192]; h[q] = pk2(v, 0.f) & 0xffffu; lw[q] = pk2(v - bf_lo(h[q]), 0.f) & 0xffffu; }
                const v4u H = {h[0] | (h[1] << 16), h[2] | (h[3] << 16), h[4] | (h[5] << 16), h[6] | (h[7] << 16)}, Lw = {lw[0] | (lw[1] << 16), lw[2] | (lw[3] << 16), lw[4] | (lw[5] << 16), lw[6] | (lw[7] << 16)};
                *(v4u*)(dst + j8 * 8) = H; *(v4u*)(dst + 64 + j8 * 8) = Lw; *(v4u*)(dst + 128 + j8 * 8) = H; *(v4u*)(dst + 192 + j8 * 8) = (v4u){0u, 0u, 0u, 0u}; }
        }
    }
#endif
#ifndef NO_PD
    {
        f32x2* cs = WSP(f32x2, WS_CS);
        for (int i = F.vcu * 512 + F.tid; i < SEQ * 32; i += F.G * 512) { const int l = i >> 5, q = i & 31; const float pos = (float)((q < 16) ? (l >> 6) : (l & 63));
            const float inv = powf(10000.0f, -(float)(q & 15) / 16.0f); const float ang = pos * inv; cs[i] = (f32x2){cosf(ang), sinf(ang)}; }
        f32x2* tw = WSP(f32x2, WS_TW);
        for (int i = F.vcu * 512 + F.tid; i < 8192; i += F.G * 512) { float s, c; if (i < 4096) sincospif((float)i / 2048.0f, &s, &c); else sincospif((float)(i - 4096) / 4096.0f, &s, &c); tw[i] = (f32x2){c, -s}; }
    }
#endif
}

__device__ __forceinline__ void norm_store(const f32x4 (&v)[8], float rstd, const float* g, const float* shift, const float* scale, bf16* orow, int lane) {
#pragma unroll
    for (int j = 0; j < 8; ++j) { const int c = 4 * (64 * j + lane); const f32x4 g4 = *(const f32x4*)(g + c), sh = *(const f32x4*)(shift + c), sc = *(const f32x4*)(scale + c);
        const f32x4 y = v[j] * rstd * g4 * (1.0f + sc) + sh; v2u o; o.x = pk2(y[0], y[1]); o.y = pk2(y[2], y[3]); *(v2u*)(orow + c) = o; }
}
__device__ __forceinline__ void p1_norm0(Frame& F) {
    const int lane = opq(F.tid) & 63;
    const int gw = F.vcu * NWAVES + F.wave, NGW = F.G * NWAVES;
    const float* mod = WSP(float, WS_MOD); bf16* H = WSP(bf16, WS_H); const float* xin = arg_in(0); const float* cin = arg_in(2); const float* ng = arg_in(6);
    for (int row = gw; row < MT; row += NGW) {
        const int b = row >= LT ? 1 : 0, r = row - b * LT; const bool lat = r < SEQ;
        const float* xr = lat ? xin + ((size_t)b * SEQ + r) * DM : cin + ((size_t)b * CTXL + (r - SEQ)) * DM;
        const float* mr = mod + (size_t)(lat ? b : 2) * 6 * DM;
        f32x4 v[8]; float s = 0.f;
#pragma unroll
        for (int j = 0; j < 8; ++j) { v[j] = *(const f32x4*)(xr + 4 * (64 * j + lane)); s += (v[j][0] * v[j][0] + v[j][1] * v[j][1]) + (v[j][2] * v[j][2] + v[j][3] * v[j][3]); }
        const float rstd = 1.0f / sqrtf(wave_sum(s) * (1.0f / DM) + EPS);
        norm_store(v, rstd, ng, mr, mr + DM, H + (size_t)row * DM, lane);
    }
}
__device__ __forceinline__ void p3_latent(Frame& F) {
    const int lane = opq(F.tid) & 63;
    const int gw = F.vcu * NWAVES + F.wave, NGW = F.G * NWAVES;
    const float* proj = WSP(float, WS_PROJ); bf16* cqn = WSP(bf16, WS_CQN); bf16* ckvn = WSP(bf16, WS_CKVN); bf16* kro = WSP(bf16, WS_KROPE); const f32x2* cs = WSP(f32x2, WS_CS);
    const float* gq = arg_in(9); const float* gkv = arg_in(10);
    for (int row = gw; row < MT; row += NGW) {
        const float* pr = proj + (size_t)row * INPAD; const int l = row % LT;
        const f32x4 q0 = *(const f32x4*)(pr + 4 * lane), q1 = *(const f32x4*)(pr + 256 + 4 * lane), kv = *(const f32x4*)(pr + 512 + 4 * lane);
        float sq = (q0[0] * q0[0] + q0[1] * q0[1]) + (q0[2] * q0[2] + q0[3] * q0[3]) + (q1[0] * q1[0] + q1[1] * q1[1]) + (q1[2] * q1[2] + q1[3] * q1[3]);
        float sk = (kv[0] * kv[0] + kv[1] * kv[1]) + (kv[2] * kv[2] + kv[3] * kv[3]);
        const float rq = 1.0f / sqrtf(wave_sum(sq) * (1.0f / QRANK) + EPS), rk = 1.0f / sqrtf(wave_sum(sk) * (1.0f / KVRANK) + EPS);
        { const f32x4 g0 = *(const f32x4*)(gq + 4 * lane), g1 = *(const f32x4*)(gq + 256 + 4 * lane), g2 = *(const f32x4*)(gkv + 4 * lane);
          const f32x4 y0 = q0 * rq * g0, y1 = q1 * rq * g1, y2 = kv * rk * g2;
          v2u o; o.x = pk2(y0[0], y0[1]); o.y = pk2(y0[2], y0[3]); *(v2u*)(cqn + (size_t)row * QRANK + 4 * lane) = o;
          o.x = pk2(y1[0], y1[1]); o.y = pk2(y1[2], y1[3]); *(v2u*)(cqn + (size_t)row * QRANK + 256 + 4 * lane) = o;
          o.x = pk2(y2[0], y2[1]); o.y = pk2(y2[2], y2[3]); *(v2u*)(ckvn + (size_t)row * KVRANK + 4 * lane) = o; }
        if (lane < 32) { const float x1 = pr[768 + lane], x2 = pr[800 + lane]; float o1 = x1, o2 = x2;
            if (l < SEQ) { const f32x2 c = cs[(size_t)l * 32 + lane]; o1 = x1 * c.x - x2 * c.y; o2 = x2 * c.x + x1 * c.y; }
            ((unsigned*)(kro + (size_t)row * 64))[lane] = pk2(o1, o2); }
    }
}
__device__ __forceinline__ void p8_norm_router(Frame& F, int layer) {
    const int lane = opq(F.tid) & 63;
    const int gw = F.vcu * NWAVES + F.wave, NGW = F.G * NWAVES;
    const float* X = WSP(float, WS_X1); bf16* H = WSP(bf16, WS_H); float* aff = WSP(float, WS_AFF);
    const float* mod = WSP(float, WS_MOD) + (size_t)layer * 3 * 6 * DM; const float* g = arg_in(6) + (size_t)(layer * 2 + 1) * DM;
    LAS float* wr = (LAS float*)F.lds;
    __syncthreads();
    { const float* W = arg_in(26) + (size_t)layer * DM * NE;
      for (int i = F.tid; i < DM * NE / 4; i += 512) { const int c = i >> 2, q = i & 3; *(LAS f32x4*)(wr + c * 16 + (c >> 2) * 4 + q * 4) = *(const f32x4*)(W + (size_t)i * 4); } }
    __syncthreads();
    for (int row = gw; row < MX; row += NGW) {
        const int b = row >> 12, t = row & 4095; const float* xr = X + (size_t)row * DM; const float* shift = mod + (size_t)b * 6 * DM + 3 * DM; const float* scale = shift + DM;
        f32x4 v[8]; float s = 0.f;
#pragma unroll
        for (int j = 0; j < 8; ++j) { v[j] = *(const f32x4*)(xr + 4 * (64 * j + lane)); s += (v[j][0] * v[j][0] + v[j][1] * v[j][1]) + (v[j][2] * v[j][2] + v[j][3] * v[j][3]); }
        const float rstd = 1.0f / sqrtf(wave_sum(s) * (1.0f / DM) + EPS);
        f32x4 lg[4] = {{0.f, 0.f, 0.f, 0.f}, {0.f, 0.f, 0.f, 0.f}, {0.f, 0.f, 0.f, 0.f}, {0.f, 0.f, 0.f, 0.f}};
#pragma unroll
        for (int j = 0; j < 8; ++j) { const int c = 4 * (64 * j + lane); const f32x4 g4 = *(const f32x4*)(g + c), sh = *(const f32x4*)(shift + c), sc = *(const f32x4*)(scale + c);
            const f32x4 y = v[j] * rstd * g4 * (1.0f + sc) + sh; v2u o; o.x = pk2(y[0], y[1]); o.y = pk2(y[2], y[3]); *(v2u*)(H + (size_t)row * DM + c) = o;
            const LAS float* wp = wr + c * 16 + (c >> 2) * 4;
#pragma unroll
            for (int q = 0; q < 4; ++q) {
#pragma unroll
                for (int e4 = 0; e4 < 4; ++e4) lg[e4] += y[q] * *(const LAS f32x4*)(wp + q * 16 + e4 * 4); } }
        float lv[16];
#pragma unroll
        for (int e = 0; e < 16; ++e) lv[e] = wave_sum(lg[e >> 2][e & 3]);
        float mx = lv[0];
#pragma unroll
        for (int e = 1; e < 16; ++e) mx = fmaxf(mx, lv[e]);
        float den = 0.f;
#pragma unroll
        for (int e = 0; e < 16; ++e) { lv[e] = __expf(lv[e] - mx); den += lv[e]; }
        float mine = 0.f;
#pragma unroll
        for (int e = 0; e < 16; ++e) mine = (lane == e) ? lv[e] : mine;
        if (lane < 16) aff[((size_t)b * NE + lane) * SEQ + t] = mine / den;
    }
    __syncthreads();
}
__device__ __forceinline__ void p9_select_gather(Frame& F) {
    const int lane = opq(F.tid) & 63;
    const float* aff = WSP(float, WS_AFF); int* tok = WSP(int, WS_TOK); const bf16* H = WSP(bf16, WS_H); bf16* XG = WSP(bf16, WS_XG);
    LAS int* red = (LAS int*)F.lds;
    LAS int* sel = (LAS int*)(F.lds + 256);
    for (int un = F.vcu; un < NB * NE * 8; un += F.G) {
        const int be = un >> 3, part = un & 7, b = be >> 4, e = be & 15;
        const float* ar = aff + (size_t)be * SEQ + 8 * F.tid;
        const f32x4 a0 = *(const f32x4*)ar, a1 = *(const f32x4*)(ar + 4);
        unsigned key[8] = {__float_as_uint(a0[0]), __float_as_uint(a0[1]), __float_as_uint(a0[2]), __float_as_uint(a0[3]), __float_as_uint(a1[0]), __float_as_uint(a1[1]), __float_as_uint(a1[2]), __float_as_uint(a1[3])};
        __syncthreads();
        unsigned prefix = 0u;
        for (int bit = 30; bit >= 0; --bit) {
            const unsigned cand = prefix | (1u << bit); int c = 0;
#pragma unroll
            for (int i = 0; i < 8; ++i) c += (key[i] >= cand) ? 1 : 0;
            c = wave_sum_i(c);
            LAS int* slot = red + (bit & 1) * 8;
            if (lane == 0) slot[F.wave] = c;
            __syncthreads();
            int tot = 0;
#pragma unroll
            for (int w = 0; w < 8; ++w) tot += slot[w];
            if (tot >= CAP) prefix = cand;
        }
        int cgt = 0, ceq = 0;
#pragma unroll
        for (int i = 0; i < 8; ++i) { cgt += (key[i] > prefix) ? 1 : 0; ceq += (key[i] == prefix) ? 1 : 0; }
        int pk = (ceq << 16) | cgt, inc = pk;
#pragma unroll
        for (int o = 1; o < 64; o <<= 1) { const int y = __shfl_up(inc, o); if (lane >= o) inc += y; }
        __syncthreads();
        if (lane == 63) red[16 + F.wave] = inc;
        __syncthreads();
        int wpre = 0, total = 0;
#pragma unroll
        for (int w = 0; w < 8; ++w) { const int x = red[16 + w]; if (w < F.wave) wpre += x; total += x; }
        const int exc = wpre + inc - pk;
        const int need = CAP - (total & 0xffff);
        int eqb = exc >> 16, gtb = exc & 0xffff;
        int slotv[8];
#pragma unroll
        for (int i = 0; i < 8; ++i) { const bool gt = key[i] > prefix, eq = key[i] == prefix; const bool s = gt || (eq && eqb < need);
            const int before = gtb + (eqb < need ? eqb : need);
            slotv[i] = s ? before : -1; gtb += gt ? 1 : 0; eqb += eq ? 1 : 0; }
#pragma unroll
        for (int i = 0; i < 8; ++i) if (slotv[i] >= 0) sel[slotv[i]] = 8 * F.tid + i;
        if (part == 0) { int* tr = tok + (size_t)be * SEQ + 8 * F.tid; *(int4*)tr = make_int4(slotv[0], slotv[1], slotv[2], slotv[3]); *(int4*)(tr + 4) = make_int4(slotv[4], slotv[5], slotv[6], slotv[7]); }
        __syncthreads();
#pragma unroll
        for (int i = 0; i < 8; ++i) { const int sl = part * 64 + F.wave * 8 + i; const int t = sel[sl];
            const v4u* src = (const v4u*)(H + ((size_t)b * SEQ + t) * DM) + lane; v4u* dst = (v4u*)(XG + ((size_t)e * 1024 + b * CAP + sl) * DM) + lane;
            const v4u r0 = src[0], r1 = src[64], r2 = src[128], r3 = src[192]; dst[0] = r0; dst[64] = r1; dst[128] = r2; dst[192] = r3; }
        __syncthreads();
    }
}
template <bool FINAL>
__device__ __forceinline__ void p12_combine_norm(Frame& F, int layer) {
    const int lane = opq(F.tid) & 63;
    const int gw = F.vcu * NWAVES + F.wave, NGW = F.G * NWAVES;
    float* X = WSP(float, WS_X1); bf16* H = WSP(bf16, WS_H); const float* aff = WSP(float, WS_AFF); const int* tok = WSP(int, WS_TOK); const bf16* Y = WSP(bf16, WS_Y);
    const float* modl = WSP(float, WS_MOD) + (size_t)layer * 3 * 6 * DM; const float* gfin = FINAL ? arg_in(7) : arg_in(6) + (size_t)((layer + 1) * 2) * DM;
    for (int row = gw; row < MX; row += NGW) {
        const int b = row >> 12, t = row & 4095; float* xr = X + (size_t)row * DM; const float* g5 = modl + (size_t)b * 6 * DM + 5 * DM;
        f32x4 v[8], acc[8];
#pragma unroll
        for (int j = 0; j < 8; ++j) { v[j] = *(const f32x4*)(xr + 4 * (64 * j + lane)); acc[j] = (f32x4){0.f, 0.f, 0.f, 0.f}; }
        int sv = -1; float av = 0.f;
        if (lane < 16) { sv = tok[((size_t)b * NE + lane) * SEQ + t]; av = aff[((size_t)b * NE + lane) * SEQ + t]; }
#pragma unroll
        for (int e = 0; e < 16; ++e) { const int s = __builtin_amdgcn_readlane(sv, e); const float a = __builtin_bit_cast(float, __builtin_amdgcn_readlane(__builtin_bit_cast(int, av), e));
            if (s >= 0) { const bf16* yr = Y + ((size_t)e * 1024 + b * CAP + s) * DM;
#pragma unroll
                for (int j = 0; j < 8; ++j) { const v2u w = *(const v2u*)(yr + 4 * (64 * j + lane)); acc[j] += a * (f32x4){bf_lo(w.x), bf_hi(w.x), bf_lo(w.y), bf_hi(w.y)}; } } }
        float s2 = 0.f;
#pragma unroll
        for (int j = 0; j < 8; ++j) { const f32x4 g4 = *(const f32x4*)(g5 + 4 * (64 * j + lane)); v[j] += g4 * acc[j]; s2 += (v[j][0] * v[j][0] + v[j][1] * v[j][1]) + (v[j][2] * v[j][2] + v[j][3] * v[j][3]); }
        const float rstd = 1.0f / sqrtf(wave_sum(s2) * (1.0f / DM) + EPS);
        if constexpr (FINAL) {
#pragma unroll
            for (int j = 0; j < 8; ++j) { const int c = 4 * (64 * j + lane); *(f32x4*)(F.out + (size_t)row * DM + c) = v[j] * rstd * *(const f32x4*)(gfin + c); }
        } else {
#pragma unroll
            for (int j = 0; j < 8; ++j) *(f32x4*)(xr + 4 * (64 * j + lane)) = v[j];
            const float* m1 = WSP(float, WS_MOD) + (size_t)(layer + 1) * 3 * 6 * DM + (size_t)b * 6 * DM;
            norm_store(v, rstd, gfin, m1, m1 + DM, H + (size_t)row * DM, lane);
        }
    }
}
__device__ __forceinline__ void p15_transpose(Frame& F) {
    const int lane = opq(F.tid) & 63;
    const int gw = F.vcu * NWAVES + F.wave, NGW = F.G * NWAVES;
    const bf16* ZT = WSP(bf16, WS_ZT); bf16* Z = WSP(bf16, WS_Z);
    LAS bf16* scr = (LAS bf16*)(F.lds + F.wave * 8704);
    for (int tl = gw; tl < (DM / 64) * (MX / 64); tl += NGW) {
        const int dt = tl & 31, tt = tl >> 5;
#pragma unroll
        for (int i = 0; i < 8; ++i) { const int d = 8 * i + (lane >> 3); const v4u w = *(const v4u*)(ZT + (size_t)(dt * 64 + d) * MX + tt * 64 + (lane & 7) * 8);
            LAS bf16* p = scr + d * 68 + (lane & 7) * 8; *(LAS v2u*)p = (v2u){w.x, w.y}; *(LAS v2u*)(p + 4) = (v2u){w.z, w.w}; }
        LDS_WAIT(); asm volatile("" ::: "memory");
#pragma unroll
        for (int i = 0; i < 8; ++i) { const int tk = 8 * i + (lane >> 3), d0 = (lane & 7) * 8; unsigned short h[8];
#pragma unroll
            for (int q = 0; q < 8; ++q) h[q] = scr[(d0 + q) * 68 + tk];
            v4u o; o.x = h[0] | ((unsigned)h[1] << 16); o.y = h[2] | ((unsigned)h[3] << 16); o.z = h[4] | ((unsigned)h[5] << 16); o.w = h[6] | ((unsigned)h[7] << 16);
            *(v4u*)(Z + (size_t)(tt * 64 + tk) * DM + dt * 64 + d0) = o; }
        LDS_WAIT(); asm volatile("" ::: "memory");
    }
}

namespace att {
constexpr int NW = 8, QBLK = 32, KVBLK = 64, KROW = 384  ;
constexpr float SCALE = 0.07216878364870322f;
constexpr float THR = 8.f;
#ifndef ATT_SDEPTH
#define ATT_SDEPTH 1
#endif
constexpr int SDEPTH = ATT_SDEPTH;
constexpr int SHM_V = KVBLK * 128 * 2, SHM_K = KVBLK * KROW, SHM_QR = 2 * SHM_V + 2 * SHM_K + NW * 64 * 4  , SHM_ATTN = SHM_QR + NW * 4096;
#define KSWZ(row, colB) ((row) * 384 + ((colB) ^ (((row) & 7) << 4)))
#define SBAR() __builtin_amdgcn_sched_barrier(0)
__device__ __forceinline__ int crow(int r, int hi) { return (r & 3) + 8 * (r >> 2) + 4 * hi; }
__device__ __forceinline__ void partialSM(f32x16& p0, f32x16& p1, float& m_reg, float& mn, float& alpha) {
  constexpr float C = SCALE * 1.4426950408889634f;
  float pmax = p0[0];
#pragma unroll
  for (int r = 1; r < 16; ++r) pmax = fmaxf(pmax, p0[r]);
#pragma unroll
  for (int r = 0; r < 16; ++r) pmax = fmaxf(pmax, p1[r]);
  { auto rr = __builtin_amdgcn_permlane32_swap(__float_as_uint(pmax), __float_as_uint(pmax), false, false);
    pmax = fmaxf(__uint_as_float(rr[0]), __uint_as_float(rr[1])); }
  if (__builtin_expect(__all(pmax - m_reg <= THR / SCALE), 1)) { mn = m_reg; alpha = 1.f; }
  else { mn = fmaxf(m_reg, pmax); alpha = __builtin_amdgcn_exp2f((m_reg - mn) * C); m_reg = mn; }
  const float mnC = -mn * C;
#pragma unroll
  for (int r = 0; r < 16; ++r) p0[r] = fmaf(p0[r], C, mnC);
#pragma unroll
  for (int r = 0; r < 16; ++r) p1[r] = fmaf(p1[r], C, mnC);
#pragma unroll
  for (int r = 0; r < 16; ++r) p0[r] = __builtin_amdgcn_exp2f(p0[r]);
}
__device__ __forceinline__ void finishSM(f32x16& p0, f32x16& p1, float alpha, float& l_reg, bf16x8& pa0, bf16x8& pa1, bf16x8& pa2, bf16x8& pa3) {
#pragma unroll
  for (int r = 0; r < 16; ++r) p1[r] = __builtin_amdgcn_exp2f(p1[r]);
  float ps = 0;
#pragma unroll
  for (int r = 0; r < 16; ++r) ps += p0[r];
#pragma unroll
  for (int r = 0; r < 16; ++r) ps += p1[r];
  { auto rr = __builtin_amdgcn_permlane32_swap(__float_as_uint(ps), __float_as_uint(ps), false, false);
    ps = __uint_as_float(rr[0]) + __uint_as_float(rr[1]); }
  l_reg = l_reg * alpha + ps;
#define PK4(P, BASE, OUT) do { unsigned a0 = pk2(P[BASE + 0], P[BASE + 1]), a1 = pk2(P[BASE + 2], P[BASE + 3]);   \
    unsigned b0 = pk2(P[BASE + 4], P[BASE + 5]), b1 = pk2(P[BASE + 6], P[BASE + 7]);                              \
    auto r0 = __builtin_amdgcn_permlane32_swap(a0, b0, false, false); auto r1 = __builtin_amdgcn_permlane32_swap(a1, b1, false, false); \
    v4u w = {r0[0], r1[0], r0[1], r1[1]}; OUT = *reinterpret_cast<bf16x8*>(&w); } while (0)
  PK4(p0, 0, pa0); PK4(p0, 8, pa1); PK4(p1, 0, pa2); PK4(p1, 8, pa3);
#undef PK4
}
__device__ __forceinline__ void qkt(f32x16& p0, f32x16& p1, const char* Ks, const bf16x8* qr, const char* qL, const int (&kb)[4]) {
  p0 = f32x16{}; p1 = f32x16{};
#pragma unroll
  for (int d0 = 0; d0 < 12; ++d0) {
    const bf16x8 qf = d0 < 8 ? qr[d0 < 8 ? d0 : 0] : *reinterpret_cast<const bf16x8*>(qL + (d0 - 8) * 1024);
    const bf16x8 b0 = *reinterpret_cast<const bf16x8*>(Ks + kb[d0 & 3] + (d0 >> 2) * 128);
    const bf16x8 b1 = *reinterpret_cast<const bf16x8*>(Ks + kb[d0 & 3] + (d0 >> 2) * 128 + 32 * 384);
    p0 = __builtin_amdgcn_mfma_f32_32x32x16_bf16(b0, qf, p0, 0, 0, 0);
    p1 = __builtin_amdgcn_mfma_f32_32x32x16_bf16(b1, qf, p1, 0, 0, 0); }
}
__device__ __forceinline__ int v_st(int k, int c) { const int kk = (k & ~0xC) | ((k & 4) << 1) | ((k & 8) >> 1); return ((kk >> 3) * 4 + (c >> 5)) * 512 + ((kk & 7) * 32 + (c & 31)) * 2; }
__device__ __forceinline__ int v_rd_base(int lane) { return ((lane & 3) << 3) | (((lane >> 2) & 3) << 6) | (((lane >> 4) & 1) << 5) | (((lane >> 5) & 1) << 8); }
constexpr int v_rd_off(int d0, int ks, int half) { return d0 * 512 + ks * 4096 + half * 2048; }
template <int OFF> __device__ __forceinline__ s16x4 tr_read(int vb) {
  s16x4 r; asm volatile("ds_read_b64_tr_b16 %0, %1 offset:%2" : "=&v"(r) : "v"(vb), "i"(OFF) : "memory"); return r;
}
template <int D0> __device__ __forceinline__ void pv_one(f32x16& od, int vb, bf16x8 pa0, bf16x8 pa1, bf16x8 pa2, bf16x8 pa3) {
  const s16x4 l0 = tr_read<v_rd_off(D0, 0, 0)>(vb), h0 = tr_read<v_rd_off(D0, 0, 1)>(vb), l1 = tr_read<v_rd_off(D0, 1, 0)>(vb), h1 = tr_read<v_rd_off(D0, 1, 1)>(vb);
  const s16x4 l2 = tr_read<v_rd_off(D0, 2, 0)>(vb), h2 = tr_read<v_rd_off(D0, 2, 1)>(vb), l3 = tr_read<v_rd_off(D0, 3, 0)>(vb), h3 = tr_read<v_rd_off(D0, 3, 1)>(vb);
  asm volatile("s_waitcnt lgkmcnt(0)" ::: "memory"); SBAR();
#define PKV(L, H) (bf16x8){L[0], L[1], L[2], L[3], H[0], H[1], H[2], H[3]}
  od = __builtin_amdgcn_mfma_f32_32x32x16_bf16(pa0, PKV(l0, h0), od, 0, 0, 0);
  od = __builtin_amdgcn_mfma_f32_32x32x16_bf16(pa1, PKV(l1, h1), od, 0, 0, 0);
  od = __builtin_amdgcn_mfma_f32_32x32x16_bf16(pa2, PKV(l2, h2), od, 0, 0, 0);
  od = __builtin_amdgcn_mfma_f32_32x32x16_bf16(pa3, PKV(l3, h3), od, 0, 0, 0);
#undef PKV
}
__device__ __forceinline__ void pv_d0(f32x16* o, int vb, bf16x8 pa0, bf16x8 pa1, bf16x8 pa2, bf16x8 pa3) {
  pv_one<0>(o[0], vb, pa0, pa1, pa2, pa3); pv_one<1>(o[1], vb, pa0, pa1, pa2, pa3); pv_one<2>(o[2], vb, pa0, pa1, pa2, pa3); pv_one<3>(o[3], vb, pa0, pa1, pa2, pa3);
}
__device__ __forceinline__ void attn_body(const bf16* __restrict__ Qb, const bf16* __restrict__ Kn, const bf16* __restrict__ Kr, const bf16* __restrict__ Vh, bf16* __restrict__ Ob, int seq, char* lds) {
  constexpr int LDQ = 3072, LDK = 4096, LDR = 64, LDO = 2048;
  const int tid = threadIdx.x, wid = tid >> 6, lane = tid & 63, r32 = lane & 31, hi = lane >> 5;
  char* V_lds = lds; char* K_lds = lds + 2 * SHM_V;
  float* ws = (float*)(lds + 2 * SHM_V + 2 * SHM_K) + wid * 64; float* li_l = ws; float* al_l = ws + 32;
  float m_reg = -1e30f, l_reg = 0; f32x16 o[4] = {}; bf16x8 qr[8];
  char* qL = lds + SHM_QR + wid * 4096 + lane * 16;
  const bf16* Qw = Qb + (unsigned)((wid * QBLK + r32) * LDQ + hi * 8);
#pragma unroll
  for (int d0 = 0; d0 < 8; ++d0) qr[d0] = *reinterpret_cast<const bf16x8*>(Qw + d0 * 16);
#pragma unroll
  for (int d0 = 8; d0 < 12; ++d0) *reinterpret_cast<bf16x8*>(qL + (d0 - 8) * 1024) = *reinterpret_cast<const bf16x8*>(Qw + d0 * 16);
  const int sr = tid >> 4, sc = (tid & 15) * 8, vst0 = v_st(sr, sc), vst1 = v_st(32 + sr, sc);
  const int rr = tid >> 3, rc = (tid & 7) * 8;
  const unsigned o_s0 = (unsigned)(sr * LDK + sc), o_s1 = (unsigned)((32 + sr) * LDK + sc), o_r = (unsigned)(rr * LDR + rc);
  int kb[4];
#pragma unroll
  for (int q = 0; q < 4; ++q) kb[q] = r32 * 384 + ((q * 32 + hi * 16) ^ ((r32 & 7) << 4));
  const int vb0 = (int)(uintptr_t)V_lds + v_rd_base(lane);
  struct { bf16x8 vs0, vs1, ks0, ks1, kr0; } sr_[SDEPTH];
#define SLOAD(i, k0) do { const bf16* Vt = Vh + (size_t)(k0) * LDK; const bf16* Kt = Kn + (size_t)(k0) * LDK; const bf16* Rt = Kr + (size_t)(k0) * LDR; \
    sr_[i].vs0 = *(const bf16x8*)(Vt + o_s0); sr_[i].vs1 = *(const bf16x8*)(Vt + o_s1); sr_[i].ks0 = *(const bf16x8*)(Kt + o_s0); sr_[i].ks1 = *(const bf16x8*)(Kt + o_s1); \
    sr_[i].kr0 = *(const bf16x8*)(Rt + o_r); } while (0)
#define SWRITE(b, i) do { *(bf16x8*)(V_lds + (b) * SHM_V + vst0) = sr_[i].vs0; *(bf16x8*)(V_lds + (b) * SHM_V + vst1) = sr_[i].vs1; const int kc = sc * 2;               \
    *(bf16x8*)(K_lds + (b) * SHM_K + KSWZ(sr, kc)) = sr_[i].ks0; *(bf16x8*)(K_lds + (b) * SHM_K + KSWZ(32 + sr, kc)) = sr_[i].ks1;                       \
    *(bf16x8*)(K_lds + (b) * SHM_K + KSWZ(rr, 256 + rc * 2)) = sr_[i].kr0; } while (0)
#define SWAIT() do { if constexpr (SDEPTH == 2) asm volatile("s_waitcnt vmcnt(5)" ::: "memory"); else asm volatile("s_waitcnt vmcnt(0)" ::: "memory"); } while (0)
#define RESC(a) do { if (__any((a) < 1.f)) { if (hi == 0) al_l[r32] = (a); asm volatile("s_waitcnt lgkmcnt(0)" ::: "memory"); \
    _Pragma("unroll") for (int d = 0; d < 4; ++d) _Pragma("unroll") for (int r = 0; r < 16; ++r) o[d][r] *= al_l[crow(r, hi)]; } } while (0)
  f32x16 pA0, pA1, pB0, pB1; float mnA, mnB, alA, alB; bf16x8 pa0, pa1, pa2, pa3; const int NT = seq / KVBLK;
  constexpr int SE = 0, SO = SDEPTH - 1;
  SLOAD(SE, 0); asm volatile("s_waitcnt vmcnt(0)" ::: "memory"); SWRITE(0, SE); __syncthreads();
  qkt(pA0, pA1, K_lds, qr, qL, kb); partialSM(pA0, pA1, m_reg, mnA, alA);
  SLOAD(SO, KVBLK); if constexpr (SDEPTH == 2) { if (2 < NT) SLOAD(SE, 2 * KVBLK); }
  SWAIT(); SWRITE(1, SO); __syncthreads();
  for (int j = 1; j + 1 < NT; j += 2) {
    SBAR(); qkt(pB0, pB1, K_lds + SHM_K, qr, qL, kb);
    finishSM(pA0, pA1, alA, l_reg, pa0, pa1, pa2, pa3); SBAR();
    SLOAD(SO, (j + SDEPTH) * KVBLK); SBAR();
    pv_d0(o, vb0, pa0, pa1, pa2, pa3); partialSM(pB0, pB1, m_reg, mnB, alB);
    __syncthreads(); SWAIT(); SWRITE(0, SE);
    RESC(alB); __syncthreads();
    SBAR(); qkt(pA0, pA1, K_lds, qr, qL, kb);
    finishSM(pB0, pB1, alB, l_reg, pa0, pa1, pa2, pa3); SBAR();
    if (SDEPTH == 1 || j + 3 < NT) SLOAD(SE, (j + 1 + SDEPTH) * KVBLK); SBAR();
    pv_d0(o, vb0 + SHM_V, pa0, pa1, pa2, pa3); partialSM(pA0, pA1, m_reg, mnA, alA);
    __syncthreads(); SWAIT(); SWRITE(1, SO);
    RESC(alA); __syncthreads();
  }
  SBAR(); qkt(pB0, pB1, K_lds + SHM_K, qr, qL, kb);
  finishSM(pA0, pA1, alA, l_reg, pa0, pa1, pa2, pa3); SBAR();
  pv_d0(o, vb0, pa0, pa1, pa2, pa3); partialSM(pB0, pB1, m_reg, mnB, alB);
  __syncthreads(); RESC(alB);
  finishSM(pB0, pB1, alB, l_reg, pa0, pa1, pa2, pa3); SBAR();
  pv_d0(o, vb0 + SHM_V, pa0, pa1, pa2, pa3);
  if (hi == 0) li_l[r32] = l_reg; asm volatile("s_waitcnt lgkmcnt(0)" ::: "memory");
  float rli[16];
#pragma unroll
  for (int r = 0; r < 16; ++r) rli[r] = __builtin_amdgcn_rcpf(li_l[crow(r, hi)]);
  bf16* Ow = Ob + (size_t)(wid * QBLK) * LDO;
#pragma unroll
  for (int r = 0; r < 16; ++r) { const int orow = crow(r, hi);
#pragma unroll
    for (int d0 = 0; d0 < 4; ++d0) Ow[(unsigned)(orow * LDO + d0 * 32 + r32)] = (bf16)(pk2(o[d0][r] * rli[r], 0.f) & 0xffffu); }
#undef SLOAD
#undef SWRITE
#undef SWAIT
#undef RESC
}
}
__device__ __forceinline__ void p6_attention(Frame& F) {
    const bf16* Q = WSP(bf16, WS_Q); const bf16* KV = WSP(bf16, WS_KV); const bf16* KR = WSP(bf16, WS_KROPE); bf16* O = WSP(bf16, WS_O);
    const int nun = NB * NH * (SEQ / 256);
    for (int i = 0; ; ++i) {
        int bh, qb;
        if (F.G == 256) { if (i >= 2) break; const int x = blockIdx.x & 7, j = blockIdx.x >> 3; bh = (i * 8 + x) * 2 + (j >> 4); qb = j & 15; }
        else { const int L = i * F.G + (int)blockIdx.x; if (L >= nun) break; bh = L >> 4; qb = L & 15; }
        const int b = bh >> 4, h = bh & 15;
        __syncthreads();
        att::attn_body(Q + ((size_t)b * LT + qb * 256) * QW + h * 192, KV + (size_t)b * LT * KVW + h * 256, KR + (size_t)b * LT * 64, KV + (size_t)b * LT * KVW + h * 256 + 128,
                       O + ((size_t)b * SEQ + qb * 256) * DM + h * 128, LT, (char*)F.ldsg);
    }
    __syncthreads();
}

namespace hy {
typedef float cpx __attribute__((ext_vector_type(2)));
__device__ __forceinline__ cpx cmul(cpx a, cpx b) { return (cpx){a.x * b.x - a.y * b.y, a.x * b.y + a.y * b.x}; }
__device__ __forceinline__ cpx cmulc(cpx a, cpx b) { return (cpx){a.x * b.x + a.y * b.y, a.y * b.x - a.x * b.y}; }
__device__ __forceinline__ cpx cadd(cpx a, cpx b) { return a + b; }
__device__ __forceinline__ cpx csub(cpx a, cpx b) { return a - b; }
template <int S> __device__ __forceinline__ cpx mul_i(cpx a) { return S < 0 ? (cpx){a.y, -a.x} : (cpx){-a.y, a.x}; }
template <int S> __device__ __forceinline__ void dft4(cpx& x0, cpx& x1, cpx& x2, cpx& x3) {
    const cpx t0 = cadd(x0, x2), t1 = csub(x0, x2), t2 = cadd(x1, x3), t3 = mul_i<S>(csub(x1, x3));
    x0 = cadd(t0, t2); x2 = csub(t0, t2); x1 = cadd(t1, t3); x3 = csub(t1, t3);
}
template <int S> __device__ __forceinline__ cpx tw16(cpx a, int m) {
    constexpr float C1 = 0.9238795325112867f, S1 = 0.3826834323650898f, R = 0.7071067811865476f;
    cpx w;
    switch (m) { case 0: return a; case 1: w = (cpx){C1, -S1}; break; case 2: w = (cpx){R, -R}; break; case 3: w = (cpx){S1, -C1}; break; case 4: w = (cpx){0.f, -1.f}; break; case 6: w = (cpx){-R, -R}; break; default: w = (cpx){-C1, S1}; break; }
    if (S > 0) w.y = -w.y;
    return cmul(a, w);
}
template <int S> __device__ __forceinline__ void dft16(cpx (&v)[16]) {
#pragma unroll
    for (int a = 0; a < 4; ++a) { dft4<S>(v[a], v[a + 4], v[a + 8], v[a + 12]);
#pragma unroll
        for (int d = 1; d < 4; ++d) v[a + 4 * d] = tw16<S>(v[a + 4 * d], a * d); }
#pragma unroll
    for (int d = 0; d < 4; ++d) dft4<S>(v[4 * d], v[4 * d + 1], v[4 * d + 2], v[4 * d + 3]);
}
__device__ __forceinline__ constexpr int SL(int k) { return 4 * (k & 3) + (k >> 2); }
__device__ __forceinline__ int PI(int i) { return i + (i >> 4); }
typedef LAS cpx* lbuf;
typedef const LAS cpx* ltab;
__device__ __forceinline__ cpx tw_lookup(ltab T, int m) { return cmul(T[64 + (m >> 6)], T[m & 63]); }
__device__ __forceinline__ void tw_powers(cpx b, cpx (&p)[16]) {
    p[0] = (cpx){1.f, 0.f}; p[1] = b; p[2] = cmul(b, b); p[3] = cmul(p[2], b); p[4] = cmul(p[2], p[2]); p[5] = cmul(p[4], b); p[6] = cmul(p[4], p[2]); p[7] = cmul(p[4], p[3]); p[8] = cmul(p[4], p[4]);
    p[9] = cmul(p[8], b); p[10] = cmul(p[8], p[2]); p[11] = cmul(p[8], p[3]); p[12] = cmul(p[8], p[4]); p[13] = cmul(p[8], p[5]); p[14] = cmul(p[8], p[6]); p[15] = cmul(p[8], p[7]);
}
struct Addr { int a1, a2, a3; };
__device__ __forceinline__ void fwd12(lbuf buf, Addr A, const cpx (&pw1)[16], cpx b2) {
    cpx v[16], pw2[16];
    { lbuf b = buf + A.a1;
#pragma unroll
      for (int n = 0; n < 16; ++n) v[n] = b[n * 272];
      dft16<-1>(v);
#pragma unroll
      for (int k = 0; k < 16; ++k) b[k * 272] = k ? cmul(v[SL(k)], pw1[k]) : v[SL(k)]; }
    __syncthreads();
    { lbuf b = buf + A.a2;
#pragma unroll
      for (int n = 0; n < 16; ++n) v[n] = b[n * 17];
      tw_powers(b2, pw2);
      dft16<-1>(v);
#pragma unroll
      for (int k = 0; k < 16; ++k) b[k * 17] = k ? cmul(v[SL(k)], pw2[k]) : v[SL(k)]; }
    __syncthreads();
}
__device__ __forceinline__ void inv21(lbuf buf, Addr A, const cpx (&pw1)[16], cpx b2) {
    cpx v[16], pw2[16];
    { lbuf b = buf + A.a2; tw_powers(b2, pw2);
#pragma unroll
      for (int k = 0; k < 16; ++k) { const cpx x = b[k * 17]; v[k] = k ? cmulc(x, pw2[k]) : x; }
      dft16<1>(v);
#pragma unroll
      for (int n = 0; n < 16; ++n) b[n * 17] = v[SL(n)]; }
    __syncthreads();
    { lbuf b = buf + A.a1;
#pragma unroll
      for (int k = 0; k < 16; ++k) { const cpx x = b[k * 272]; v[k] = k ? cmulc(x, pw1[k]) : x; }
      dft16<1>(v);
#pragma unroll
      for (int n = 0; n < 16; ++n) b[n * 272] = v[SL(n)]; }
    __syncthreads();
}
template <int ORDER> __device__ __forceinline__ void conv_core(lbuf bx, lbuf bw, Addr A, int ap, bool special, float scale, const cpx (&pw1)[16], cpx b2) {
    fwd12(bx, A, pw1, b2);
    cpx v[16], u[16];
    { lbuf b = bx + A.a3;
#pragma unroll
      for (int n = 0; n < 16; ++n) v[n] = b[n]; }
    dft16<-1>(v);
    const float hs = 0.5f * scale;
    { lbuf bo = bw + A.a3; lbuf bp = bw + ap;
#pragma unroll
      for (int k3 = 0; k3 < 16; ++k3) {
        const cpx wf = bo[k3]; const cpx wp = (k3 == 0) ? bw[special ? ap - 1 : ap + 15] : bp[15 - k3];
        const cpx K = ORDER == 0 ? (cpx){(wf.x + wp.x) * hs, (wf.y - wp.y) * hs} : (cpx){(wf.y + wp.y) * hs, -(wf.x - wp.x) * hs};
        u[k3] = cmul(v[SL(k3)], K); } }
    dft16<1>(u);
    { lbuf b = bx + A.a3;
#pragma unroll
      for (int n = 0; n < 16; ++n) b[n] = u[SL(n)]; }
    __syncthreads();
    inv21(bx, A, pw1, b2);
}
}

__device__ __forceinline__ void p14_hyena_conv(Frame& F) {
    const int lane = opq(F.tid) & 63;
    using namespace hy;
    lbuf bufX = (lbuf)F.lds; lbuf bufW = (lbuf)(F.lds + 69632);
    LAS float* red = (LAS float*)(F.lds + 139264);
    LAS cpx* tab = (LAS cpx*)(F.lds + 139264 + 64);
    const float* HF = WSP(float, WS_HF);
    const bf16* U = WSP(bf16, WS_U); bf16* ZT = WSP(bf16, WS_ZT);
    const float* b3 = arg_in(22); const float* cw = arg_in(15); const float* cb = arg_in(16); const float* skip = arg_in(24);
    __syncthreads();
    if (F.tid < 256) { const f32x2* twg = WSP(f32x2, WS_TW); const int q = F.tid >> 6, i = F.tid & 63; tab[F.tid] = twg[(q >> 1) * 4096 + ((q & 1) ? 64 * i : i)]; }
    __syncthreads();
    const int t0_ = F.tid, e = t0_ >> 8, j = t0_ & 255;
    cpx pw1[16];
    tw_powers(tw_lookup(tab, j), pw1); const cpx b2 = tw_lookup(tab, 16 * (j & 15));
    Addr A; A.a1 = j + (j >> 4); A.a2 = (j >> 4) * 272 + (j & 15); A.a3 = j * 17;
    const int k1 = j >> 4, k2 = j & 15; const bool special = (e == 0 && j == 0);
    const int ap = e ? (15 - k1) * 272 + (15 - k2) * 17 : (k1 ? (16 - k1) * 272 + (15 - k2) * 17 : (k2 ? (16 - k2) * 17 : 1));
    lbuf bx = bufX + e * 4352; lbuf bw = bufW + e * 4352;
#define HY_ISSUE(T, raw) do { const int ch = (T) * DM + d; \
        _Pragma("unroll") for (int b = 0; b < 2; ++b) { const bf16* pr = U + (size_t)ch * MX + b * SEQ + n0; raw.m[b] = *(const v4u*)pr; raw.l[b] = t > 0 ? pr[-1] : (bf16)0; raw.r[b] = t < 511 ? pr[8] : (bf16)0; } } while (0)
#define HY_CONV(T, raw, dst) do { const int ch = (T) * DM + d; const float w0 = cw[ch], w1 = cw[3 * DM + ch], w2 = cw[6 * DM + ch], bs = cb[ch]; \
        _Pragma("unroll") for (int b = 0; b < 2; ++b) { const v4u m = raw.m[b]; \
            const float p[10] = {bf1(raw.l[b]), bf_lo(m.x), bf_hi(m.x), bf_lo(m.y), bf_hi(m.y), bf_lo(m.z), bf_hi(m.z), bf_lo(m.w), bf_hi(m.w), bf1(raw.r[b])}; \
            _Pragma("unroll") for (int i = 0; i < 8; ++i) { const float uu = w0 * p[i] + w1 * p[i + 1] + w2 * p[i + 2] + bs; if (b == 0) dst[i].x = uu; else dst[i].y = uu; } } } while (0)
    struct Raw { v4u m[2]; bf16 l[2], r[2]; };
#define HY_TW8() cpx tw8[8]; { const cpx th = tab[192 + (t >> 3)]; _Pragma("unroll") for (int i = 0; i < 8; ++i) tw8[i] = cmul(th, tab[128 + 8 * (t & 7) + i]); }
#pragma unroll 1
    for (int d = F.vcu; d < DM; d += F.G) {
        int t = F.tid; asm volatile("" : "+v"(t));
        const int n0 = 8 * t, p0 = n0 + (t >> 1);
        Raw rv, r1; HY_ISSUE(0, rv); HY_ISSUE(1, r1);
        __syncthreads();
        {
            const float* h00 = HF + (size_t)d * SEQ + n0; const float* h10 = h00 + (size_t)2048 * SEQ; const float* h01 = h00 + (size_t)4096 * SEQ; const float* h11 = h01 + (size_t)2048 * SEQ;
            const f32x4 a00 = *(const f32x4*)h00, b00 = *(const f32x4*)(h00 + 4), a10 = *(const f32x4*)h10, b10 = *(const f32x4*)(h10 + 4);
            const f32x4 a01 = *(const f32x4*)h01, b01 = *(const f32x4*)(h01 + 4), a11 = *(const f32x4*)h11, b11 = *(const f32x4*)(h11 + 4);
            const float bb00 = b3[d], bb01 = b3[2048 + d], bb10 = b3[4096 + d], bb11 = b3[6144 + d];
            const float adel = 3.0701134573253944f + (float)d * ((15.350567286626972f - 3.0701134573253944f) / 2047.0f);
            float ss0 = 0.f, ss1 = 0.f; HY_TW8();
#pragma unroll
            for (int i = 0; i < 8; ++i) { const int n = n0 + i; const float df = __expf(-((float)n * (1.0f / 4096.0f)) * adel), db = __expf(-((float)(4096 - n) * (1.0f / 4096.0f)) * adel);
                const float f00 = (i < 4 ? a00[i & 3] : b00[i & 3]) + bb00, f10 = (i < 4 ? a10[i & 3] : b10[i & 3]) + bb10, f01 = (i < 4 ? a01[i & 3] : b01[i & 3]) + bb01, f11 = (i < 4 ? a11[i & 3] : b11[i & 3]) + bb11;
                const float a0 = f00 * df, a1 = f10 * df;
                const float c0 = n ? f01 * db : 0.f, c1 = n ? f11 * db : 0.f;
                ss0 += a0 * a0 + c0 * c0; ss1 += a1 * a1 + c1 * c1;
                bufW[p0 + i] = (cpx){a0 + c0, a1 + c1};
                bufW[4352 + p0 + i] = cmul((cpx){a0 - c0, a1 - c1}, tw8[i]); }
            ss0 = wave_sum(ss0); ss1 = wave_sum(ss1);
            if (lane == 0) { red[F.wave * 2] = ss0; red[F.wave * 2 + 1] = ss1; }
        }
        __syncthreads();
        float rs0 = 0.f, rs1 = 0.f;
#pragma unroll
        for (int w = 0; w < 8; ++w) { rs0 += red[w * 2]; rs1 += red[w * 2 + 1]; }
        rs0 = (1.0f / sqrtf(rs0 + EPS)) * (1.0f / 8192.0f); rs1 = (1.0f / sqrtf(rs1 + EPS)) * (1.0f / 8192.0f);
        { fwd12(bw, A, pw1, b2); cpx v[16]; lbuf b = bw + A.a3;
#pragma unroll
          for (int n = 0; n < 16; ++n) v[n] = b[n];
          dft16<-1>(v);
#pragma unroll
          for (int k = 0; k < 16; ++k) b[k] = v[SL(k)]; }
        cpx vv[8];
        HY_CONV(0, rv, vv);
        const float sk0 = skip[d], sk1 = skip[DM + d];
        { HY_TW8();
#pragma unroll
        for (int i = 0; i < 8; ++i) { bufX[p0 + i] = vv[i]; bufX[4352 + p0 + i] = cmul(vv[i], tw8[i]); } }
        __syncthreads();
        conv_core<0>(bx, bw, A, ap, special, rs0, pw1, b2);
        Raw r2; HY_ISSUE(2, r2);
        { cpx x1c[8]; HY_CONV(1, r1, x1c); HY_TW8();
#pragma unroll
        for (int i = 0; i < 8; ++i) { const cpx ye = bufX[p0 + i], yo = bufX[4352 + p0 + i]; const cpx y = cadd(ye, cmulc(yo, tw8[i]));
            vv[i] = (cpx){x1c[i].x * (y.x + sk0 * vv[i].x), x1c[i].y * (y.y + sk0 * vv[i].y)};
            bufX[p0 + i] = vv[i]; bufX[4352 + p0 + i] = cmul(vv[i], tw8[i]); } }
        __syncthreads();
        conv_core<1>(bx, bw, A, ap, special, rs1, pw1, b2);
        cpx x2c[8]; HY_CONV(2, r2, x2c); HY_TW8();
        unsigned ob0[4], ob1[4];
#pragma unroll
        for (int i = 0; i < 8; i += 2) { float z0[2], z1[2];
#pragma unroll
            for (int q = 0; q < 2; ++q) { const cpx ye = bufX[p0 + i + q], yo = bufX[4352 + p0 + i + q]; const cpx y = cadd(ye, cmulc(yo, tw8[i + q]));
                z0[q] = x2c[i + q].x * (y.x + sk1 * vv[i + q].x); z1[q] = x2c[i + q].y * (y.y + sk1 * vv[i + q].y); }
            ob0[i >> 1] = pk2(z0[0], z0[1]); ob1[i >> 1] = pk2(z1[0], z1[1]); }
        *(v4u*)(ZT + (size_t)d * MX + n0) = (v4u){ob0[0], ob0[1], ob0[2], ob0[3]};
        *(v4u*)(ZT + (size_t)d * MX + SEQ + n0) = (v4u){ob1[0], ob1[1], ob1[2], ob1[3]};
    }
    __syncthreads();
#undef HY_ISSUE
#undef HY_CONV
#undef HY_TW8
}

#ifndef MK_SINGLE
#define MK_SINGLE 1
#endif
struct Args { const float* in[30]; float* out; unsigned char* ws; int ph_lo, ph_hi; };
__global__ void __launch_bounds__(NWAVES * 64, 2) mk_fwd(Args args) {
    extern __shared__ __attribute__((aligned(16))) unsigned char lds[];
    Frame F;
    F.lds = (LAS unsigned char*)lds; F.ldsg = lds;
    F.tid = threadIdx.x; F.wave = __builtin_amdgcn_readfirstlane(F.tid >> 6);
    F.G = gridDim.x; { const int bx = blockIdx.x; F.vcu = (F.G % 8 == 0) ? (bx % 8) * (F.G / 8) + bx / 8 : bx; }
    F.out = args.out; F.ws = args.ws;
    volatile LAS unsigned* MISC = (volatile LAS unsigned*)(F.lds + MISC_OFF);
    if (F.tid < 32) MISC[F.tid] = 0u;
    __syncthreads();
    unsigned* ctl = (unsigned*)(F.ws + WS_CTL);
    XcdBarrier bar; bar.bar = ctl + CW_BAR; bar.x = 0; bar.st = nullptr;
    if (MK_SINGLE) bar = xcd_barrier_post(ctl + CW_BAR, MISC + 8);
    const int lo = args.ph_lo, hi = args.ph_hi;
#ifndef PH_MASK
#define PH_MASK 0x1fffff
#endif
#ifndef PROBE_DUP
#define PROBE_DUP 0
#endif
#define IN(k) (((PH_MASK >> (k)) & 1) && lo <= (k) && (k) < hi)
#define REP(k) for (int rep_ = 0; rep_ < (((PROBE_DUP >> (k)) & 1) ? 2 : 1); ++rep_)
#ifndef PROBE_XBAR
#define PROBE_XBAR 0
#endif
#define SEAM(k) do { if (MK_SINGLE && IN(k) && IN((k) + 1)) { xcd_barrier(bar); if (PROBE_XBAR) xcd_barrier(bar); } } while (0)
    using namespace pg8;
    const bf16_t* Hb = WSP(bf16_t, WS_H);
    float* mod = WSP(float, WS_MOD);

    if (IN(0)) REP(0) { p0_prologue(F); convert_moe(F, 0); convert_moe(F, 1); } SEAM(0);
    if (IN(1)) REP(1) { p1_norm0(F); } SEAM(1);
    if (IN(2)) REP(2) {
        Gemm g{Hb, WSP(bf16_t, WS_WIN), MT, INPAD, DM}; StaticOrder S; S.init(MT, INPAD, F.G, (int)blockIdx.x);
        EpiF32Plain E{WSP(float, WS_PROJ), INPAD, 0x7fffffff};
        gemm_phase<EpiF32Plain, StaticOrder, true, true>(F.lds, g, S, E);
        {
            __syncthreads();
            Gemm g2{WSP(bf16_t, WS_W3S), WSP(bf16_t, WS_A2S), 8192, 4096, 256}; HfOrder S2{F.G, (int)blockIdx.x, 136};
            EpiF32Plain E2{WSP(float, WS_HF), 4096, 15};
            gemm_phase<EpiF32Plain, HfOrder, true, true>(F.lds, g2, S2, E2);
        }
    } SEAM(2);
    if (IN(3)) REP(3) { p3_latent(F); } SEAM(3);
    if (IN(4)) REP(4) {
        { Gemm g{WSP(bf16_t, WS_CQN), WSP(bf16_t, WS_WUQ), MT, QW, QRANK}; StaticOrder S; S.init(MT, QW, F.G, (int)blockIdx.x);
          EpiQRope E{WSP(bf16_t, WS_Q), WSP(float, WS_CS)};
          gemm_phase<EpiQRope, StaticOrder, true, true>(F.lds, g, S, E); }
        __syncthreads();
        { Gemm g{WSP(bf16_t, WS_CKVN), WSP(bf16_t, WS_WUKV), MT, KVW, KVRANK}; StaticOrder S; S.init(MT, KVW, F.G, (int)blockIdx.x);
          EpiBf16Plain E{WSP(bf16_t, WS_KV), KVW, 0x7fffffff};
          gemm_phase<EpiBf16Plain, StaticOrder, true, true>(F.lds, g, S, E); }
    } SEAM(4);
    if (IN(5)) REP(5) { p6_attention(F); } SEAM(5);
    if (IN(6)) REP(6) {
        Gemm g{WSP(bf16_t, WS_O), WSP(bf16_t, WS_WO), MX, DM, DM}; StaticOrder S; S.init(MX, DM, F.G, (int)blockIdx.x);
        EpiResid E{arg_in(0), WSP(float, WS_X1), mod + 2 * DM, 6 * DM};
        gemm_phase<EpiResid, StaticOrder, true, true>(F.lds, g, S, E);
    } SEAM(6);
#define MOE_PHASES(layer, pb) \
    if (IN(pb)) REP(pb) { p8_norm_router(F, layer); } SEAM(pb); \
    if (IN((pb) + 1)) REP((pb) + 1) { p9_select_gather(F); } SEAM((pb) + 1); \
    if (IN((pb) + 2)) REP((pb) + 2) {     \
        Gemm g{WSP(bf16_t, WS_XG), WSP(bf16_t, WS_WGU) + (size_t)(layer) * NE * 2048 * DM, MROWS, 2048, DM}; MoeOrder S{F.G, (int)blockIdx.x}; \
        EpiSwiGLU E{WSP(bf16_t, WS_ACT)}; \
        gemm_phase<EpiSwiGLU, MoeOrder, true, true>(F.lds, g, S, E); \
    } SEAM((pb) + 2); \
    if (IN((pb) + 3)) REP((pb) + 3) {     \
        Gemm g{WSP(bf16_t, WS_ACT), WSP(bf16_t, WS_WD) + (size_t)(layer) * NE * 2048 * FFD, MROWS, 2048, FFD}; MoeOrder S{F.G, (int)blockIdx.x}; \
        EpiBf16Plain E{WSP(bf16_t, WS_Y), DM, 7}; \
        gemm_phase<EpiBf16Plain, MoeOrder, true, true>(F.lds, g, S, E); \
    } SEAM((pb) + 3);
    MOE_PHASES(0, 7)
    if (IN(11)) REP(11) { p12_combine_norm<false>(F, 0); } SEAM(11);
    if (IN(12)) REP(12) {
        Gemm g{WSP(bf16_t, WS_HYWIN), Hb, 3 * DM, MX, DM}; StaticOrder S; S.init(3 * DM, MX, F.G, (int)blockIdx.x);
        EpiBf16Plain E{WSP(bf16_t, WS_U), MX, 0x7fffffff};
        gemm_phase<EpiBf16Plain, StaticOrder, true, true>(F.lds, g, S, E);
    } SEAM(12);
    if (IN(13)) REP(13) { p14_hyena_conv(F); } SEAM(13);
    if (IN(14)) REP(14) { p15_transpose(F); } SEAM(14);
    if (IN(15)) REP(15) {
        Gemm g{WSP(bf16_t, WS_Z), WSP(bf16_t, WS_HYWOUT), MX, DM, DM}; StaticOrder S; S.init(MX, DM, F.G, (int)blockIdx.x);
        EpiResid E{WSP(float, WS_X1), WSP(float, WS_X1), mod + 3 * 6 * DM + 2 * DM, 6 * DM};
        gemm_phase<EpiResid, StaticOrder, true, true>(F.lds, g, S, E);
    } SEAM(15);
    MOE_PHASES(1, 16)
    if (IN(20)) REP(20) { p12_combine_norm<true>(F, 1); }
#undef MOE_PHASES
#undef IN
#undef SEAM
}

extern "C" void kernel_launch(void* const* d_in, const int* in_sizes, int n_in, void* d_out, int out_size, void* d_ws, size_t ws_size, hipStream_t stream) {
    static int grid = 0;
    if (grid == 0) {
        if (n_in != 30 || out_size != MX * DM || ws_size < WS_END) { fprintf(stderr, "kernel_launch: shape/workspace mismatch: n_in %d out %d ws %zu (need %zu)\n", n_in, out_size, ws_size, (size_t)WS_END); grid = -1; return; }
        int dev = 0, cus = 0, per_cu = 0;
        if (hipGetDevice(&dev) != hipSuccess || hipDeviceGetAttribute(&cus, hipDeviceAttributeMultiprocessorCount, dev) != hipSuccess) { grid = -1; return; }
        if (hipFuncSetAttribute((const void*)mk_fwd, hipFuncAttributeMaxDynamicSharedMemorySize, LDS_BYTES) != hipSuccess) { fprintf(stderr, "kernel_launch: hipFuncSetAttribute failed\n"); grid = -1; return; }
        if (hipOccupancyMaxActiveBlocksPerMultiprocessor(&per_cu, (const void*)mk_fwd, NWAVES * 64, LDS_BYTES) != hipSuccess || per_cu < 1) { fprintf(stderr, "kernel_launch: occupancy query says %d blocks per CU\n", per_cu); }
        (void)hipGetLastError();
        grid = cus;
    }
    if (grid < 0) return;
    if (hipMemsetAsync((char*)d_ws + WS_CTL, 0, CTL_ZERO_BYTES, stream) != hipSuccess) return;
    Args a{};
    for (int i = 0; i < 30; ++i) a.in[i] = (const float*)d_in[i];
    a.out = (float*)d_out; a.ws = (unsigned char*)d_ws;
#if MK_SINGLE
    a.ph_lo = 0; a.ph_hi = NPHASE;
    hipLaunchKernelGGL(mk_fwd, dim3(grid), dim3(NWAVES * 64), LDS_BYTES, stream, a);
#else
    for (int p = 0; p < NPHASE; ++p) { a.ph_lo = p; a.ph_hi = p + 1; hipLaunchKernelGGL(mk_fwd, dim3(grid), dim3(NWAVES * 64), LDS_BYTES, stream, a); }
#endif
    const hipError_t le = hipPeekAtLastError();
    if (le != hipSuccess) fprintf(stderr, "kernel_launch: launch failed: %s\n", hipGetErrorName(le));
}
```

```cpp
#include <hip/hip_runtime.h>
#include <cstdio>
#include <cstdint>
namespace pg8 {
#define PG8_LAS __attribute__((address_space(3)))
typedef unsigned short bf16_t;
typedef short bf16x8 __attribute__((ext_vector_type(8)));
typedef float f32x4 __attribute__((ext_vector_type(4)));
typedef unsigned u32x4 __attribute__((ext_vector_type(4)));
constexpr int BM = 256, BK = 64, HALF = 128, HTB = HALF * BK * 2  , STAGE_BYTES = 8 * HTB, NXCD = 8, WGM = 8;

__host__ __device__ __forceinline__ int lds_byte(int r, int c) { const int st = (r >> 4) * 2 + (c >> 5), rr = r & 15, cc = c & 31, ob = rr * 64 + cc * 2; return st * 1024 + (ob ^ (((ob >> 9) & 1) << 5)); }
__host__ __device__ __forceinline__ void stage_rc(int b, int& R, int& C) { const int st = b / 1024, sb = b % 1024, swz = sb ^ (((sb >> 9) & 1) << 5); R = (st >> 1) * 16 + swz / 64; C = (st & 1) * 32 + (swz % 64) / 2; }
__host__ __device__ __forceinline__ int perm32(int rho) { const int n = rho >> 4, i = rho & 15; return 8 * (i >> 2) + 4 * n + (i & 3); }

struct Unit { int pm, pn; };
struct Gemm { const bf16_t* A; const bf16_t* Bt; int M, N, K; };

struct StaticOrder {
    int nM, nN, nwg, G, c;
    __host__ __device__ void init(int M, int N, int G_, int c_) { nM = M / BM; nN = N / BM; nwg = nM * nN; G = G_; c = c_; }
    __host__ __device__ bool next(int i, Unit& u) const {
        const long L = (long)i * G + c; if (L >= nwg) return false;
        int wgid = (int)L; { const int q = nwg / NXCD, r = nwg % NXCD, xcd = wgid % NXCD, off = wgid / NXCD; wgid = (xcd < r ? xcd * (q + 1) : r * (q + 1) + (xcd - r) * q) + off; }
        const int nig = WGM * nN, gid = wgid / nig, fm = gid * WGM, gsz = (nM - fm) < WGM ? (nM - fm) : WGM;
        u.pm = fm + ((wgid % nig) % gsz); u.pn = (wgid % nig) / gsz; return true;
    }
    __device__ __forceinline__ void a_ready(const Unit&) const {}
    __device__ __forceinline__ void done(const Unit&) const {}
};

__device__ __forceinline__ unsigned cvt_pk_bf16(float lo, float hi) { unsigned r; asm volatile("v_cvt_pk_bf16_f32 %0, %1, %2" : "=v"(r) : "v"(lo), "v"(hi)); return r; }
typedef float f32x2 __attribute__((ext_vector_type(2)));
struct EpiF32Plain {
    static constexpr bool PERM = false, AFTER_DRAIN = false;
    float* C; int ldc; int pn_mask;
    __device__ __forceinline__ void operator()(const f32x4 (&acc)[2][2][4][2], const Unit& u, int wr, int wc, int fr, int fq) const {
        const int row0 = u.pm * BM + wr * 64 + fr, col0 = (u.pn & pn_mask) * BM + wc * 32 + 4 * fq;
#pragma unroll
        for (int ai = 0; ai < 2; ++ai)
#pragma unroll
            for (int m = 0; m < 4; ++m) { float* rowp = C + (size_t)(row0 + ai * HALF + m * 16) * ldc + col0;
#pragma unroll
                for (int bj = 0; bj < 2; ++bj)
#pragma unroll
                    for (int n = 0; n < 2; ++n) *(f32x4*)(rowp + bj * HALF + n * 16) = acc[ai][bj][m][n]; }
    }
};
struct EpiBf16Plain {
    static constexpr bool PERM = true, AFTER_DRAIN = false;
    bf16_t* O; int ldc; int pn_mask;
    __device__ __forceinline__ void operator()(const f32x4 (&acc)[2][2][4][2], const Unit& u, int wr, int wc, int fr, int fq) const {
        const int row0 = u.pm * BM + wr * 64 + fr, col0 = (u.pn & pn_mask) * BM + wc * 32 + 8 * fq;
#pragma unroll
        for (int ai = 0; ai < 2; ++ai)
#pragma unroll
            for (int m = 0; m < 4; ++m) { bf16_t* rowp = O + (size_t)(row0 + ai * HALF + m * 16) * ldc + col0;
#pragma unroll
                for (int bj = 0; bj < 2; ++bj) { const f32x4 v0 = acc[ai][bj][m][0], v1 = acc[ai][bj][m][1];
                    u32x4 w; w.x = cvt_pk_bf16(v0[0], v0[1]); w.y = cvt_pk_bf16(v0[2], v0[3]); w.z = cvt_pk_bf16(v1[0], v1[1]); w.w = cvt_pk_bf16(v1[2], v1[3]);
                    *(u32x4*)(rowp + bj * HALF) = w; } }
    }
};
struct EpiQRope {
    static constexpr bool PERM = true, AFTER_DRAIN = false;
    bf16_t* O; const float* cs;
    __device__ __forceinline__ void operator()(const f32x4 (&acc)[2][2][4][2], const Unit& u, int wr, int wc, int fr, int fq) const {
        const int row0 = u.pm * BM + wr * 64 + fr;
#pragma unroll
        for (int ai = 0; ai < 2; ++ai)
#pragma unroll
            for (int m = 0; m < 4; ++m) { const int row = row0 + ai * HALF + m * 16; const int bb = row >= 4352 ? 1 : 0; const int l = row - bb * 4352; const bool lat = l < 4096; const int lp = lat ? l : 0;
#pragma unroll
                for (int bj = 0; bj < 2; ++bj) { const int c0 = u.pn * BM + bj * HALF + wc * 32 + 8 * fq; const int hh = c0 / 192, jj = c0 - hh * 192;
                    f32x4 v0 = acc[ai][bj][m][0], v1 = acc[ai][bj][m][1];
                    if (jj >= 128 && lat) { const f32x4* cp = (const f32x4*)(cs + ((size_t)lp * 32 + ((jj - 128) >> 1)) * 2); const f32x4 ca = cp[0], cb = cp[1];
                        const f32x4 a = v0, b = v1;
                        v0[0] = a[0] * ca[0] - a[1] * ca[1]; v0[1] = a[1] * ca[0] + a[0] * ca[1]; v0[2] = a[2] * ca[2] - a[3] * ca[3]; v0[3] = a[3] * ca[2] + a[2] * ca[3];
                        v1[0] = b[0] * cb[0] - b[1] * cb[1]; v1[1] = b[1] * cb[0] + b[0] * cb[1]; v1[2] = b[2] * cb[2] - b[3] * cb[3]; v1[3] = b[3] * cb[2] + b[2] * cb[3]; }
                    u32x4 w; w.x = cvt_pk_bf16(v0[0], v0[1]); w.y = cvt_pk_bf16(v0[2], v0[3]); w.z = cvt_pk_bf16(v1[0], v1[1]); w.w = cvt_pk_bf16(v1[2], v1[3]);
                    *(u32x4*)(O + (size_t)row * 3072 + c0) = w; } }
    }
};
struct EpiResid {
    static constexpr bool PERM = false, AFTER_DRAIN = false;
    const float* base; float* out; const float* gate; int gstride;
    __device__ __forceinline__ void operator()(const f32x4 (&acc)[2][2][4][2], const Unit& u, int wr, int wc, int fr, int fq) const {
        const int row0 = u.pm * BM + wr * 64 + fr, col0 = u.pn * BM + wc * 32 + 4 * fq; const float* gp = gate + (size_t)(u.pm >> 4) * gstride + col0;
        f32x4 gv[2][2];
#pragma unroll
        for (int bj = 0; bj < 2; ++bj)
#pragma unroll
            for (int n = 0; n < 2; ++n) gv[bj][n] = *(const f32x4*)(gp + bj * HALF + n * 16);
#pragma unroll
        for (int ai = 0; ai < 2; ++ai)
#pragma unroll
            for (int m = 0; m < 4; ++m) { const size_t off = (size_t)(row0 + ai * HALF + m * 16) * 2048 + col0;
#pragma unroll
                for (int bj = 0; bj < 2; ++bj)
#pragma unroll
                    for (int n = 0; n < 2; ++n) { const f32x4 bs = *(const f32x4*)(base + off + bj * HALF + n * 16); *(f32x4*)(out + off + bj * HALF + n * 16) = bs + gv[bj][n] * acc[ai][bj][m][n]; }
                asm volatile("" ::: "memory"); }
    }
};
struct EpiSwiGLU {
    static constexpr bool PERM = true, AFTER_DRAIN = false;
    bf16_t* O;
    __device__ __forceinline__ float silu(float g) const { return g * __builtin_amdgcn_rcpf(1.0f + __builtin_amdgcn_exp2f(-1.4426950408889634f * g)); }
    __device__ __forceinline__ void operator()(const f32x4 (&acc)[2][2][4][2], const Unit& u, int wr, int wc, int fr, int fq) const {
        const int row0 = u.pm * BM + wr * 64 + fr, col0 = (u.pn & 7) * 128 + wc * 32 + 8 * fq;
#pragma unroll
        for (int ai = 0; ai < 2; ++ai)
#pragma unroll
            for (int m = 0; m < 4; ++m) { const f32x4 g0 = acc[ai][0][m][0], g1 = acc[ai][0][m][1], u0 = acc[ai][1][m][0], u1 = acc[ai][1][m][1];
                u32x4 w; w.x = cvt_pk_bf16(silu(g0[0]) * u0[0], silu(g0[1]) * u0[1]); w.y = cvt_pk_bf16(silu(g0[2]) * u0[2], silu(g0[3]) * u0[3]);
                w.z = cvt_pk_bf16(silu(g1[0]) * u1[0], silu(g1[1]) * u1[1]); w.w = cvt_pk_bf16(silu(g1[2]) * u1[2], silu(g1[3]) * u1[3]);
                *(u32x4*)(O + (size_t)(row0 + ai * HALF + m * 16) * 1024 + col0) = w; }
    }
};
struct HfOrder {
    int G, c, skip;
    __device__ __forceinline__ bool next(int i, Unit& u) const {
        int L;
        if (G > skip + 8) { if (c < skip) return false; L = (c - skip) + i * (G - skip); } else L = i * G + c;
        if (L >= 512) return false;
        const int dir = L >> 8, w = L & 255; u.pm = dir * 16 + (w & 15); u.pn = dir * 16 + (w >> 4); return true;
    }
    __device__ __forceinline__ void a_ready(const Unit&) const {}
    __device__ __forceinline__ void done(const Unit&) const {}
};
struct MoeOrder {
    int G, c;
    __device__ __forceinline__ bool next(int i, Unit& u) const {
        int e, j;
        if (G == 256) { if (i >= 2) return false; e = i * 8 + (c & 7); j = c >> 3; }
        else { const int L = i * G + c; if (L >= 512) return false; e = L >> 5; j = L & 31; }
        u.pm = e * 4 + (j & 3); u.pn = e * 8 + (j >> 2); return true;
    }
    __device__ __forceinline__ void a_ready(const Unit&) const {}
    __device__ __forceinline__ void done(const Unit&) const {}
};

template <class Epi, class Sched, bool ALIGN_EPI = false, bool SP2 = false>
__device__ __forceinline__ void gemm_phase(PG8_LAS unsigned char* lds, const Gemm g, const Sched& S, const Epi& E) {
    const int tid = threadIdx.x, wid = __builtin_amdgcn_readfirstlane(tid >> 6), lane = tid & 63, wr = wid >> 2, wc = wid & 3, fr = lane & 15, fq = lane >> 4;
    const int K = g.K, nt = K / BK;
    unsigned voffA[2], voffB[2];
#pragma unroll
    for (int i = 0; i < 2; ++i) { int R, C; stage_rc(tid * 16 + i * 8192, R, C); const int Rb = Epi::PERM ? ((R & ~31) + perm32(R & 31)) : R;
        voffA[i] = (unsigned)(R * K + C) * 2u; voffB[i] = (unsigned)(Rb * K + C) * 2u; }
    const size_t kstep = (size_t)(BK * 2);
    const size_t hstep = (size_t)HALF * K * 2;
    const size_t tstep = 2 * hstep;
    const unsigned ldsw = (unsigned)wid * 1024u;
    const int aoff = lds_byte(wr * 64 + fr, fq * 8), boff = lds_byte(wc * 32 + fr, fq * 8);
#define PG8_SA(b, h) (((b) * 2 + (h)) * HTB)
#define PG8_SB(b, h) ((4 + (b) * 2 + (h)) * HTB)
#define PG8_STAGE(bufoff, gbase, voff) do { _Pragma("unroll") for (int _i = 0; _i < 2; ++_i) \
        __builtin_amdgcn_global_load_lds((const unsigned*)((const char*)(gbase) + (voff)[_i]), (PG8_LAS unsigned*)(lds + (bufoff) + ldsw + _i * 8192), 16, 0, 0); } while (0)
#define PG8_LDA(dst, b, h) do { _Pragma("unroll") for (int m = 0; m < 4; ++m) _Pragma("unroll") for (int k = 0; k < 2; ++k) dst[m][k] = *(const PG8_LAS bf16x8*)(lds + PG8_SA(b, h) + aoff + m * 2048 + k * 1024); } while (0)
#define PG8_LDB(dst, b, h) do { _Pragma("unroll") for (int n = 0; n < 2; ++n) _Pragma("unroll") for (int k = 0; k < 2; ++k) dst[n][k] = *(const PG8_LAS bf16x8*)(lds + PG8_SB(b, h) + boff + n * 2048 + k * 1024); } while (0)
#define PG8_MMA(ai, bj, At, Bt) do { __builtin_amdgcn_s_setprio(1); _Pragma("unroll") for (int m = 0; m < 4; ++m) _Pragma("unroll") for (int n = 0; n < 2; ++n) _Pragma("unroll") for (int k = 0; k < 2; ++k) \
        acc[ai][bj][m][n] = __builtin_amdgcn_mfma_f32_16x16x32_bf16(Bt[n][k], At[m][k], acc[ai][bj][m][n], 0, 0, 0); __builtin_amdgcn_s_setprio(0); } while (0)
#define PG8_WAIT_V(n) asm volatile("s_waitcnt vmcnt(" #n ")" ::: "memory")
#define PG8_WAIT_L(n) asm volatile("s_waitcnt lgkmcnt(" #n ")" ::: "memory")
#define PG8_BAR __builtin_amdgcn_s_barrier()
#define PG8_SCHED __builtin_amdgcn_sched_barrier(0)
    Unit cur, nxt; int ui = 0;
    if (!S.next(0, cur)) return;
    f32x4 acc[2][2][4][2];
#pragma unroll
    for (int a = 0; a < 2; ++a)
#pragma unroll
        for (int b = 0; b < 2; ++b)
#pragma unroll
            for (int m = 0; m < 4; ++m)
#pragma unroll
                for (int n = 0; n < 2; ++n) acc[a][b][m][n] = (f32x4){0.f, 0.f, 0.f, 0.f};
    bf16x8 At[4][2], B0[2][2], B1[2][2];
    const char* cA = (const char*)g.A + (size_t)cur.pm * tstep; const char* cB = (const char*)g.Bt + (size_t)cur.pn * tstep;
    S.a_ready(cur);
    if constexpr (SP2) {
        PG8_STAGE(PG8_SB(0, 0), cB, voffB); PG8_STAGE(PG8_SB(0, 1), cB + hstep, voffB); PG8_STAGE(PG8_SA(0, 0), cA, voffA); PG8_STAGE(PG8_SA(0, 1), cA + hstep, voffA);
        if (wr == 1) PG8_BAR;
        PG8_WAIT_V(2); PG8_BAR;
        PG8_STAGE(PG8_SB(1, 0), cB + kstep, voffB); PG8_STAGE(PG8_SA(1, 0), cA + kstep, voffA); PG8_STAGE(PG8_SB(1, 1), cB + hstep + kstep, voffB);
        PG8_WAIT_V(6); PG8_BAR;
    } else {
        PG8_STAGE(PG8_SB(0, 0), cB, voffB); PG8_STAGE(PG8_SA(0, 0), cA, voffA); PG8_STAGE(PG8_SB(0, 1), cB + hstep, voffB); PG8_STAGE(PG8_SA(0, 1), cA + hstep, voffA);
        if (wr == 1) PG8_BAR;
        PG8_WAIT_V(4); PG8_BAR;
        PG8_STAGE(PG8_SB(1, 0), cB + kstep, voffB); PG8_STAGE(PG8_SA(1, 0), cA + kstep, voffA); PG8_STAGE(PG8_SB(1, 1), cB + hstep + kstep, voffB);
        PG8_WAIT_V(6); PG8_BAR;
    }
    for (;;) {
        const bool has_next = S.next(ui + 1, nxt);
        const char* nA = has_next ? (const char*)g.A + (size_t)nxt.pm * tstep : cA; const char* nB = has_next ? (const char*)g.Bt + (size_t)nxt.pn * tstep : cB;
        for (int t = 0; t < nt; t += 2) {
            const bool last = (t == nt - 2);
            const char* a1 = cA + (size_t)(t + 1) * kstep;
            const char* a2 = last ? nA : cA + (size_t)(t + 2) * kstep; const char* b2 = last ? nB : cB + (size_t)(t + 2) * kstep;
            const char* a3 = a2 + kstep; const char* b3 = b2 + kstep;
            if (last && has_next) S.a_ready(nxt);
            if constexpr (SP2) {
            PG8_LDB(B0, 0, 0); PG8_LDB(B1, 0, 1); PG8_SCHED; PG8_LDA(At, 0, 0); PG8_STAGE(PG8_SA(1, 1), a1 + hstep, voffA);
            PG8_WAIT_V(8); PG8_WAIT_L(0); PG8_BAR; PG8_MMA(0, 0, At, B0); PG8_MMA(0, 1, At, B1); PG8_BAR; PG8_SCHED;
            PG8_LDA(At, 0, 1); PG8_STAGE(PG8_SB(0, 0), b2, voffB); PG8_STAGE(PG8_SB(0, 1), b2 + hstep, voffB); PG8_STAGE(PG8_SA(0, 0), a2, voffA);
            PG8_WAIT_V(8); PG8_WAIT_L(0); PG8_BAR; PG8_MMA(1, 0, At, B0); PG8_MMA(1, 1, At, B1); PG8_BAR; PG8_SCHED;
            PG8_LDB(B0, 1, 0); PG8_LDB(B1, 1, 1); PG8_SCHED; PG8_LDA(At, 1, 0); PG8_STAGE(PG8_SA(0, 1), a2 + hstep, voffA);
            PG8_WAIT_V(8); PG8_WAIT_L(0); PG8_BAR; PG8_MMA(0, 0, At, B0); PG8_MMA(0, 1, At, B1); PG8_BAR; PG8_SCHED;
            PG8_LDA(At, 1, 1); PG8_STAGE(PG8_SB(1, 0), b3, voffB); PG8_STAGE(PG8_SB(1, 1), b3 + hstep, voffB); PG8_STAGE(PG8_SA(1, 0), a3, voffA);
            PG8_WAIT_V(8); PG8_WAIT_L(0); PG8_BAR; PG8_MMA(1, 0, At, B0); PG8_MMA(1, 1, At, B1); PG8_BAR; PG8_SCHED;
            } else {
            PG8_LDB(B0, 0, 0); PG8_SCHED; PG8_LDA(At, 0, 0); PG8_STAGE(PG8_SA(1, 1), a1 + hstep, voffA);
            PG8_WAIT_L(8); PG8_BAR; PG8_WAIT_L(0); PG8_MMA(0, 0, At, B0); PG8_BAR; PG8_SCHED;
            PG8_LDB(B1, 0, 1); PG8_STAGE(PG8_SB(0, 0), b2, voffB);
            PG8_BAR; PG8_WAIT_L(0); PG8_MMA(0, 1, At, B1); PG8_BAR;
            PG8_LDA(At, 0, 1); PG8_STAGE(PG8_SA(0, 0), a2, voffA);
            PG8_BAR; PG8_WAIT_L(0); PG8_MMA(1, 0, At, B0); PG8_BAR; PG8_SCHED;
            PG8_STAGE(PG8_SB(0, 1), b2 + hstep, voffB);
            PG8_WAIT_V(6); PG8_BAR; PG8_MMA(1, 1, At, B1); PG8_BAR;
            PG8_LDB(B0, 1, 0); PG8_SCHED; PG8_LDA(At, 1, 0); PG8_STAGE(PG8_SA(0, 1), a2 + hstep, voffA);
            PG8_WAIT_L(8); PG8_BAR; PG8_WAIT_L(0); PG8_MMA(0, 0, At, B0); PG8_BAR; PG8_SCHED;
            PG8_LDB(B1, 1, 1); PG8_STAGE(PG8_SB(1, 0), b3, voffB);
            PG8_BAR; PG8_WAIT_L(0); PG8_MMA(0, 1, At, B1); PG8_BAR;
            PG8_LDA(At, 1, 1); PG8_STAGE(PG8_SA(1, 0), a3, voffA);
            PG8_BAR; PG8_WAIT_L(0); PG8_MMA(1, 0, At, B0); PG8_BAR; PG8_SCHED;
            PG8_STAGE(PG8_SB(1, 1), b3 + hstep, voffB);
            PG8_WAIT_V(6); PG8_BAR; PG8_MMA(1, 1, At, B1); PG8_BAR;
            }
        }
        if constexpr (ALIGN_EPI) { if (wr == 0) PG8_BAR; }
        if constexpr (!Epi::AFTER_DRAIN) { E(acc, cur, wr, wc, fr, fq); S.done(cur); }
        if (!has_next) break;
#pragma unroll
        for (int a = 0; a < 2; ++a)
#pragma unroll
            for (int b = 0; b < 2; ++b)
#pragma unroll
                for (int m = 0; m < 4; ++m)
#pragma unroll
                    for (int n = 0; n < 2; ++n) acc[a][b][m][n] = (f32x4){0.f, 0.f, 0.f, 0.f};
        cur = nxt; cA = nA; cB = nB; ++ui;
        if constexpr (ALIGN_EPI) { if (wr == 1) PG8_BAR; }
    }
    PG8_WAIT_V(0);
    if constexpr (!ALIGN_EPI) { if (wr == 0) PG8_BAR; }
    PG8_BAR;
    if constexpr (Epi::AFTER_DRAIN) { E.fused(acc, cur, wr, wc, fr, fq, lds, wid, lane); S.done(cur); }
#undef PG8_SA
#undef PG8_SB
#undef PG8_STAGE
#undef PG8_LDA
#undef PG8_LDB
#undef PG8_MMA
#undef PG8_WAIT_V
#undef PG8_WAIT_L
#undef PG8_BAR
#undef PG8_SCHED
}
}
#define GAS __attribute__((address_space(1)))
#define LAS __attribute__((address_space(3)))
typedef unsigned short bf16;
typedef unsigned v4u __attribute__((ext_vector_type(4)));
typedef unsigned v2u __attribute__((ext_vector_type(2)));
typedef float f32x4 __attribute__((ext_vector_type(4)));
typedef float f32x2 __attribute__((ext_vector_type(2)));
typedef float f32x16 __attribute__((ext_vector_type(16)));
typedef short bf16x8 __attribute__((ext_vector_type(8)));
typedef short s16x4 __attribute__((ext_vector_type(4)));
typedef GAS unsigned gu32;
#define RLX_AGENT __ATOMIC_RELAXED, __HIP_MEMORY_SCOPE_AGENT
#define LDS_WAIT() asm volatile("s_waitcnt lgkmcnt(0)" ::: "memory")
#define VM_WAIT() asm volatile("s_waitcnt vmcnt(0)" ::: "memory")
__device__ __forceinline__ unsigned pk2(float lo, float hi) { unsigned r; asm volatile("v_cvt_pk_bf16_f32 %0, %1, %2" : "=v"(r) : "v"(lo), "v"(hi)); return r; }
__device__ __forceinline__ float bf_lo(unsigned w) { return __uint_as_float(w << 16); }
__device__ __forceinline__ float bf_hi(unsigned w) { return __uint_as_float(w & 0xffff0000u); }
__device__ __forceinline__ float bf1(bf16 h) { return __uint_as_float(((unsigned)h) << 16); }
__device__ __forceinline__ int opq(int x) { asm volatile("" : "+v"(x)); return x; }
__device__ __forceinline__ float wave_sum(float v) {
#pragma unroll
    for (int o = 1; o < 64; o <<= 1) v += __shfl_xor(v, o);
    return v;
}
__device__ __forceinline__ int wave_sum_i(int v) {
#pragma unroll
    for (int o = 1; o < 64; o <<= 1) v += __shfl_xor(v, o);
    return v;
}

#define XB_TMO      128
#define XB_XCNT(j)  (256  + 64 * (j))
#define XB_XSUB(j)  (1280 + 64 * (j))
#define XB_XGEN(j)  (2304 + 64 * (j))
#define XB_TOP      3328
#define XB_TOPGEN   3392
#define XCD_BAR_WORDS 3456
#define XB_SPIN_CAP (1u << 18)

__device__ __forceinline__ unsigned xb_ld(unsigned* p)              { return __hip_atomic_load(p, __ATOMIC_RELAXED, __HIP_MEMORY_SCOPE_AGENT); }
__device__ __forceinline__ unsigned xb_add(unsigned* p, unsigned v) { return __hip_atomic_fetch_add(p, v, __ATOMIC_RELAXED, __HIP_MEMORY_SCOPE_AGENT); }
__device__ __forceinline__ unsigned xb_xcc_id() { return (unsigned)__builtin_amdgcn_s_getreg((3 << 11) | 20) & 0xFu; }
#define XB_SPIN(cond, bar) do { unsigned _sp = 0; while (cond) { __builtin_amdgcn_s_sleep(1); \
    if ((++_sp & 255u) == 0u) { if (xb_ld(&(bar)[XB_TMO])) break; if (_sp > XB_SPIN_CAP) { atomicAdd(&(bar)[XB_TMO], 1u); break; } } } } while (0)

struct XcdBarrier {
    unsigned* bar; unsigned x;
    volatile LAS unsigned* st;
};

__device__ __forceinline__ XcdBarrier xcd_barrier_post(unsigned* bar, volatile LAS unsigned* st) {
    XcdBarrier b; b.bar = bar; b.x = xb_xcc_id(); b.st = st;
    if (threadIdx.x == 0) (void)xb_add(&bar[XB_XCNT(b.x)], 1u);
    return b;
}
__device__ __forceinline__ void xcd_barrier_complete(unsigned* bar, unsigned x, unsigned& nloc, unsigned& nx) {
    const unsigned G = gridDim.x * gridDim.y * gridDim.z;
    unsigned sum, cnt, mine, sp = 0u;
    for (;;) {
        sum = 0u; cnt = 0u; mine = 0u;
#pragma unroll
        for (unsigned j = 0; j < 16; ++j) { const unsigned c = xb_ld(&bar[XB_XCNT(j)]); sum += c; cnt += (c > 0u) ? 1u : 0u; mine = (j == x) ? c : mine; }
        if (sum == G) break;
        __builtin_amdgcn_s_sleep(1);
        if ((++sp & 255u) == 0u) { if (xb_ld(&bar[XB_TMO])) break; if (sp > XB_SPIN_CAP) { atomicAdd(&bar[XB_TMO], 1u); break; } }
    }
    nloc = mine > 0u ? mine : 1u; nx = cnt > 0u ? cnt : 1u;
}

__device__ __forceinline__ void xcd_barrier(const XcdBarrier& b) {
    asm volatile("s_waitcnt vmcnt(0)" ::: "memory");
    __syncthreads();
    if (threadIdx.x == 0) {
        unsigned* bar = b.bar;
        __builtin_amdgcn_s_waitcnt(0);
        unsigned nloc = b.st[0], nx = b.st[1];
        if (nloc == 0u) { xcd_barrier_complete(bar, b.x, nloc, nx); b.st[0] = nloc; b.st[1] = nx; }
        const unsigned old = xb_add(&bar[XB_XSUB(b.x)], 1u);
        const unsigned gen = old / nloc;
        if (old + 1u == (gen + 1u) * nloc) {
            __builtin_amdgcn_fence(__ATOMIC_RELEASE, "agent");
            asm volatile("s_waitcnt vmcnt(0)" ::: "memory");
            const unsigned og = xb_add(&bar[XB_TOP], 1u);
            const unsigned tg = og / nx;
            if (og + 1u == (tg + 1u) * nx) xb_add(&bar[XB_TOPGEN], 1u);
            else XB_SPIN(xb_ld(&bar[XB_TOPGEN]) == tg, bar);
            __builtin_amdgcn_fence(__ATOMIC_ACQUIRE, "agent");
            xb_add(&bar[XB_XGEN(b.x)], 1u);
            asm volatile("s_waitcnt vmcnt(0)" ::: "memory");
        } else {
            XB_SPIN(xb_ld(&bar[XB_XGEN(b.x)]) == gen, bar);
            __builtin_amdgcn_fence(__ATOMIC_ACQUIRE, "agent");
            asm volatile("s_waitcnt vmcnt(0)" ::: "memory");
        }
    }
    __syncthreads();
}

constexpr int NWAVES = 8;
constexpr int DM = 2048, NB = 2, SEQ = 4096, CTXL = 256, LT = SEQ + CTXL  , MT = NB * LT  , MX = NB * SEQ  ;
constexpr int NH = 16, QRANK = 512, KVRANK = 256, INDIM = 832, INPAD = 1024, QW = NH * 192  , KVW = NH * 256  ;
constexpr int NE = 16, CAP = 512, FFD = 1024, MROWS = NB * NE * CAP  ;
constexpr float EPS = 1e-6f;
constexpr size_t MiB = 1u << 20;
constexpr size_t WS_CTL = 0, CTL_ZERO_BYTES = 1 * MiB;
constexpr size_t WS_MOD = 64 * 1024;
constexpr size_t WS_CS = 1 * MiB, WS_A2S = 2 * MiB  , WS_A2RS = 4 * MiB  , WS_W3S = 58 * MiB  , WS_TW = 6 * MiB  , WS_AFF = 7 * MiB  , WS_TOK = 7 * MiB + 512 * 1024  ;
constexpr size_t WS_WIN = 8 * MiB, WS_WUQ = 12 * MiB, WS_WUKV = 15 * MiB, WS_WO = 17 * MiB, WS_HYWOUT = 25 * MiB, WS_HYWIN = 33 * MiB;
constexpr size_t WS_WGU = 64 * MiB  , WS_WD = 320 * MiB  ;
constexpr size_t WS_H = 448 * MiB  , WS_PROJ = 482 * MiB  , WS_CQN = 516 * MiB, WS_CKVN = 525 * MiB, WS_KROPE = 530 * MiB;
constexpr size_t WS_Q = 532 * MiB, WS_KV = 583 * MiB, WS_O = 651 * MiB, WS_X1 = 683 * MiB  , WS_XG = 747 * MiB, WS_ACT = 811 * MiB, WS_Y = 843 * MiB, WS_HF = 907 * MiB  , WS_END = 1035 * MiB;
constexpr size_t WS_U = 532 * MiB  , WS_ZT = 628 * MiB  , WS_Z = 482 * MiB  ;
constexpr int CW_TMO = 0, CW_BAR = 4096;
constexpr int LDS_BYTES = 155648, MISC_OFF = 153600;
constexpr int NPHASE = 21;

struct Frame {
    LAS unsigned char* lds; unsigned char* ldsg;
    int tid, wave, vcu, G;
    float* out; unsigned char* ws;
};
__device__ __forceinline__ const float* arg_in(int i) {
    const __attribute__((address_space(4))) unsigned long long* ka = (const __attribute__((address_space(4))) unsigned long long*)__builtin_amdgcn_kernarg_segment_ptr();
    asm volatile("" : "+s"(ka));
    return (const float*)(const __attribute__((address_space(1))) float*)ka[i];
}
#define WSP(T, off) ((T*)(F.ws + (off)))

__device__ __forceinline__ int uq_srccol(int n) { const int hh = n / 192, jj = n - hh * 192; if (jj < 128) return n; const int r = jj - 128; return hh * 192 + 128 + (r >> 1) + 32 * (r & 1); }
template <bool VEC>
__device__ __forceinline__ void transpose_item(const float* src, int N, int c0, int k0, bf16* dst, int K, LAS float* scr, int lane) {
    if constexpr (VEC) {
        const float* s = src + (size_t)k0 * N + c0 + (lane & 15) * 4;
        f32x4 v[16];
#pragma unroll
        for (int i = 0; i < 16; ++i) v[i] = __builtin_nontemporal_load((const f32x4*)(s + (size_t)(4 * i + (lane >> 4)) * N));
#pragma unroll
        for (int i = 0; i < 16; ++i) { LAS float* d = scr + (4 * i + (lane >> 4)) * 65 + (lane & 15) * 4; d[0] = v[i][0]; d[1] = v[i][1]; d[2] = v[i][2]; d[3] = v[i][3]; }
    } else {
        const int sc = uq_srccol(c0 + lane);
        const float* s = src + (size_t)k0 * N + sc;
#pragma unroll 16
        for (int kk = 0; kk < 64; ++kk) scr[kk * 65 + lane] = s[(size_t)kk * N];
    }
    LDS_WAIT(); asm volatile("" ::: "memory");
    const int c = lane & 7;
#pragma unroll
    for (int jj = 0; jj < 8; ++jj) { const int n = (lane >> 3) + 8 * jj; const LAS float* s = scr + (8 * c) * 65 + n;
        v4u o; o.x = pk2(s[0 * 65], s[1 * 65]); o.y = pk2(s[2 * 65], s[3 * 65]); o.z = pk2(s[4 * 65], s[5 * 65]); o.w = pk2(s[6 * 65], s[7 * 65]);
        *(v4u*)(dst + (size_t)n * K + k0 + 8 * c) = o; }
    LDS_WAIT(); asm volatile("" ::: "memory");
}
__device__ __forceinline__ float silu_f(float x) { return x / (1.0f + __expf(-x)); }

constexpr int CI0 = 32 * 13, CI1 = 8 * 48, CI2 = 4 * 64, CI_EARLY = CI0 + CI1 + CI2;
constexpr int CI3 = 32 * 32, CI4 = 32 * 32, CI5 = 32 * 96, CI_GU = 32 * 1024, CI_D = 32 * 512, CI_LATE = CI3 + CI4 + CI5 + CI_GU + CI_D;
__device__ __forceinline__ void convert_early(Frame& F) {
    const int lane = opq(F.tid) & 63;
    const int gw = F.vcu * NWAVES + F.wave, NGW = F.G * NWAVES;
    LAS float* scr = (LAS float*)(F.lds + F.wave * 16640);
#pragma unroll 1
    for (int it = gw; it < CI_EARLY; it += NGW) {
        int r = it; const float* src; int N, c0, k0, K; bf16* dst; bool vec = true;
        if (r < CI0) { const int kb = r / 13, nb = r % 13; src = arg_in(8); N = INDIM; c0 = nb * 64; k0 = kb * 64; K = DM; dst = WSP(bf16, WS_WIN) + (size_t)nb * 64 * DM; }
        else if ((r -= CI0) < CI1) { const int kb = r / 48, nb = r % 48; src = arg_in(11); N = QW; c0 = nb * 64; k0 = kb * 64; K = QRANK; dst = WSP(bf16, WS_WUQ) + (size_t)nb * 64 * QRANK; vec = false; }
        else { r -= CI1; const int kb = r / 64, nb = r % 64; src = arg_in(12); N = KVW; c0 = nb * 64; k0 = kb * 64; K = KVRANK; dst = WSP(bf16, WS_WUKV) + (size_t)nb * 64 * KVRANK; }
        if (vec) transpose_item<true>(src, N, c0, k0, dst, K, scr, lane); else transpose_item<false>(src, N, c0, k0, dst, K, scr, lane);
    }
}
struct CvItem { const float* s; bf16* dst; int N, K; };
__device__ __forceinline__ CvItem cv_decode_late(Frame& F, int it, int lane) {
    int r = it; const float* src; int N, c0, k0, K; bf16* dst;
    if (r < CI3) { const int kb = r / 32, nb = r % 32; src = arg_in(13); N = DM; c0 = nb * 64; k0 = kb * 64; K = DM; dst = WSP(bf16, WS_WO) + (size_t)nb * 64 * DM; }
    else if ((r -= CI3) < CI4) { const int kb = r / 32, nb = r % 32; src = arg_in(25); N = DM; c0 = nb * 64; k0 = kb * 64; K = DM; dst = WSP(bf16, WS_HYWOUT) + (size_t)nb * 64 * DM; }
    else if ((r -= CI4) < CI5) { const int kb = r / 96, nb = r % 96; src = arg_in(14); N = 3 * DM; c0 = nb * 64; k0 = kb * 64; K = DM; dst = WSP(bf16, WS_HYWIN) + (size_t)nb * 64 * DM; }
    else if ((r -= CI5) < CI_GU) { const int le = r >> 10, q = r & 1023, kb = q >> 5, nb = q & 31;
        src = (((nb >> 1) & 1) ? arg_in(28) : arg_in(27)) + (size_t)le * DM * FFD; N = FFD; c0 = (nb >> 2) * 128 + (nb & 1) * 64; k0 = kb * 64; K = DM; dst = WSP(bf16, WS_WGU) + ((size_t)le * 2048 + nb * 64) * DM; }
    else { r -= CI_GU; const int le = r >> 9, q = r & 511, kb = q >> 5, nb = q & 31;
        src = arg_in(29) + (size_t)le * FFD * DM; N = DM; c0 = nb * 64; k0 = kb * 64; K = FFD; dst = WSP(bf16, WS_WD) + ((size_t)le * 2048 + nb * 64) * FFD; }
    CvItem d; d.s = src + (size_t)(k0 + (lane >> 4)) * N + c0 + (lane & 15) * 4; d.dst = dst + k0; d.N = N; d.K = K; return d;
}
__device__ __forceinline__ void cv_issue(const CvItem& d, f32x4 (&v)[16]) {
#pragma unroll
    for (int i = 0; i < 16; ++i) v[i] = __builtin_nontemporal_load((const f32x4*)(d.s + (size_t)(4 * i) * d.N));
}
__device__ __forceinline__ void cv_finish(const CvItem& d, const f32x4 (&v)[16], LAS float* scr, int lane) {
#pragma unroll
    for (int i = 0; i < 16; ++i) { LAS float* p = scr + (4 * i + (lane >> 4)) * 65 + (lane & 15) * 4; p[0] = v[i][0]; p[1] = v[i][1]; p[2] = v[i][2]; p[3] = v[i][3]; }
    LDS_WAIT(); asm volatile("" ::: "memory");
    const int c = lane & 7;
#pragma unroll
    for (int jj = 0; jj < 8; ++jj) { const int n = (lane >> 3) + 8 * jj; const LAS float* s = scr + (8 * c) * 65 + n;
        v4u o; o.x = pk2(s[0 * 65], s[1 * 65]); o.y = pk2(s[2 * 65], s[3 * 65]); o.z = pk2(s[4 * 65], s[5 * 65]); o.w = pk2(s[6 * 65], s[7 * 65]);
        *(v4u*)(d.dst + (size_t)n * d.K + 8 * c) = o; }
    LDS_WAIT(); asm volatile("" ::: "memory");
}
__device__ __forceinline__ void convert_late(Frame& F) {
    const int lane = opq(F.tid) & 63;
    const int gw = F.vcu * NWAVES + F.wave, NGW = F.G * NWAVES;
    LAS float* scr = (LAS float*)(F.lds + F.wave * 16640);
    __syncthreads();
    int it = gw; CvItem da, db; f32x4 va[16], vb[16];
    if (it < CI_LATE) { da = cv_decode_late(F, it, lane); cv_issue(da, va); }
#pragma unroll 1
    while (it < CI_LATE) {
        const int it2 = it + NGW; const bool h2 = it2 < CI_LATE;
        if (h2) { db = cv_decode_late(F, it2, lane); cv_issue(db, vb); }
        cv_finish(da, va, scr, lane);
        if (!h2) break;
        const int it3 = it2 + NGW; const bool h3 = it3 < CI_LATE;
        if (h3) { da = cv_decode_late(F, it3, lane); cv_issue(da, va); }
        cv_finish(db, vb, scr, lane);
        it = it3;
    }
    __syncthreads();
}
__device__ __forceinline__ void p0_prologue(Frame& F) {
    const int lane = opq(F.tid) & 63;
#ifndef NO_PA
    convert_early(F);
#endif
    __syncthreads();
#ifndef NO_PB
    {
        LAS float* sv = (LAS float*)F.lds;
        LAS float* part = sv + 3 * DM;
        { const float* cin = arg_in(1); const float* cctx = arg_in(3);
        for (int i = F.tid; i < 3 * DM; i += 512) { const float cv = i < 2 * DM ? cin[i] : cctx[i - 2 * DM]; sv[i] = silu_f(cv); } }
        __syncthreads();
        float* mod = WSP(float, WS_MOD); const float* adaw = arg_in(4); const float* adab = arg_in(5);
        const int q = F.tid % 24, kg = F.tid / 24;
        for (int un = F.vcu; un < 256; un += F.G) {
            const int layer = un >> 7, n0 = (un & 127) * 96;
            const float* W = adaw + (size_t)layer * DM * 6 * DM + n0 + q * 4;
            f32x4 a0 = {0.f, 0.f, 0.f, 0.f}, a1 = a0, a2 = a0;
            if (kg < 21) {
#pragma unroll 8
                for (int k = kg; k < DM; k += 21) { const f32x4 w = *(const f32x4*)(W + (size_t)k * (6 * DM)); a0 += sv[k] * w; a1 += sv[DM + k] * w; a2 += sv[2 * DM + k] * w; }
                LAS float* pp = part + kg * 288 + q * 4;
                *(LAS f32x4*)pp = a0; *(LAS f32x4*)(pp + 96) = a1; *(LAS f32x4*)(pp + 192) = a2;
            }
            __syncthreads();
            if (F.tid < 288) { const int m = F.tid / 96, nn = F.tid % 96; float s = adab[(size_t)layer * 6 * DM + n0 + nn];
#pragma unroll
                for (int g = 0; g < 21; ++g) s += part[g * 288 + F.tid];
                mod[((size_t)layer * 3 + m) * 6 * DM + n0 + nn] = s; }
            __syncthreads();
        }
    }
#endif
    __syncthreads();
#ifndef NO_PC
    {
        LAS float* h1s = (LAS float*)F.lds;
        const float* w1 = arg_in(17); const float* b1 = arg_in(18); const float* w2 = arg_in(19); const float* b2 = arg_in(20); const float* fr = arg_in(23);
        bf16* a2s = WSP(bf16, WS_A2S); bf16* a2rs = WSP(bf16, WS_A2RS);
        const int lp = F.tid >> 6, j = F.tid & 63;
        for (int un = F.vcu; un < SEQ / 8; un += F.G) {
            const int l = un * 8 + lp;
            const float t = (float)l / (float)SEQ, w = 6.283185307179586f * (float)l / (float)SEQ;
            float pre = b1[j] + t * w1[j];
#pragma unroll
            for (int i = 0; i < 16; ++i) { const float band = 1e-4f + (float)i * ((15.0f - 1e-4f) / 15.0f); const float ang = w * band;
                pre += cosf(ang) * w1[(1 + i) * 64 + j] - sinf(ang) * w1[(17 + i) * 64 + j]; }
            const float f = fr[j];
            __syncthreads();
            h1s[lp * 64 + j] = sinf(f * pre);
            __syncthreads();
            float p2 = b2[j];
#pragma unroll 8
            for (int i = 0; i < 64; ++i) p2 += h1s[lp * 64 + i] * w2[i * 64 + j];
            const float a = sinf(f * p2);
            const unsigned hi = pk2(a, 0.f) & 0xffffu; const unsigned lo = pk2(a - bf_lo(hi), 0.f) & 0xffffu;
            bf16* r0 = a2s + (size_t)l * 256; r0[j] = (bf16)hi; r0[64 + j] = (bf16)hi; r0[128 + j] = (bf16)lo; r0[192 + j] = 0;
            bf16* r1 = a2rs + (size_t)((SEQ - l) & (SEQ - 1)) * 256;
            if (l >= 1) { r1[j] = (bf16)hi; r1[64 + j] = (bf16)hi; r1[128 + j] = (bf16)lo; r1[192 + j] = 0; } else { r1[j] = 0; r1[64 + j] = 0; r1[128 + j] = 0; r1[192 + j] = 0; }
        }
        const float* w3 = arg_in(21); bf16* w3s = WSP(bf16, WS_W3S);
        for (int r = F.vcu * 512 + F.tid; r < 8192; r += F.G * 512) {
            const int dir = r >> 12, o = (r >> 11) & 1, d = r & 2047; const float* src = w3 + o * 4096 + dir * 2048 + d; bf16* dst = w3s + (size_t)r * 256;
#pragma unroll 4
            for (int j8 = 0; j8 < 8; ++j8) { unsigned h[8], lw[8];
#pragma unroll
                for (int q = 0; q < 8; ++q) { const float v = src[(size_t)(j8 * 8 + q) * 8192]; h[q] = pk2(v, 0.f) & 0xffffu; lw[q] = pk2(v - bf_lo(h[q]), 0.f) & 0xffffu; }
                const v4u H = {h[0] | (h[1] << 16), h[2] | (h[3] << 16), h[4] | (h[5] << 16), h[6] | (h[7] << 16)}, Lw = {lw[0] | (lw[1] << 16), lw[2] | (lw[3] << 16), lw[4] | (lw[5] << 16), lw[6] | (lw[7] << 16)};
                *(v4u*)(dst + j8 * 8) = H; *(v4u*)(dst + 64 + j8 * 8) = Lw; *(v4u*)(dst + 128 + j8 * 8) = H; *(v4u*)(dst + 192 + j8 * 8) = (v4u){0u, 0u, 0u, 0u}; }
        }
    }
#endif
#ifndef NO_PD
    {
        f32x2* cs = WSP(f32x2, WS_CS);
        for (int i = F.vcu * 512 + F.tid; i < SEQ * 32; i += F.G * 512) { const int l = i >> 5, q = i & 31; const float pos = (float)((q < 16) ? (l >> 6) : (l & 63));
            const float inv = powf(10000.0f, -(float)(q & 15) / 16.0f); const float ang = pos * inv; cs[i] = (f32x2){cosf(ang), sinf(ang)}; }
        f32x2* tw = WSP(f32x2, WS_TW);
        for (int i = F.vcu * 512 + F.tid; i < 8192; i += F.G * 512) { float s, c; if (i < 4096) sincospif((float)i / 2048.0f, &s, &c); else sincospif((float)(i - 4096) / 4096.0f, &s, &c); tw[i] = (f32x2){c, -s}; }
    }
#endif
}

__device__ __forceinline__ void norm_store(const f32x4 (&v)[8], float rstd, const float* g, const float* shift, const float* scale, bf16* orow, int lane) {
#pragma unroll
    for (int j = 0; j < 8; ++j) { const int c = 4 * (64 * j + lane); const f32x4 g4 = *(const f32x4*)(g + c), sh = *(const f32x4*)(shift + c), sc = *(const f32x4*)(scale + c);
        const f32x4 y = v[j] * rstd * g4 * (1.0f + sc) + sh; v2u o; o.x = pk2(y[0], y[1]); o.y = pk2(y[2], y[3]); *(v2u*)(orow + c) = o; }
}
__device__ __forceinline__ void p1_norm0(Frame& F) {
    const int lane = opq(F.tid) & 63;
    const int gw = F.vcu * NWAVES + F.wave, NGW = F.G * NWAVES;
    const float* mod = WSP(float, WS_MOD); bf16* H = WSP(bf16, WS_H); const float* xin = arg_in(0); const float* cin = arg_in(2); const float* ng = arg_in(6);
    for (int row = gw; row < MT; row += NGW) {
        const int b = row >= LT ? 1 : 0, r = row - b * LT; const bool lat = r < SEQ;
        const float* xr = lat ? xin + ((size_t)b * SEQ + r) * DM : cin + ((size_t)b * CTXL + (r - SEQ)) * DM;
        const float* mr = mod + (size_t)(lat ? b : 2) * 6 * DM;
        f32x4 v[8]; float s = 0.f;
#pragma unroll
        for (int j = 0; j < 8; ++j) { v[j] = *(const f32x4*)(xr + 4 * (64 * j + lane)); s += (v[j][0] * v[j][0] + v[j][1] * v[j][1]) + (v[j][2] * v[j][2] + v[j][3] * v[j][3]); }
        const float rstd = 1.0f / sqrtf(wave_sum(s) * (1.0f / DM) + EPS);
        norm_store(v, rstd, ng, mr, mr + DM, H + (size_t)row * DM, lane);
    }
}
__device__ __forceinline__ void p3_latent(Frame& F) {
    const int lane = opq(F.tid) & 63;
    const int gw = F.vcu * NWAVES + F.wave, NGW = F.G * NWAVES;
    const float* proj = WSP(float, WS_PROJ); bf16* cqn = WSP(bf16, WS_CQN); bf16* ckvn = WSP(bf16, WS_CKVN); bf16* kro = WSP(bf16, WS_KROPE); const f32x2* cs = WSP(f32x2, WS_CS);
    const float* gq = arg_in(9); const float* gkv = arg_in(10);
    for (int row = gw; row < MT; row += NGW) {
        const float* pr = proj + (size_t)row * INPAD; const int l = row % LT;
        const f32x4 q0 = *(const f32x4*)(pr + 4 * lane), q1 = *(const f32x4*)(pr + 256 + 4 * lane), kv = *(const f32x4*)(pr + 512 + 4 * lane);
        float sq = (q0[0] * q0[0] + q0[1] * q0[1]) + (q0[2] * q0[2] + q0[3] * q0[3]) + (q1[0] * q1[0] + q1[1] * q1[1]) + (q1[2] * q1[2] + q1[3] * q1[3]);
        float sk = (kv[0] * kv[0] + kv[1] * kv[1]) + (kv[2] * kv[2] + kv[3] * kv[3]);
        const float rq = 1.0f / sqrtf(wave_sum(sq) * (1.0f / QRANK) + EPS), rk = 1.0f / sqrtf(wave_sum(sk) * (1.0f / KVRANK) + EPS);
        { const f32x4 g0 = *(const f32x4*)(gq + 4 * lane), g1 = *(const f32x4*)(gq + 256 + 4 * lane), g2 = *(const f32x4*)(gkv + 4 * lane);
          const f32x4 y0 = q0 * rq * g0, y1 = q1 * rq * g1, y2 = kv * rk * g2;
          v2u o; o.x = pk2(y0[0], y0[1]); o.y = pk2(y0[2], y0[3]); *(v2u*)(cqn + (size_t)row * QRANK + 4 * lane) = o;
          o.x = pk2(y1[0], y1[1]); o.y = pk2(y1[2], y1[3]); *(v2u*)(cqn + (size_t)row * QRANK + 256 + 4 * lane) = o;
          o.x = pk2(y2[0], y2[1]); o.y = pk2(y2[2], y2[3]); *(v2u*)(ckvn + (size_t)row * KVRANK + 4 * lane) = o; }
        if (lane < 32) { const float x1 = pr[768 + lane], x2 = pr[800 + lane]; float o1 = x1, o2 = x2;
            if (l < SEQ) { const f32x2 c = cs[(size_t)l * 32 + lane]; o1 = x1 * c.x - x2 * c.y; o2 = x2 * c.x + x1 * c.y; }
            ((unsigned*)(kro + (size_t)row * 64))[lane] = pk2(o1, o2); }
    }
}
__device__ __forceinline__ void p8_norm_router(Frame& F, int layer) {
    const int lane = opq(F.tid) & 63;
    const int gw = F.vcu * NWAVES + F.wave, NGW = F.G * NWAVES;
    const float* X = WSP(float, WS_X1); bf16* H = WSP(bf16, WS_H); float* aff = WSP(float, WS_AFF);
    const float* mod = WSP(float, WS_MOD) + (size_t)layer * 3 * 6 * DM; const float* g = arg_in(6) + (size_t)(layer * 2 + 1) * DM;
    LAS float* wr = (LAS float*)F.lds;
    __syncthreads();
    { const float* W = arg_in(26) + (size_t)layer * DM * NE;
      for (int i = F.tid; i < DM * NE / 4; i += 512) { const int c = i >> 2, q = i & 3; *(LAS f32x4*)(wr + c * 16 + (c >> 2) * 4 + q * 4) = *(const f32x4*)(W + (size_t)i * 4); } }
    __syncthreads();
    for (int row = gw; row < MX; row += NGW) {
        const int b = row >> 12, t = row & 4095; const float* xr = X + (size_t)row * DM; const float* shift = mod + (size_t)b * 6 * DM + 3 * DM; const float* scale = shift + DM;
        f32x4 v[8]; float s = 0.f;
#pragma unroll
        for (int j = 0; j < 8; ++j) { v[j] = *(const f32x4*)(xr + 4 * (64 * j + lane)); s += (v[j][0] * v[j][0] + v[j][1] * v[j][1]) + (v[j][2] * v[j][2] + v[j][3] * v[j][3]); }
        const float rstd = 1.0f / sqrtf(wave_sum(s) * (1.0f / DM) + EPS);
        f32x4 lg[4] = {{0.f, 0.f, 0.f, 0.f}, {0.f, 0.f, 0.f, 0.f}, {0.f, 0.f, 0.f, 0.f}, {0.f, 0.f, 0.f, 0.f}};
#pragma unroll
        for (int j = 0; j < 8; ++j) { const int c = 4 * (64 * j + lane); const f32x4 g4 = *(const f32x4*)(g + c), sh = *(const f32x4*)(shift + c), sc = *(const f32x4*)(scale + c);
            const f32x4 y = v[j] * rstd * g4 * (1.0f + sc) + sh; v2u o; o.x = pk2(y[0], y[1]); o.y = pk2(y[2], y[3]); *(v2u*)(H + (size_t)row * DM + c) = o;
            const LAS float* wp = wr + c * 16 + (c >> 2) * 4;
#pragma unroll
            for (int q = 0; q < 4; ++q) {
#pragma unroll
                for (int e4 = 0; e4 < 4; ++e4) lg[e4] += y[q] * *(const LAS f32x4*)(wp + q * 16 + e4 * 4); } }
        float lv[16];
#pragma unroll
        for (int e = 0; e < 16; ++e) lv[e] = wave_sum(lg[e >> 2][e & 3]);
        float mx = lv[0];
#pragma unroll
        for (int e = 1; e < 16; ++e) mx = fmaxf(mx, lv[e]);
        float den = 0.f;
#pragma unroll
        for (int e = 0; e < 16; ++e) { lv[e] = __expf(lv[e] - mx); den += lv[e]; }
        float mine = 0.f;
#pragma unroll
        for (int e = 0; e < 16; ++e) mine = (lane == e) ? lv[e] : mine;
        if (lane < 16) aff[((size_t)b * NE + lane) * SEQ + t] = mine / den;
    }
    __syncthreads();
}
__device__ __forceinline__ void p9_select_gather(Frame& F) {
    const int lane = opq(F.tid) & 63;
    const float* aff = WSP(float, WS_AFF); int* tok = WSP(int, WS_TOK); const bf16* H = WSP(bf16, WS_H); bf16* XG = WSP(bf16, WS_XG);
    LAS int* red = (LAS int*)F.lds;
    LAS int* sel = (LAS int*)(F.lds + 256);
    for (int un = F.vcu; un < NB * NE * 8; un += F.G) {
        const int be = un >> 3, part = un & 7, b = be >> 4, e = be & 15;
        const float* ar = aff + (size_t)be * SEQ + 8 * F.tid;
        const f32x4 a0 = *(const f32x4*)ar, a1 = *(const f32x4*)(ar + 4);
        unsigned key[8] = {__float_as_uint(a0[0]), __float_as_uint(a0[1]), __float_as_uint(a0[2]), __float_as_uint(a0[3]), __float_as_uint(a1[0]), __float_as_uint(a1[1]), __float_as_uint(a1[2]), __float_as_uint(a1[3])};
        __syncthreads();
        unsigned prefix = 0u;
        for (int bit = 30; bit >= 0; --bit) {
            const unsigned cand = prefix | (1u << bit); int c = 0;
#pragma unroll
            for (int i = 0; i < 8; ++i) c += (key[i] >= cand) ? 1 : 0;
            c = wave_sum_i(c);
            LAS int* slot = red + (bit & 1) * 8;
            if (lane == 0) slot[F.wave] = c;
            __syncthreads();
            int tot = 0;
#pragma unroll
            for (int w = 0; w < 8; ++w) tot += slot[w];
            if (tot >= CAP) prefix = cand;
        }
        int cgt = 0, ceq = 0;
#pragma unroll
        for (int i = 0; i < 8; ++i) { cgt += (key[i] > prefix) ? 1 : 0; ceq += (key[i] == prefix) ? 1 : 0; }
        int pk = (ceq << 16) | cgt, inc = pk;
#pragma unroll
        for (int o = 1; o < 64; o <<= 1) { const int y = __shfl_up(inc, o); if (lane >= o) inc += y; }
        __syncthreads();
        if (lane == 63) red[16 + F.wave] = inc;
        __syncthreads();
        int wpre = 0, total = 0;
#pragma unroll
        for (int w = 0; w < 8; ++w) { const int x = red[16 + w]; if (w < F.wave) wpre += x; total += x; }
        const int exc = wpre + inc - pk;
        const int need = CAP - (total & 0xffff);
        int eqb = exc >> 16, gtb = exc & 0xffff;
        int slotv[8];
#pragma unroll
        for (int i = 0; i < 8; ++i) { const bool gt = key[i] > prefix, eq = key[i] == prefix; const bool s = gt || (eq && eqb < need);
            const int before = gtb + (eqb < need ? eqb : need);
            slotv[i] = s ? before : -1; gtb += gt ? 1 : 0; eqb += eq ? 1 : 0; }
#pragma unroll
        for (int i = 0; i < 8; ++i) if (slotv[i] >= 0) sel[slotv[i]] = 8 * F.tid + i;
        if (part == 0) { int* tr = tok + (size_t)be * SEQ + 8 * F.tid; *(int4*)tr = make_int4(slotv[0], slotv[1], slotv[2], slotv[3]); *(int4*)(tr + 4) = make_int4(slotv[4], slotv[5], slotv[6], slotv[7]); }
        __syncthreads();
#pragma unroll
        for (int i = 0; i < 8; ++i) { const int sl = part * 64 + F.wave * 8 + i; const int t = sel[sl];
            const v4u* src = (const v4u*)(H + ((size_t)b * SEQ + t) * DM) + lane; v4u* dst = (v4u*)(XG + ((size_t)e * 1024 + b * CAP + sl) * DM) + lane;
            const v4u r0 = src[0], r1 = src[64], r2 = src[128], r3 = src[192]; dst[0] = r0; dst[64] = r1; dst[128] = r2; dst[192] = r3; }
        __syncthreads();
    }
}
template <bool FINAL>
__device__ __forceinline__ void p12_combine_norm(Frame& F, int layer) {
    const int lane = opq(F.tid) & 63;
    const int gw = F.vcu * NWAVES + F.wave, NGW = F.G * NWAVES;
    float* X = WSP(float, WS_X1); bf16* H = WSP(bf16, WS_H); const float* aff = WSP(float, WS_AFF); const int* tok = WSP(int, WS_TOK); const bf16* Y = WSP(bf16, WS_Y);
    const float* modl = WSP(float, WS_MOD) + (size_t)layer * 3 * 6 * DM; const float* gfin = FINAL ? arg_in(7) : arg_in(6) + (size_t)((layer + 1) * 2) * DM;
    for (int row = gw; row < MX; row += NGW) {
        const int b = row >> 12, t = row & 4095; float* xr = X + (size_t)row * DM; const float* g5 = modl + (size_t)b * 6 * DM + 5 * DM;
        f32x4 v[8], acc[8];
#pragma unroll
        for (int j = 0; j < 8; ++j) { v[j] = *(const f32x4*)(xr + 4 * (64 * j + lane)); acc[j] = (f32x4){0.f, 0.f, 0.f, 0.f}; }
        int sv = -1; float av = 0.f;
        if (lane < 16) { sv = tok[((size_t)b * NE + lane) * SEQ + t]; av = aff[((size_t)b * NE + lane) * SEQ + t]; }
#pragma unroll
        for (int e = 0; e < 16; ++e) { const int s = __builtin_amdgcn_readlane(sv, e); const float a = __builtin_bit_cast(float, __builtin_amdgcn_readlane(__builtin_bit_cast(int, av), e));
            if (s >= 0) { const bf16* yr = Y + ((size_t)e * 1024 + b * CAP + s) * DM;
#pragma unroll
                for (int j = 0; j < 8; ++j) { const v2u w = *(const v2u*)(yr + 4 * (64 * j + lane)); acc[j] += a * (f32x4){bf_lo(w.x), bf_hi(w.x), bf_lo(w.y), bf_hi(w.y)}; } } }
        float s2 = 0.f;
#pragma unroll
        for (int j = 0; j < 8; ++j) { const f32x4 g4 = *(const f32x4*)(g5 + 4 * (64 * j + lane)); v[j] += g4 * acc[j]; s2 += (v[j][0] * v[j][0] + v[j][1] * v[j][1]) + (v[j][2] * v[j][2] + v[j][3] * v[j][3]); }
        const float rstd = 1.0f / sqrtf(wave_sum(s2) * (1.0f / DM) + EPS);
        if constexpr (FINAL) {
#pragma unroll
            for (int j = 0; j < 8; ++j) { const int c = 4 * (64 * j + lane); *(f32x4*)(F.out + (size_t)row * DM + c) = v[j] * rstd * *(const f32x4*)(gfin + c); }
        } else {
#pragma unroll
            for (int j = 0; j < 8; ++j) *(f32x4*)(xr + 4 * (64 * j + lane)) = v[j];
            const float* m1 = WSP(float, WS_MOD) + (size_t)(layer + 1) * 3 * 6 * DM + (size_t)b * 6 * DM;
            norm_store(v, rstd, gfin, m1, m1 + DM, H + (size_t)row * DM, lane);
        }
    }
}
__device__ __forceinline__ void p15_transpose(Frame& F) {
    const int lane = opq(F.tid) & 63;
    const int gw = F.vcu * NWAVES + F.wave, NGW = F.G * NWAVES;
    const bf16* ZT = WSP(bf16, WS_ZT); bf16* Z = WSP(bf16, WS_Z);
    LAS bf16* scr = (LAS bf16*)(F.lds + F.wave * 8704);
    for (int tl = gw; tl < (DM / 64) * (MX / 64); tl += NGW) {
        const int dt = tl & 31, tt = tl >> 5;
#pragma unroll
        for (int i = 0; i < 8; ++i) { const int d = 8 * i + (lane >> 3); const v4u w = *(const v4u*)(ZT + (size_t)(dt * 64 + d) * MX + tt * 64 + (lane & 7) * 8);
            LAS bf16* p = scr + d * 68 + (lane & 7) * 8; *(LAS v2u*)p = (v2u){w.x, w.y}; *(LAS v2u*)(p + 4) = (v2u){w.z, w.w}; }
        LDS_WAIT(); asm volatile("" ::: "memory");
#pragma unroll
        for (int i = 0; i < 8; ++i) { const int tk = 8 * i + (lane >> 3), d0 = (lane & 7) * 8; unsigned short h[8];
#pragma unroll
            for (int q = 0; q < 8; ++q) h[q] = scr[(d0 + q) * 68 + tk];
            v4u o; o.x = h[0] | ((unsigned)h[1] << 16); o.y = h[2] | ((unsigned)h[3] << 16); o.z = h[4] | ((unsigned)h[5] << 16); o.w = h[6] | ((unsigned)h[7] << 16);
            *(v4u*)(Z + (size_t)(tt * 64 + tk) * DM + dt * 64 + d0) = o; }
        LDS_WAIT(); asm volatile("" ::: "memory");
    }
}

namespace att {
constexpr int NW = 8, QBLK = 32, KVBLK = 64, KROW = 384  ;
constexpr float SCALE = 0.07216878364870322f;
constexpr float THR = 8.f;
#ifndef ATT_SDEPTH
#define ATT_SDEPTH 1
#endif
constexpr int SDEPTH = ATT_SDEPTH;
constexpr int SHM_V = KVBLK * 128 * 2, SHM_K = KVBLK * KROW, SHM_QR = 2 * SHM_V + 2 * SHM_K + NW * 64 * 4  , SHM_ATTN = SHM_QR + NW * 4096;
#define KSWZ(row, colB) ((row) * 384 + ((colB) ^ ((((row) ^ (((row) >> 3) & 3)) & 7) << 4)))
#define SBAR() __builtin_amdgcn_sched_barrier(0)
__device__ __forceinline__ int crow(int r, int hi) { return (r & 3) + 8 * (r >> 2) + 4 * hi; }
__device__ __forceinline__ void partialSM(f32x16& p0, f32x16& p1, float& m_reg, float& mn, float& alpha) {
  constexpr float C = SCALE * 1.4426950408889634f;
  float pmax = p0[0];
#pragma unroll
  for (int r = 1; r < 16; ++r) pmax = fmaxf(pmax, p0[r]);
#pragma unroll
  for (int r = 0; r < 16; ++r) pmax = fmaxf(pmax, p1[r]);
  { auto rr = __builtin_amdgcn_permlane32_swap(__float_as_uint(pmax), __float_as_uint(pmax), false, false);
    pmax = fmaxf(__uint_as_float(rr[0]), __uint_as_float(rr[1])); }
  if (__builtin_expect(__all(pmax - m_reg <= THR / SCALE), 1)) { mn = m_reg; alpha = 1.f; }
  else { mn = fmaxf(m_reg, pmax); alpha = __builtin_amdgcn_exp2f((m_reg - mn) * C); m_reg = mn; }
  const float mnC = -mn * C;
#pragma unroll
  for (int r = 0; r < 16; ++r) p0[r] = fmaf(p0[r], C, mnC);
#pragma unroll
  for (int r = 0; r < 16; ++r) p1[r] = fmaf(p1[r], C, mnC);
#pragma unroll
  for (int r = 0; r < 16; ++r) p0[r] = __builtin_amdgcn_exp2f(p0[r]);
}
__device__ __forceinline__ void finishSM(f32x16& p0, f32x16& p1, float alpha, float& l_reg, bf16x8& pa0, bf16x8& pa1, bf16x8& pa2, bf16x8& pa3) {
#pragma unroll
  for (int r = 0; r < 16; ++r) p1[r] = __builtin_amdgcn_exp2f(p1[r]);
  float ps = 0;
#pragma unroll
  for (int r = 0; r < 16; ++r) ps += p0[r];
#pragma unroll
  for (int r = 0; r < 16; ++r) ps += p1[r];
  { auto rr = __builtin_amdgcn_permlane32_swap(__float_as_uint(ps), __float_as_uint(ps), false, false);
    ps = __uint_as_float(rr[0]) + __uint_as_float(rr[1]); }
  l_reg = l_reg * alpha + ps;
#define PK4(P, BASE, OUT) do { unsigned a0 = pk2(P[BASE + 0], P[BASE + 1]), a1 = pk2(P[BASE + 2], P[BASE + 3]);   \
    unsigned b0 = pk2(P[BASE + 4], P[BASE + 5]), b1 = pk2(P[BASE + 6], P[BASE + 7]);                              \
    auto r0 = __builtin_amdgcn_permlane32_swap(a0, b0, false, false); auto r1 = __builtin_amdgcn_permlane32_swap(a1, b1, false, false); \
    v4u w = {r0[0], r1[0], r0[1], r1[1]}; OUT = *reinterpret_cast<bf16x8*>(&w); } while (0)
  PK4(p0, 0, pa0); PK4(p0, 8, pa1); PK4(p1, 0, pa2); PK4(p1, 8, pa3);
#undef PK4
}
__device__ __forceinline__ void qkt(f32x16& p0, f32x16& p1, const char* Ks, const bf16x8* qr, const char* qL, const int (&kb)[4]) {
  p0 = f32x16{}; p1 = f32x16{};
#pragma unroll
  for (int d0 = 0; d0 < 12; ++d0) {
    const bf16x8 qf = d0 < 8 ? qr[d0 < 8 ? d0 : 0] : *reinterpret_cast<const bf16x8*>(qL + (d0 - 8) * 1024);
    const bf16x8 b0 = *reinterpret_cast<const bf16x8*>(Ks + kb[d0 & 3] + (d0 >> 2) * 128);
    const bf16x8 b1 = *reinterpret_cast<const bf16x8*>(Ks + kb[d0 & 3] + (d0 >> 2) * 128 + 32 * 384);
    p0 = __builtin_amdgcn_mfma_f32_32x32x16_bf16(b0, qf, p0, 0, 0, 0);
    p1 = __builtin_amdgcn_mfma_f32_32x32x16_bf16(b1, qf, p1, 0, 0, 0); }
}
__device__ __forceinline__ int v_st(int k, int c) { const int kk = (k & ~0xC) | ((k & 4) << 1) | ((k & 8) >> 1); return ((kk >> 3) * 4 + (c >> 5)) * 512 + ((kk & 7) * 32 + (c & 31)) * 2; }
__device__ __forceinline__ int v_rd_base(int lane) { return ((lane & 3) << 3) | (((lane >> 2) & 3) << 6) | (((lane >> 4) & 1) << 5) | (((lane >> 5) & 1) << 8); }
constexpr int v_rd_off(int d0, int ks, int half) { return d0 * 512 + ks * 4096 + half * 2048; }
template <int OFF> __device__ __forceinline__ s16x4 tr_read(int vb) {
  s16x4 r; asm volatile("ds_read_b64_tr_b16 %0, %1 offset:%2" : "=&v"(r) : "v"(vb), "i"(OFF) : "memory"); return r;
}
template <int D0> __device__ __forceinline__ void pv_one(f32x16& od, int vb, bf16x8 pa0, bf16x8 pa1, bf16x8 pa2, bf16x8 pa3) {
  const s16x4 l0 = tr_read<v_rd_off(D0, 0, 0)>(vb), h0 = tr_read<v_rd_off(D0, 0, 1)>(vb), l1 = tr_read<v_rd_off(D0, 1, 0)>(vb), h1 = tr_read<v_rd_off(D0, 1, 1)>(vb);
  const s16x4 l2 = tr_read<v_rd_off(D0, 2, 0)>(vb), h2 = tr_read<v_rd_off(D0, 2, 1)>(vb), l3 = tr_read<v_rd_off(D0, 3, 0)>(vb), h3 = tr_read<v_rd_off(D0, 3, 1)>(vb);
  asm volatile("s_waitcnt lgkmcnt(0)" ::: "memory"); SBAR();
#define PKV(L, H) (bf16x8){L[0], L[1], L[2], L[3], H[0], H[1], H[2], H[3]}
  od = __builtin_amdgcn_mfma_f32_32x32x16_bf16(pa0, PKV(l0, h0), od, 0, 0, 0);
  od = __builtin_amdgcn_mfma_f32_32x32x16_bf16(pa1, PKV(l1, h1), od, 0, 0, 0);
  od = __builtin_amdgcn_mfma_f32_32x32x16_bf16(pa2, PKV(l2, h2), od, 0, 0, 0);
  od = __builtin_amdgcn_mfma_f32_32x32x16_bf16(pa3, PKV(l3, h3), od, 0, 0, 0);
#undef PKV
}
__device__ __forceinline__ void pv_d0(f32x16* o, int vb, bf16x8 pa0, bf16x8 pa1, bf16x8 pa2, bf16x8 pa3) {
  pv_one<0>(o[0], vb, pa0, pa1, pa2, pa3); pv_one<1>(o[1], vb, pa0, pa1, pa2, pa3); pv_one<2>(o[2], vb, pa0, pa1, pa2, pa3); pv_one<3>(o[3], vb, pa0, pa1, pa2, pa3);
}
__device__ __forceinline__ void attn_body(const bf16* __restrict__ Qb, const bf16* __restrict__ Kn, const bf16* __restrict__ Kr, const bf16* __restrict__ Vh, bf16* __restrict__ Ob, int seq, char* lds) {
  constexpr int LDQ = 3072, LDK = 4096, LDR = 64, LDO = 2048;
  const int tid = threadIdx.x, wid = tid >> 6, lane = tid & 63, r32 = lane & 31, hi = lane >> 5;
  char* V_lds = lds; char* K_lds = lds + 2 * SHM_V;
  float* ws = (float*)(lds + 2 * SHM_V + 2 * SHM_K) + wid * 64; float* li_l = ws; float* al_l = ws + 32;
  float m_reg = -1e30f, l_reg = 0; f32x16 o[4] = {}; bf16x8 qr[8];
  char* qL = lds + SHM_QR + wid * 4096 + lane * 16;
  const bf16* Qw = Qb + (unsigned)((wid * QBLK + r32) * LDQ + hi * 8);
#pragma unroll
  for (int d0 = 0; d0 < 8; ++d0) qr[d0] = *reinterpret_cast<const bf16x8*>(Qw + d0 * 16);
#pragma unroll
  for (int d0 = 8; d0 < 12; ++d0) *reinterpret_cast<bf16x8*>(qL + (d0 - 8) * 1024) = *reinterpret_cast<const bf16x8*>(Qw + d0 * 16);
  const int sr = tid >> 4, sc = (tid & 15) * 8, vst0 = v_st(sr, sc), vst1 = v_st(32 + sr, sc);
  const int rr = tid >> 3, rc = (tid & 7) * 8;
  const unsigned o_s0 = (unsigned)(sr * LDK + sc), o_s1 = (unsigned)((32 + sr) * LDK + sc), o_r = (unsigned)(rr * LDR + rc);
  int kb[4];
#pragma unroll
  for (int q = 0; q < 4; ++q) kb[q] = KSWZ(r32, q * 32 + hi * 16);
  const int vb0 = (int)(uintptr_t)V_lds + v_rd_base(lane);
  struct { bf16x8 vs0, vs1, ks0, ks1, kr0; } sr_[SDEPTH];
#define SLOAD(i, k0) do { const bf16* Vt = Vh + (size_t)(k0) * LDK; const bf16* Kt = Kn + (size_t)(k0) * LDK; const bf16* Rt = Kr + (size_t)(k0) * LDR; \
    sr_[i].vs0 = *(const bf16x8*)(Vt + o_s0); sr_[i].vs1 = *(const bf16x8*)(Vt + o_s1); sr_[i].ks0 = *(const bf16x8*)(Kt + o_s0); sr_[i].ks1 = *(const bf16x8*)(Kt + o_s1); \
    sr_[i].kr0 = *(const bf16x8*)(Rt + o_r); } while (0)
#define SWRITE(b, i) do { *(bf16x8*)(V_lds + (b) * SHM_V + vst0) = sr_[i].vs0; *(bf16x8*)(V_lds + (b) * SHM_V + vst1) = sr_[i].vs1; const int kc = sc * 2;               \
    *(bf16x8*)(K_lds + (b) * SHM_K + KSWZ(sr, kc)) = sr_[i].ks0; *(bf16x8*)(K_lds + (b) * SHM_K + KSWZ(32 + sr, kc)) = sr_[i].ks1;                       \
    *(bf16x8*)(K_lds + (b) * SHM_K + KSWZ(rr, 256 + rc * 2)) = sr_[i].kr0; } while (0)
#define SWAIT() do { if constexpr (SDEPTH == 2) asm volatile("s_waitcnt vmcnt(5)" ::: "memory"); else asm volatile("s_waitcnt vmcnt(0)" ::: "memory"); } while (0)
#define RESC(a) do { if (__any((a) < 1.f)) { if (hi == 0) al_l[r32] = (a); asm volatile("s_waitcnt lgkmcnt(0)" ::: "memory"); \
    _Pragma("unroll") for (int d = 0; d < 4; ++d) _Pragma("unroll") for (int r = 0; r < 16; ++r) o[d][r] *= al_l[crow(r, hi)]; } } while (0)
  f32x16 pA0, pA1, pB0, pB1; float mnA, mnB, alA, alB; bf16x8 pa0, pa1, pa2, pa3; const int NT = seq / KVBLK;
  constexpr int SE = 0, SO = SDEPTH - 1;
  SLOAD(SE, 0); asm volatile("s_waitcnt vmcnt(0)" ::: "memory"); SWRITE(0, SE); __syncthreads();
  qkt(pA0, pA1, K_lds, qr, qL, kb); partialSM(pA0, pA1, m_reg, mnA, alA);
  SLOAD(SO, KVBLK); if constexpr (SDEPTH == 2) { if (2 < NT) SLOAD(SE, 2 * KVBLK); }
  SWAIT(); SWRITE(1, SO); __syncthreads();
  for (int j = 1; j + 1 < NT; j += 2) {
    SBAR(); qkt(pB0, pB1, K_lds + SHM_K, qr, qL, kb);
    finishSM(pA0, pA1, alA, l_reg, pa0, pa1, pa2, pa3); SBAR();
    SLOAD(SO, (j + SDEPTH) * KVBLK); SBAR();
    pv_d0(o, vb0, pa0, pa1, pa2, pa3); partialSM(pB0, pB1, m_reg, mnB, alB);
    __syncthreads(); SWAIT(); SWRITE(0, SE);
    RESC(alB); __syncthreads();
    SBAR(); qkt(pA0, pA1, K_lds, qr, qL, kb);
    finishSM(pB0, pB1, alB, l_reg, pa0, pa1, pa2, pa3); SBAR();
    if (SDEPTH == 1 || j + 3 < NT) SLOAD(SE, (j + 1 + SDEPTH) * KVBLK); SBAR();
    pv_d0(o, vb0 + SHM_V, pa0, pa1, pa2, pa3); partialSM(pA0, pA1, m_reg, mnA, alA);
    __syncthreads(); SWAIT(); SWRITE(1, SO);
    RESC(alA); __syncthreads();
  }
  SBAR(); qkt(pB0, pB1, K_lds + SHM_K, qr, qL, kb);
  finishSM(pA0, pA1, alA, l_reg, pa0, pa1, pa2, pa3); SBAR();
  pv_d0(o, vb0, pa0, pa1, pa2, pa3); partialSM(pB0, pB1, m_reg, mnB, alB);
  __syncthreads(); RESC(alB);
  finishSM(pB0, pB1, alB, l_reg, pa0, pa1, pa2, pa3); SBAR();
  pv_d0(o, vb0 + SHM_V, pa0, pa1, pa2, pa3);
  if (hi == 0) li_l[r32] = l_reg; asm volatile("s_waitcnt lgkmcnt(0)" ::: "memory");
  float rli[16];
#pragma unroll
  for (int r = 0; r < 16; ++r) rli[r] = __builtin_amdgcn_rcpf(li_l[crow(r, hi)]);
  bf16* Ow = Ob + (size_t)(wid * QBLK) * LDO;
#pragma unroll
  for (int r = 0; r < 16; ++r) { const int orow = crow(r, hi);
#pragma unroll
    for (int d0 = 0; d0 < 4; ++d0) Ow[(unsigned)(orow * LDO + d0 * 32 + r32)] = (bf16)(pk2(o[d0][r] * rli[r], 0.f) & 0xffffu); }
#undef SLOAD
#undef SWRITE
#undef SWAIT
#undef RESC
}
}
__device__ __forceinline__ void p6_attention(Frame& F) {
    const bf16* Q = WSP(bf16, WS_Q); const bf16* KV = WSP(bf16, WS_KV); const bf16* KR = WSP(bf16, WS_KROPE); bf16* O = WSP(bf16, WS_O);
    const int cslot = (int)((blockIdx.x >> 3) % 3u);
    if (cslot == 0) convert_late(F);
    const int nun = NB * NH * (SEQ / 256);
    for (int i = 0; ; ++i) {
        int bh, qb;
        if (F.G == 256) { if (i >= 2) break; const int x = blockIdx.x & 7, j = blockIdx.x >> 3; bh = (i * 8 + x) * 2 + (j >> 4); qb = j & 15; }
        else { const int L = i * F.G + (int)blockIdx.x; if (L >= nun) break; bh = L >> 4; qb = L & 15; }
        const int b = bh >> 4, h = bh & 15;
        if (i == 1 && cslot == 1) convert_late(F);
        __syncthreads();
        att::attn_body(Q + ((size_t)b * LT + qb * 256) * QW + h * 192, KV + (size_t)b * LT * KVW + h * 256, KR + (size_t)b * LT * 64, KV + (size_t)b * LT * KVW + h * 256 + 128,
                       O + ((size_t)b * SEQ + qb * 256) * DM + h * 128, LT, (char*)F.ldsg);
    }
    __syncthreads();
    if (cslot == 2) convert_late(F);
}

namespace hy {
typedef float cpx __attribute__((ext_vector_type(2)));
__device__ __forceinline__ cpx cmul(cpx a, cpx b) { return (cpx){a.x * b.x - a.y * b.y, a.x * b.y + a.y * b.x}; }
__device__ __forceinline__ cpx cmulc(cpx a, cpx b) { return (cpx){a.x * b.x + a.y * b.y, a.y * b.x - a.x * b.y}; }
__device__ __forceinline__ cpx cadd(cpx a, cpx b) { return a + b; }
__device__ __forceinline__ cpx csub(cpx a, cpx b) { return a - b; }
template <int S> __device__ __forceinline__ cpx mul_i(cpx a) { return S < 0 ? (cpx){a.y, -a.x} : (cpx){-a.y, a.x}; }
template <int S> __device__ __forceinline__ void dft4(cpx& x0, cpx& x1, cpx& x2, cpx& x3) {
    const cpx t0 = cadd(x0, x2), t1 = csub(x0, x2), t2 = cadd(x1, x3), t3 = mul_i<S>(csub(x1, x3));
    x0 = cadd(t0, t2); x2 = csub(t0, t2); x1 = cadd(t1, t3); x3 = csub(t1, t3);
}
template <int S> __device__ __forceinline__ cpx tw16(cpx a, int m) {
    constexpr float C1 = 0.9238795325112867f, S1 = 0.3826834323650898f, R = 0.7071067811865476f;
    cpx w;
    switch (m) { case 0: return a; case 1: w = (cpx){C1, -S1}; break; case 2: w = (cpx){R, -R}; break; case 3: w = (cpx){S1, -C1}; break; case 4: w = (cpx){0.f, -1.f}; break; case 6: w = (cpx){-R, -R}; break; default: w = (cpx){-C1, S1}; break; }
    if (S > 0) w.y = -w.y;
    return cmul(a, w);
}
template <int S> __device__ __forceinline__ void dft16(cpx (&v)[16]) {
#pragma unroll
    for (int a = 0; a < 4; ++a) { dft4<S>(v[a], v[a + 4], v[a + 8], v[a + 12]);
#pragma unroll
        for (int d = 1; d < 4; ++d) v[a + 4 * d] = tw16<S>(v[a + 4 * d], a * d); }
#pragma unroll
    for (int d = 0; d < 4; ++d) dft4<S>(v[4 * d], v[4 * d + 1], v[4 * d + 2], v[4 * d + 3]);
}
__device__ __forceinline__ constexpr int SL(int k) { return 4 * (k & 3) + (k >> 2); }
__device__ __forceinline__ int PI(int i) { return i + (i >> 4); }
typedef LAS cpx* lbuf;
typedef const LAS cpx* ltab;
__device__ __forceinline__ cpx tw_lookup(ltab T, int m) { return cmul(T[64 + (m >> 6)], T[m & 63]); }
__device__ __forceinline__ void tw_powers(cpx b, cpx (&p)[16]) {
    p[0] = (cpx){1.f, 0.f}; p[1] = b; p[2] = cmul(b, b); p[3] = cmul(p[2], b); p[4] = cmul(p[2], p[2]); p[5] = cmul(p[4], b); p[6] = cmul(p[4], p[2]); p[7] = cmul(p[4], p[3]); p[8] = cmul(p[4], p[4]);
    p[9] = cmul(p[8], b); p[10] = cmul(p[8], p[2]); p[11] = cmul(p[8], p[3]); p[12] = cmul(p[8], p[4]); p[13] = cmul(p[8], p[5]); p[14] = cmul(p[8], p[6]); p[15] = cmul(p[8], p[7]);
}
struct Addr { int a1, a2, a3; };
__device__ __forceinline__ void fwd12(lbuf buf, Addr A, const cpx (&pw1)[16], cpx b2) {
    cpx v[16], pw2[16];
    { lbuf b = buf + A.a1;
#pragma unroll
      for (int n = 0; n < 16; ++n) v[n] = b[n * 272];
      dft16<-1>(v);
#pragma unroll
      for (int k = 0; k < 16; ++k) b[k * 272] = k ? cmul(v[SL(k)], pw1[k]) : v[SL(k)]; }
    __syncthreads();
    { lbuf b = buf + A.a2;
#pragma unroll
      for (int n = 0; n < 16; ++n) v[n] = b[n * 17];
      tw_powers(b2, pw2);
      dft16<-1>(v);
#pragma unroll
      for (int k = 0; k < 16; ++k) b[k * 17] = k ? cmul(v[SL(k)], pw2[k]) : v[SL(k)]; }
    __syncthreads();
}
__device__ __forceinline__ void inv21(lbuf buf, Addr A, const cpx (&pw1)[16], cpx b2) {
    cpx v[16], pw2[16];
    { lbuf b = buf + A.a2; tw_powers(b2, pw2);
#pragma unroll
      for (int k = 0; k < 16; ++k) { const cpx x = b[k * 17]; v[k] = k ? cmulc(x, pw2[k]) : x; }
      dft16<1>(v);
#pragma unroll
      for (int n = 0; n < 16; ++n) b[n * 17] = v[SL(n)]; }
    __syncthreads();
    { lbuf b = buf + A.a1;
#pragma unroll
      for (int k = 0; k < 16; ++k) { const cpx x = b[k * 272]; v[k] = k ? cmulc(x, pw1[k]) : x; }
      dft16<1>(v);
#pragma unroll
      for (int n = 0; n < 16; ++n) b[n * 272] = v[SL(n)]; }
    __syncthreads();
}
template <int ORDER> __device__ __forceinline__ void conv_core(lbuf bx, lbuf bw, Addr A, int ap, bool special, float scale, const cpx (&pw1)[16], cpx b2) {
    fwd12(bx, A, pw1, b2);
    cpx v[16], u[16];
    { lbuf b = bx + A.a3;
#pragma unroll
      for (int n = 0; n < 16; ++n) v[n] = b[n]; }
    dft16<-1>(v);
    const float hs = 0.5f * scale;
    { lbuf bo = bw + A.a3; lbuf bp = bw + ap;
#pragma unroll
      for (int k3 = 0; k3 < 16; ++k3) {
        const cpx wf = bo[k3]; const cpx wp = (k3 == 0) ? bw[special ? ap - 1 : ap + 15] : bp[15 - k3];
        const cpx K = ORDER == 0 ? (cpx){(wf.x + wp.x) * hs, (wf.y - wp.y) * hs} : (cpx){(wf.y + wp.y) * hs, -(wf.x - wp.x) * hs};
        u[k3] = cmul(v[SL(k3)], K); } }
    dft16<1>(u);
    { lbuf b = bx + A.a3;
#pragma unroll
      for (int n = 0; n < 16; ++n) b[n] = u[SL(n)]; }
    __syncthreads();
    inv21(bx, A, pw1, b2);
}
}

__device__ __forceinline__ void p14_hyena_conv(Frame& F) {
    const int lane = opq(F.tid) & 63;
    using namespace hy;
    lbuf bufX = (lbuf)F.lds; lbuf bufW = (lbuf)(F.lds + 69632);
    LAS float* red = (LAS float*)(F.lds + 139264);
    LAS cpx* tab = (LAS cpx*)(F.lds + 139264 + 64);
    const float* HF = WSP(float, WS_HF);
    const bf16* U = WSP(bf16, WS_U); bf16* ZT = WSP(bf16, WS_ZT);
    const float* b3 = arg_in(22); const float* cw = arg_in(15); const float* cb = arg_in(16); const float* skip = arg_in(24);
    __syncthreads();
    if (F.tid < 256) { const f32x2* twg = WSP(f32x2, WS_TW); const int q = F.tid >> 6, i = F.tid & 63; tab[F.tid] = twg[(q >> 1) * 4096 + ((q & 1) ? 64 * i : i)]; }
    __syncthreads();
    const int t0_ = F.tid, e = t0_ >> 8, j = t0_ & 255;
    cpx pw1[16];
    tw_powers(tw_lookup(tab, j), pw1); const cpx b2 = tw_lookup(tab, 16 * (j & 15));
    Addr A; A.a1 = j + (j >> 4); A.a2 = (j >> 4) * 272 + (j & 15); A.a3 = j * 17;
    const int k1 = j >> 4, k2 = j & 15; const bool special = (e == 0 && j == 0);
    const int ap = e ? (15 - k1) * 272 + (15 - k2) * 17 : (k1 ? (16 - k1) * 272 + (15 - k2) * 17 : (k2 ? (16 - k2) * 17 : 1));
    lbuf bx = bufX + e * 4352; lbuf bw = bufW + e * 4352;
#define HY_ISSUE(T, raw) do { const int ch = (T) * DM + d; \
        _Pragma("unroll") for (int b = 0; b < 2; ++b) { const bf16* pr = U + (size_t)ch * MX + b * SEQ + n0; raw.m[b] = *(const v4u*)pr; raw.l[b] = t > 0 ? pr[-1] : (bf16)0; raw.r[b] = t < 511 ? pr[8] : (bf16)0; } } while (0)
#define HY_CONV(T, raw, dst) do { const int ch = (T) * DM + d; const float w0 = cw[ch], w1 = cw[3 * DM + ch], w2 = cw[6 * DM + ch], bs = cb[ch]; \
        _Pragma("unroll") for (int b = 0; b < 2; ++b) { const v4u m = raw.m[b]; \
            const float p[10] = {bf1(raw.l[b]), bf_lo(m.x), bf_hi(m.x), bf_lo(m.y), bf_hi(m.y), bf_lo(m.z), bf_hi(m.z), bf_lo(m.w), bf_hi(m.w), bf1(raw.r[b])}; \
            _Pragma("unroll") for (int i = 0; i < 8; ++i) { const float uu = w0 * p[i] + w1 * p[i + 1] + w2 * p[i + 2] + bs; if (b == 0) dst[i].x = uu; else dst[i].y = uu; } } } while (0)
    struct Raw { v4u m[2]; bf16 l[2], r[2]; };
#define HY_TW8() cpx tw8[8]; { const cpx th = tab[192 + (t >> 3)]; _Pragma("unroll") for (int i = 0; i < 8; ++i) tw8[i] = cmul(th, tab[128 + 8 * (t & 7) + i]); }
#pragma unroll 1
    for (int d = F.vcu; d < DM; d += F.G) {
        int t = F.tid; asm volatile("" : "+v"(t));
        const int n0 = 8 * t, p0 = n0 + (t >> 1);
        Raw rv, r1; HY_ISSUE(0, rv); HY_ISSUE(1, r1);
        __syncthreads();
        {
            const float* h00 = HF + (size_t)d * SEQ + n0; const float* h10 = h00 + (size_t)2048 * SEQ; const float* h01 = h00 + (size_t)4096 * SEQ; const float* h11 = h01 + (size_t)2048 * SEQ;
            const f32x4 a00 = *(const f32x4*)h00, b00 = *(const f32x4*)(h00 + 4), a10 = *(const f32x4*)h10, b10 = *(const f32x4*)(h10 + 4);
            const f32x4 a01 = *(const f32x4*)h01, b01 = *(const f32x4*)(h01 + 4), a11 = *(const f32x4*)h11, b11 = *(const f32x4*)(h11 + 4);
            const float bb00 = b3[d], bb01 = b3[2048 + d], bb10 = b3[4096 + d], bb11 = b3[6144 + d];
            const float adel = 3.0701134573253944f + (float)d * ((15.350567286626972f - 3.0701134573253944f) / 2047.0f);
            float ss0 = 0.f, ss1 = 0.f; HY_TW8();
#pragma unroll
            for (int i = 0; i < 8; ++i) { const int n = n0 + i; const float df = __expf(-((float)n * (1.0f / 4096.0f)) * adel), db = __expf(-((float)(4096 - n) * (1.0f / 4096.0f)) * adel);
                const float f00 = (i < 4 ? a00[i & 3] : b00[i & 3]) + bb00, f10 = (i < 4 ? a10[i & 3] : b10[i & 3]) + bb10, f01 = (i < 4 ? a01[i & 3] : b01[i & 3]) + bb01, f11 = (i < 4 ? a11[i & 3] : b11[i & 3]) + bb11;
                const float a0 = f00 * df, a1 = f10 * df;
                const float c0 = n ? f01 * db : 0.f, c1 = n ? f11 * db : 0.f;
                ss0 += a0 * a0 + c0 * c0; ss1 += a1 * a1 + c1 * c1;
                bufW[p0 + i] = (cpx){a0 + c0, a1 + c1};
                bufW[4352 + p0 + i] = cmul((cpx){a0 - c0, a1 - c1}, tw8[i]); }
            ss0 = wave_sum(ss0); ss1 = wave_sum(ss1);
            if (lane == 0) { red[F.wave * 2] = ss0; red[F.wave * 2 + 1] = ss1; }
        }
        __syncthreads();
        float rs0 = 0.f, rs1 = 0.f;
#pragma unroll
        for (int w = 0; w < 8; ++w) { rs0 += red[w * 2]; rs1 += red[w * 2 + 1]; }
        rs0 = (1.0f / sqrtf(rs0 + EPS)) * (1.0f / 8192.0f); rs1 = (1.0f / sqrtf(rs1 + EPS)) * (1.0f / 8192.0f);
        { fwd12(bw, A, pw1, b2); cpx v[16]; lbuf b = bw + A.a3;
#pragma unroll
          for (int n = 0; n < 16; ++n) v[n] = b[n];
          dft16<-1>(v);
#pragma unroll
          for (int k = 0; k < 16; ++k) b[k] = v[SL(k)]; }
        cpx vv[8];
        HY_CONV(0, rv, vv);
        const float sk0 = skip[d], sk1 = skip[DM + d];
        { HY_TW8();
#pragma unroll
        for (int i = 0; i < 8; ++i) { bufX[p0 + i] = vv[i]; bufX[4352 + p0 + i] = cmul(vv[i], tw8[i]); } }
        __syncthreads();
        conv_core<0>(bx, bw, A, ap, special, rs0, pw1, b2);
        Raw r2; HY_ISSUE(2, r2);
        { cpx x1c[8]; HY_CONV(1, r1, x1c); HY_TW8();
#pragma unroll
        for (int i = 0; i < 8; ++i) { const cpx ye = bufX[p0 + i], yo = bufX[4352 + p0 + i]; const cpx y = cadd(ye, cmulc(yo, tw8[i]));
            vv[i] = (cpx){x1c[i].x * (y.x + sk0 * vv[i].x), x1c[i].y * (y.y + sk0 * vv[i].y)};
            bufX[p0 + i] = vv[i]; bufX[4352 + p0 + i] = cmul(vv[i], tw8[i]); } }
        __syncthreads();
        conv_core<1>(bx, bw, A, ap, special, rs1, pw1, b2);
        cpx x2c[8]; HY_CONV(2, r2, x2c); HY_TW8();
        unsigned ob0[4], ob1[4];
#pragma unroll
        for (int i = 0; i < 8; i += 2) { float z0[2], z1[2];
#pragma unroll
            for (int q = 0; q < 2; ++q) { const cpx ye = bufX[p0 + i + q], yo = bufX[4352 + p0 + i + q]; const cpx y = cadd(ye, cmulc(yo, tw8[i + q]));
                z0[q] = x2c[i + q].x * (y.x + sk1 * vv[i + q].x); z1[q] = x2c[i + q].y * (y.y + sk1 * vv[i + q].y); }
            ob0[i >> 1] = pk2(z0[0], z0[1]); ob1[i >> 1] = pk2(z1[0], z1[1]); }
        *(v4u*)(ZT + (size_t)d * MX + n0) = (v4u){ob0[0], ob0[1], ob0[2], ob0[3]};
        *(v4u*)(ZT + (size_t)d * MX + SEQ + n0) = (v4u){ob1[0], ob1[1], ob1[2], ob1[3]};
    }
    __syncthreads();
#undef HY_ISSUE
#undef HY_CONV
#undef HY_TW8
}


#ifndef MK_SINGLE
#define MK_SINGLE 1
#endif
struct Args { const float* in[30]; float* out; unsigned char* ws; int ph_lo, ph_hi; };
__global__ void __launch_bounds__(NWAVES * 64, 2) mk_fwd(Args args) {
    extern __shared__ __attribute__((aligned(16))) unsigned char lds[];
    Frame F;
    F.lds = (LAS unsigned char*)lds; F.ldsg = lds;
    F.tid = threadIdx.x; F.wave = __builtin_amdgcn_readfirstlane(F.tid >> 6);
    F.G = gridDim.x; { const int bx = blockIdx.x; F.vcu = (F.G % 8 == 0) ? (bx % 8) * (F.G / 8) + bx / 8 : bx; }
    F.out = args.out; F.ws = args.ws;
    volatile LAS unsigned* MISC = (volatile LAS unsigned*)(F.lds + MISC_OFF);
    if (F.tid < 32) MISC[F.tid] = 0u;
    __syncthreads();
    unsigned* ctl = (unsigned*)(F.ws + WS_CTL);
    XcdBarrier bar; bar.bar = ctl + CW_BAR; bar.x = 0; bar.st = nullptr;
    if (MK_SINGLE) bar = xcd_barrier_post(ctl + CW_BAR, MISC + 8);
    const int lo = args.ph_lo, hi = args.ph_hi;
#ifndef PH_MASK
#define PH_MASK 0x1fffff
#endif
#ifndef PROBE_DUP
#define PROBE_DUP 0
#endif
#define IN(k) (((PH_MASK >> (k)) & 1) && lo <= (k) && (k) < hi)
#define REP(k) for (int rep_ = 0; rep_ < (((PROBE_DUP >> (k)) & 1) ? 2 : 1); ++rep_)
#ifndef PROBE_XBAR
#define PROBE_XBAR 0
#endif
#define SEAM(k) do { if (MK_SINGLE && IN(k) && IN((k) + 1)) { xcd_barrier(bar); if (PROBE_XBAR) xcd_barrier(bar); } } while (0)
    using namespace pg8;
    const bf16_t* Hb = WSP(bf16_t, WS_H);
    float* mod = WSP(float, WS_MOD);

    if (IN(0)) REP(0) { p0_prologue(F); } SEAM(0);
    if (IN(1)) REP(1) { p1_norm0(F); } SEAM(1);
    if (IN(2)) REP(2) {
        Gemm g{Hb, WSP(bf16_t, WS_WIN), MT, INPAD, DM}; StaticOrder S; S.init(MT, INPAD, F.G, (int)blockIdx.x);
        EpiF32Plain E{WSP(float, WS_PROJ), INPAD, 0x7fffffff};
        gemm_phase<EpiF32Plain, StaticOrder, true, true>(F.lds, g, S, E);
        {
            __syncthreads();
            Gemm g2{WSP(bf16_t, WS_W3S), WSP(bf16_t, WS_A2S), 8192, 4096, 256}; HfOrder S2{F.G, (int)blockIdx.x, 136};
            EpiF32Plain E2{WSP(float, WS_HF), 4096, 15};
            gemm_phase<EpiF32Plain, HfOrder, true, true>(F.lds, g2, S2, E2);
        }
    } SEAM(2);
    if (IN(3)) REP(3) { p3_latent(F); } SEAM(3);
    if (IN(4)) REP(4) {
        { Gemm g{WSP(bf16_t, WS_CQN), WSP(bf16_t, WS_WUQ), MT, QW, QRANK}; StaticOrder S; S.init(MT, QW, F.G, (int)blockIdx.x);
          EpiQRope E{WSP(bf16_t, WS_Q), WSP(float, WS_CS)};
          gemm_phase<EpiQRope, StaticOrder, true, true>(F.lds, g, S, E); }
        __syncthreads();
        { Gemm g{WSP(bf16_t, WS_CKVN), WSP(bf16_t, WS_WUKV), MT, KVW, KVRANK}; StaticOrder S; S.init(MT, KVW, F.G, (int)blockIdx.x);
          EpiBf16Plain E{WSP(bf16_t, WS_KV), KVW, 0x7fffffff};
          gemm_phase<EpiBf16Plain, StaticOrder, true, true>(F.lds, g, S, E); }
    } SEAM(4);
    if (IN(5)) REP(5) { p6_attention(F); } SEAM(5);
    if (IN(6)) REP(6) {
        Gemm g{WSP(bf16_t, WS_O), WSP(bf16_t, WS_WO), MX, DM, DM}; StaticOrder S; S.init(MX, DM, F.G, (int)blockIdx.x);
        EpiResid E{arg_in(0), WSP(float, WS_X1), mod + 2 * DM, 6 * DM};
        gemm_phase<EpiResid, StaticOrder, true, true>(F.lds, g, S, E);
    } SEAM(6);
#define MOE_PHASES(layer, pb) \
    if (IN(pb)) REP(pb) { p8_norm_router(F, layer); } SEAM(pb); \
    if (IN((pb) + 1)) REP((pb) + 1) { p9_select_gather(F); } SEAM((pb) + 1); \
    if (IN((pb) + 2)) REP((pb) + 2) {     \
        Gemm g{WSP(bf16_t, WS_XG), WSP(bf16_t, WS_WGU) + (size_t)(layer) * NE * 2048 * DM, MROWS, 2048, DM}; MoeOrder S{F.G, (int)blockIdx.x}; \
        EpiSwiGLU E{WSP(bf16_t, WS_ACT)}; \
        gemm_phase<EpiSwiGLU, MoeOrder, true, true>(F.lds, g, S, E); \
    } SEAM((pb) + 2); \
    if (IN((pb) + 3)) REP((pb) + 3) {     \
        Gemm g{WSP(bf16_t, WS_ACT), WSP(bf16_t, WS_WD) + (size_t)(layer) * NE * 2048 * FFD, MROWS, 2048, FFD}; MoeOrder S{F.G, (int)blockIdx.x}; \
        EpiBf16Plain E{WSP(bf16_t, WS_Y), DM, 7}; \
        gemm_phase<EpiBf16Plain, MoeOrder, true, true>(F.lds, g, S, E); \
    } SEAM((pb) + 3);
    MOE_PHASES(0, 7)
    if (IN(11)) REP(11) { p12_combine_norm<false>(F, 0); } SEAM(11);
    if (IN(12)) REP(12) {
        Gemm g{WSP(bf16_t, WS_HYWIN), Hb, 3 * DM, MX, DM}; StaticOrder S; S.init(3 * DM, MX, F.G, (int)blockIdx.x);
        EpiBf16Plain E{WSP(bf16_t, WS_U), MX, 0x7fffffff};
        gemm_phase<EpiBf16Plain, StaticOrder, true, true>(F.lds, g, S, E);
    } SEAM(12);
    if (IN(13)) REP(13) { p14_hyena_conv(F); } SEAM(13);
    if (IN(14)) REP(14) { p15_transpose(F); } SEAM(14);
    if (IN(15)) REP(15) {
        Gemm g{WSP(bf16_t, WS_Z), WSP(bf16_t, WS_HYWOUT), MX, DM, DM}; StaticOrder S; S.init(MX, DM, F.G, (int)blockIdx.x);
        EpiResid E{WSP(float, WS_X1), WSP(float, WS_X1), mod + 3 * 6 * DM + 2 * DM, 6 * DM};
        gemm_phase<EpiResid, StaticOrder, true, true>(F.lds, g, S, E);
    } SEAM(15);
    MOE_PHASES(1, 16)
    if (IN(20)) REP(20) { p12_combine_norm<true>(F, 1); }
#undef MOE_PHASES
#undef IN
#undef SEAM
}

extern "C" void kernel_launch(void* const* d_in, const int* in_sizes, int n_in, void* d_out, int out_size, void* d_ws, size_t ws_size, hipStream_t stream) {
    static int grid = 0;
    if (grid == 0) {
        if (n_in != 30 || out_size != MX * DM || ws_size < WS_END) { fprintf(stderr, "kernel_launch: shape/workspace mismatch: n_in %d out %d ws %zu (need %zu)\n", n_in, out_size, ws_size, (size_t)WS_END); grid = -1; return; }
        int dev = 0, cus = 0, per_cu = 0;
        if (hipGetDevice(&dev) != hipSuccess || hipDeviceGetAttribute(&cus, hipDeviceAttributeMultiprocessorCount, dev) != hipSuccess) { grid = -1; return; }
        if (hipFuncSetAttribute((const void*)mk_fwd, hipFuncAttributeMaxDynamicSharedMemorySize, LDS_BYTES) != hipSuccess) { fprintf(stderr, "kernel_launch: hipFuncSetAttribute failed\n"); grid = -1; return; }
        if (hipOccupancyMaxActiveBlocksPerMultiprocessor(&per_cu, (const void*)mk_fwd, NWAVES * 64, LDS_BYTES) != hipSuccess || per_cu < 1) { fprintf(stderr, "kernel_launch: occupancy query says %d blocks per CU\n", per_cu); }
        (void)hipGetLastError();
        grid = cus;
    }
    if (grid < 0) return;
    if (hipMemsetAsync((char*)d_ws + WS_CTL, 0, CTL_ZERO_BYTES, stream) != hipSuccess) return;
    Args a{};
    for (int i = 0; i < 30; ++i) a.in[i] = (const float*)d_in[i];
    a.out = (float*)d_out; a.ws = (unsigned char*)d_ws;
#if MK_SINGLE
    a.ph_lo = 0; a.ph_hi = NPHASE;
    hipLaunchKernelGGL(mk_fwd, dim3(grid), dim3(NWAVES * 64), LDS_BYTES, stream, a);
#else
    for (int p = 0; p < NPHASE; ++p) { a.ph_lo = p; a.ph_hi = p + 1; hipLaunchKernelGGL(mk_fwd, dim3(grid), dim3(NWAVES * 64), LDS_BYTES, stream, a); }
#endif
    const hipError_t le = hipPeekAtLastError();
    if (le != hipSuccess) fprintf(stderr, "kernel_launch: launch failed: %s\n", hipGetErrorName(le));
}
```

```cpp
#include <hip/hip_runtime.h>
#include <cstdio>
#include <cstdint>
namespace pg8 {
#define PG8_LAS __attribute__((address_space(3)))
typedef unsigned short bf16_t;
typedef short bf16x8 __attribute__((ext_vector_type(8)));
typedef float f32x4 __attribute__((ext_vector_type(4)));
typedef unsigned u32x4 __attribute__((ext_vector_type(4)));
constexpr int BM = 256, BK = 64, HALF = 128, HTB = HALF * BK * 2  , STAGE_BYTES = 8 * HTB, NXCD = 8, WGM = 8;

__host__ __device__ __forceinline__ int lds_byte(int r, int c) { const int st = (r >> 4) * 2 + (c >> 5), rr = r & 15, cc = c & 31, ob = rr * 64 + cc * 2; return st * 1024 + (ob ^ (((ob >> 9) & 1) << 5)); }
__host__ __device__ __forceinline__ void stage_rc(int b, int& R, int& C) { const int st = b / 1024, sb = b % 1024, swz = sb ^ (((sb >> 9) & 1) << 5); R = (st >> 1) * 16 + swz / 64; C = (st & 1) * 32 + (swz % 64) / 2; }
__host__ __device__ __forceinline__ int perm32(int rho) { const int n = rho >> 4, i = rho & 15; return 8 * (i >> 2) + 4 * n + (i & 3); }

struct Unit { int pm, pn; };
struct Gemm { const bf16_t* A; const bf16_t* Bt; int M, N, K; };

struct StaticOrder {
    int nM, nN, nwg, G, c;
    __host__ __device__ void init(int M, int N, int G_, int c_) { nM = M / BM; nN = N / BM; nwg = nM * nN; G = G_; c = c_; }
    __host__ __device__ bool next(int i, Unit& u) const {
        const long L = (long)i * G + c; if (L >= nwg) return false;
        int wgid = (int)L; { const int q = nwg / NXCD, r = nwg % NXCD, xcd = wgid % NXCD, off = wgid / NXCD; wgid = (xcd < r ? xcd * (q + 1) : r * (q + 1) + (xcd - r) * q) + off; }
        const int nig = WGM * nN, gid = wgid / nig, fm = gid * WGM, gsz = (nM - fm) < WGM ? (nM - fm) : WGM;
        u.pm = fm + ((wgid % nig) % gsz); u.pn = (wgid % nig) / gsz; return true;
    }
    __device__ __forceinline__ void a_ready(const Unit&) const {}
    __device__ __forceinline__ void done(const Unit&) const {}
};

__device__ __forceinline__ unsigned cvt_pk_bf16(float lo, float hi) { unsigned r; asm volatile("v_cvt_pk_bf16_f32 %0, %1, %2" : "=v"(r) : "v"(lo), "v"(hi)); return r; }
typedef float f32x2 __attribute__((ext_vector_type(2)));
struct EpiF32Plain {
    static constexpr bool PERM = false, AFTER_DRAIN = false;
    float* C; int ldc; int pn_mask;
    __device__ __forceinline__ void operator()(const f32x4 (&acc)[2][2][4][2], const Unit& u, int wr, int wc, int fr, int fq) const {
        const int row0 = u.pm * BM + wr * 64 + fr, col0 = (u.pn & pn_mask) * BM + wc * 32 + 4 * fq;
#pragma unroll
        for (int ai = 0; ai < 2; ++ai)
#pragma unroll
            for (int m = 0; m < 4; ++m) { float* rowp = C + (size_t)(row0 + ai * HALF + m * 16) * ldc + col0;
#pragma unroll
                for (int bj = 0; bj < 2; ++bj)
#pragma unroll
                    for (int n = 0; n < 2; ++n) *(f32x4*)(rowp + bj * HALF + n * 16) = acc[ai][bj][m][n]; }
    }
};
struct EpiBf16Plain {
    static constexpr bool PERM = true, AFTER_DRAIN = false;
    bf16_t* O; int ldc; int pn_mask;
    __device__ __forceinline__ void operator()(const f32x4 (&acc)[2][2][4][2], const Unit& u, int wr, int wc, int fr, int fq) const {
        const int row0 = u.pm * BM + wr * 64 + fr, col0 = (u.pn & pn_mask) * BM + wc * 32 + 8 * fq;
#pragma unroll
        for (int ai = 0; ai < 2; ++ai)
#pragma unroll
            for (int m = 0; m < 4; ++m) { bf16_t* rowp = O + (size_t)(row0 + ai * HALF + m * 16) * ldc + col0;
#pragma unroll
                for (int bj = 0; bj < 2; ++bj) { const f32x4 v0 = acc[ai][bj][m][0], v1 = acc[ai][bj][m][1];
                    u32x4 w; w.x = cvt_pk_bf16(v0[0], v0[1]); w.y = cvt_pk_bf16(v0[2], v0[3]); w.z = cvt_pk_bf16(v1[0], v1[1]); w.w = cvt_pk_bf16(v1[2], v1[3]);
                    *(u32x4*)(rowp + bj * HALF) = w; } }
    }
};
struct EpiQRope {
    static constexpr bool PERM = true, AFTER_DRAIN = false;
    bf16_t* O; const float* cs;
    __device__ __forceinline__ void operator()(const f32x4 (&acc)[2][2][4][2], const Unit& u, int wr, int wc, int fr, int fq) const {
        const int row0 = u.pm * BM + wr * 64 + fr;
#pragma unroll
        for (int ai = 0; ai < 2; ++ai)
#pragma unroll
            for (int m = 0; m < 4; ++m) { const int row = row0 + ai * HALF + m * 16; const int bb = row >= 4352 ? 1 : 0; const int l = row - bb * 4352; const bool lat = l < 4096; const int lp = lat ? l : 0;
#pragma unroll
                for (int bj = 0; bj < 2; ++bj) { const int c0 = u.pn * BM + bj * HALF + wc * 32 + 8 * fq; const int hh = c0 / 192, jj = c0 - hh * 192;
                    f32x4 v0 = acc[ai][bj][m][0], v1 = acc[ai][bj][m][1];
                    if (jj >= 128 && lat) { const f32x4* cp = (const f32x4*)(cs + ((size_t)lp * 32 + ((jj - 128) >> 1)) * 2); const f32x4 ca = cp[0], cb = cp[1];
                        const f32x4 a = v0, b = v1;
                        v0[0] = a[0] * ca[0] - a[1] * ca[1]; v0[1] = a[1] * ca[0] + a[0] * ca[1]; v0[2] = a[2] * ca[2] - a[3] * ca[3]; v0[3] = a[3] * ca[2] + a[2] * ca[3];
                        v1[0] = b[0] * cb[0] - b[1] * cb[1]; v1[1] = b[1] * cb[0] + b[0] * cb[1]; v1[2] = b[2] * cb[2] - b[3] * cb[3]; v1[3] = b[3] * cb[2] + b[2] * cb[3]; }
                    u32x4 w; w.x = cvt_pk_bf16(v0[0], v0[1]); w.y = cvt_pk_bf16(v0[2], v0[3]); w.z = cvt_pk_bf16(v1[0], v1[1]); w.w = cvt_pk_bf16(v1[2], v1[3]);
                    *(u32x4*)(O + (size_t)row * 3072 + c0) = w; } }
    }
};
struct EpiResid {
    static constexpr bool PERM = false, AFTER_DRAIN = false;
    const float* base; float* out; const float* gate; int gstride;
    __device__ __forceinline__ void operator()(const f32x4 (&acc)[2][2][4][2], const Unit& u, int wr, int wc, int fr, int fq) const {
        const int row0 = u.pm * BM + wr * 64 + fr, col0 = u.pn * BM + wc * 32 + 4 * fq; const float* gp = gate + (size_t)(u.pm >> 4) * gstride + col0;
        f32x4 gv[2][2];
#pragma unroll
        for (int bj = 0; bj < 2; ++bj)
#pragma unroll
            for (int n = 0; n < 2; ++n) gv[bj][n] = *(const f32x4*)(gp + bj * HALF + n * 16);
#pragma unroll
        for (int ai = 0; ai < 2; ++ai)
#pragma unroll
            for (int m = 0; m < 4; ++m) { const size_t off = (size_t)(row0 + ai * HALF + m * 16) * 2048 + col0;
#pragma unroll
                for (int bj = 0; bj < 2; ++bj)
#pragma unroll
                    for (int n = 0; n < 2; ++n) { const f32x4 bs = *(const f32x4*)(base + off + bj * HALF + n * 16); *(f32x4*)(out + off + bj * HALF + n * 16) = bs + gv[bj][n] * acc[ai][bj][m][n]; }
                asm volatile("" ::: "memory"); }
    }
};
struct EpiSwiGLU {
    static constexpr bool PERM = true, AFTER_DRAIN = false;
    bf16_t* O;
    __device__ __forceinline__ float silu(float g) const { return g * __builtin_amdgcn_rcpf(1.0f + __builtin_amdgcn_exp2f(-1.4426950408889634f * g)); }
    __device__ __forceinline__ void operator()(const f32x4 (&acc)[2][2][4][2], const Unit& u, int wr, int wc, int fr, int fq) const {
        const int row0 = u.pm * BM + wr * 64 + fr, col0 = (u.pn & 7) * 128 + wc * 32 + 8 * fq;
#pragma unroll
        for (int ai = 0; ai < 2; ++ai)
#pragma unroll
            for (int m = 0; m < 4; ++m) { const f32x4 g0 = acc[ai][0][m][0], g1 = acc[ai][0][m][1], u0 = acc[ai][1][m][0], u1 = acc[ai][1][m][1];
                u32x4 w; w.x = cvt_pk_bf16(silu(g0[0]) * u0[0], silu(g0[1]) * u0[1]); w.y = cvt_pk_bf16(silu(g0[2]) * u0[2], silu(g0[3]) * u0[3]);
                w.z = cvt_pk_bf16(silu(g1[0]) * u1[0], silu(g1[1]) * u1[1]); w.w = cvt_pk_bf16(silu(g1[2]) * u1[2], silu(g1[3]) * u1[3]);
                *(u32x4*)(O + (size_t)(row0 + ai * HALF + m * 16) * 1024 + col0) = w; }
    }
};
struct HfOrder {
    int G, c, skip;
    __device__ __forceinline__ bool next(int i, Unit& u) const {
        int L;
        if (G > skip + 8) { if (c < skip) return false; L = (c - skip) + i * (G - skip); } else L = i * G + c;
        if (L >= 512) return false;
        const int dir = L >> 8, w = L & 255; u.pm = dir * 16 + (w & 15); u.pn = dir * 16 + (w >> 4); return true;
    }
    __device__ __forceinline__ void a_ready(const Unit&) const {}
    __device__ __forceinline__ void done(const Unit&) const {}
};
struct MoeOrder {
    int G, c;
    __device__ __forceinline__ bool next(int i, Unit& u) const {
        int e, j;
        if (G == 256) { if (i >= 2) return false; e = i * 8 + (c & 7); j = c >> 3; }
        else { const int L = i * G + c; if (L >= 512) return false; e = L >> 5; j = L & 31; }
        u.pm = e * 4 + (j & 3); u.pn = e * 8 + (j >> 2); return true;
    }
    __device__ __forceinline__ void a_ready(const Unit&) const {}
    __device__ __forceinline__ void done(const Unit&) const {}
};

template <class Epi, class Sched, bool ALIGN_EPI = false, bool SP2 = false>
__device__ __forceinline__ void gemm_phase(PG8_LAS unsigned char* lds, const Gemm g, const Sched& S, const Epi& E) {
    const int tid = threadIdx.x, wid = __builtin_amdgcn_readfirstlane(tid >> 6), lane = tid & 63, wr = wid >> 2, wc = wid & 3, fr = lane & 15, fq = lane >> 4;
    const int K = g.K, nt = K / BK;
    unsigned voffA[2], voffB[2];
#pragma unroll
    for (int i = 0; i < 2; ++i) { int R, C; stage_rc(tid * 16 + i * 8192, R, C); const int Rb = Epi::PERM ? ((R & ~31) + perm32(R & 31)) : R;
        voffA[i] = (unsigned)(R * K + C) * 2u; voffB[i] = (unsigned)(Rb * K + C) * 2u; }
    const size_t kstep = (size_t)(BK * 2);
    const size_t hstep = (size_t)HALF * K * 2;
    const size_t tstep = 2 * hstep;
    const unsigned ldsw = (unsigned)wid * 1024u;
    const int aoff = lds_byte(wr * 64 + fr, fq * 8), boff = lds_byte(wc * 32 + fr, fq * 8);
#define PG8_SA(b, h) (((b) * 2 + (h)) * HTB)
#define PG8_SB(b, h) ((4 + (b) * 2 + (h)) * HTB)
#define PG8_STAGE(bufoff, gbase, voff) do { _Pragma("unroll") for (int _i = 0; _i < 2; ++_i) \
        __builtin_amdgcn_global_load_lds((const unsigned*)((const char*)(gbase) + (voff)[_i]), (PG8_LAS unsigned*)(lds + (bufoff) + ldsw + _i * 8192), 16, 0, 0); } while (0)
#define PG8_LDA(dst, b, h) do { _Pragma("unroll") for (int m = 0; m < 4; ++m) _Pragma("unroll") for (int k = 0; k < 2; ++k) dst[m][k] = *(const PG8_LAS bf16x8*)(lds + PG8_SA(b, h) + aoff + m * 2048 + k * 1024); } while (0)
#define PG8_LDB(dst, b, h) do { _Pragma("unroll") for (int n = 0; n < 2; ++n) _Pragma("unroll") for (int k = 0; k < 2; ++k) dst[n][k] = *(const PG8_LAS bf16x8*)(lds + PG8_SB(b, h) + boff + n * 2048 + k * 1024); } while (0)
#define PG8_MMA(ai, bj, At, Bt) do { __builtin_amdgcn_s_setprio(1); _Pragma("unroll") for (int m = 0; m < 4; ++m) _Pragma("unroll") for (int n = 0; n < 2; ++n) _Pragma("unroll") for (int k = 0; k < 2; ++k) \
        acc[ai][bj][m][n] = __builtin_amdgcn_mfma_f32_16x16x32_bf16(Bt[n][k], At[m][k], acc[ai][bj][m][n], 0, 0, 0); __builtin_amdgcn_s_setprio(0); } while (0)
#define PG8_WAIT_V(n) asm volatile("s_waitcnt vmcnt(" #n ")" ::: "memory")
#define PG8_WAIT_L(n) asm volatile("s_waitcnt lgkmcnt(" #n ")" ::: "memory")
#define PG8_BAR __builtin_amdgcn_s_barrier()
#define PG8_SCHED __builtin_amdgcn_sched_barrier(0)
    Unit cur, nxt; int ui = 0;
    if (!S.next(0, cur)) return;
    f32x4 acc[2][2][4][2];
#pragma unroll
    for (int a = 0; a < 2; ++a)
#pragma unroll
        for (int b = 0; b < 2; ++b)
#pragma unroll
            for (int m = 0; m < 4; ++m)
#pragma unroll
                for (int n = 0; n < 2; ++n) acc[a][b][m][n] = (f32x4){0.f, 0.f, 0.f, 0.f};
    bf16x8 At[4][2], B0[2][2], B1[2][2];
    const char* cA = (const char*)g.A + (size_t)cur.pm * tstep; const char* cB = (const char*)g.Bt + (size_t)cur.pn * tstep;
    S.a_ready(cur);
    if constexpr (SP2) {
        PG8_STAGE(PG8_SB(0, 0), cB, voffB); PG8_STAGE(PG8_SB(0, 1), cB + hstep, voffB); PG8_STAGE(PG8_SA(0, 0), cA, voffA); PG8_STAGE(PG8_SA(0, 1), cA + hstep, voffA);
        if (wr == 1) PG8_BAR;
        PG8_WAIT_V(2); PG8_BAR;
        PG8_STAGE(PG8_SB(1, 0), cB + kstep, voffB); PG8_STAGE(PG8_SA(1, 0), cA + kstep, voffA); PG8_STAGE(PG8_SB(1, 1), cB + hstep + kstep, voffB);
        PG8_WAIT_V(6); PG8_BAR;
    } else {
        PG8_STAGE(PG8_SB(0, 0), cB, voffB); PG8_STAGE(PG8_SA(0, 0), cA, voffA); PG8_STAGE(PG8_SB(0, 1), cB + hstep, voffB); PG8_STAGE(PG8_SA(0, 1), cA + hstep, voffA);
        if (wr == 1) PG8_BAR;
        PG8_WAIT_V(4); PG8_BAR;
        PG8_STAGE(PG8_SB(1, 0), cB + kstep, voffB); PG8_STAGE(PG8_SA(1, 0), cA + kstep, voffA); PG8_STAGE(PG8_SB(1, 1), cB + hstep + kstep, voffB);
        PG8_WAIT_V(6); PG8_BAR;
    }
    for (;;) {
        const bool has_next = S.next(ui + 1, nxt);
        const char* nA = has_next ? (const char*)g.A + (size_t)nxt.pm * tstep : cA; const char* nB = has_next ? (const char*)g.Bt + (size_t)nxt.pn * tstep : cB;
        for (int t = 0; t < nt; t += 2) {
            const bool last = (t == nt - 2);
            const char* a1 = cA + (size_t)(t + 1) * kstep;
            const char* a2 = last ? nA : cA + (size_t)(t + 2) * kstep; const char* b2 = last ? nB : cB + (size_t)(t + 2) * kstep;
            const char* a3 = a2 + kstep; const char* b3 = b2 + kstep;
            if (last && has_next) S.a_ready(nxt);
            if constexpr (SP2) {
            PG8_LDB(B0, 0, 0); PG8_LDB(B1, 0, 1); PG8_SCHED; PG8_LDA(At, 0, 0); PG8_STAGE(PG8_SA(1, 1), a1 + hstep, voffA);
            PG8_WAIT_V(8); PG8_WAIT_L(0); PG8_BAR; PG8_MMA(0, 0, At, B0); PG8_MMA(0, 1, At, B1); PG8_BAR; PG8_SCHED;
            PG8_LDA(At, 0, 1); PG8_STAGE(PG8_SB(0, 0), b2, voffB); PG8_STAGE(PG8_SB(0, 1), b2 + hstep, voffB); PG8_STAGE(PG8_SA(0, 0), a2, voffA);
            PG8_WAIT_V(8); PG8_WAIT_L(0); PG8_BAR; PG8_MMA(1, 0, At, B0); PG8_MMA(1, 1, At, B1); PG8_BAR; PG8_SCHED;
            PG8_LDB(B0, 1, 0); PG8_LDB(B1, 1, 1); PG8_SCHED; PG8_LDA(At, 1, 0); PG8_STAGE(PG8_SA(0, 1), a2 + hstep, voffA);
            PG8_WAIT_V(8); PG8_WAIT_L(0); PG8_BAR; PG8_MMA(0, 0, At, B0); PG8_MMA(0, 1, At, B1); PG8_BAR; PG8_SCHED;
            PG8_LDA(At, 1, 1); PG8_STAGE(PG8_SB(1, 0), b3, voffB); PG8_STAGE(PG8_SB(1, 1), b3 + hstep, voffB); PG8_STAGE(PG8_SA(1, 0), a3, voffA);
            PG8_WAIT_V(8); PG8_WAIT_L(0); PG8_BAR; PG8_MMA(1, 0, At, B0); PG8_MMA(1, 1, At, B1); PG8_BAR; PG8_SCHED;
            } else {
            PG8_LDB(B0, 0, 0); PG8_SCHED; PG8_LDA(At, 0, 0); PG8_STAGE(PG8_SA(1, 1), a1 + hstep, voffA);
            PG8_WAIT_L(8); PG8_BAR; PG8_WAIT_L(0); PG8_MMA(0, 0, At, B0); PG8_BAR; PG8_SCHED;
            PG8_LDB(B1, 0, 1); PG8_STAGE(PG8_SB(0, 0), b2, voffB);
            PG8_BAR; PG8_WAIT_L(0); PG8_MMA(0, 1, At, B1); PG8_BAR;
            PG8_LDA(At, 0, 1); PG8_STAGE(PG8_SA(0, 0), a2, voffA);
            PG8_BAR; PG8_WAIT_L(0); PG8_MMA(1, 0, At, B0); PG8_BAR; PG8_SCHED;
            PG8_STAGE(PG8_SB(0, 1), b2 + hstep, voffB);
            PG8_WAIT_V(6); PG8_BAR; PG8_MMA(1, 1, At, B1); PG8_BAR;
            PG8_LDB(B0, 1, 0); PG8_SCHED; PG8_LDA(At, 1, 0); PG8_STAGE(PG8_SA(0, 1), a2 + hstep, voffA);
            PG8_WAIT_L(8); PG8_BAR; PG8_WAIT_L(0); PG8_MMA(0, 0, At, B0); PG8_BAR; PG8_SCHED;
            PG8_LDB(B1, 1, 1); PG8_STAGE(PG8_SB(1, 0), b3, voffB);
            PG8_BAR; PG8_WAIT_L(0); PG8_MMA(0, 1, At, B1); PG8_BAR;
            PG8_LDA(At, 1, 1); PG8_STAGE(PG8_SA(1, 0), a3, voffA);
            PG8_BAR; PG8_WAIT_L(0); PG8_MMA(1, 0, At, B0); PG8_BAR; PG8_SCHED;
            PG8_STAGE(PG8_SB(1, 1), b3 + hstep, voffB);
            PG8_WAIT_V(6); PG8_BAR; PG8_MMA(1, 1, At, B1); PG8_BAR;
            }
        }
        if constexpr (ALIGN_EPI) { if (wr == 0) PG8_BAR; }
        if constexpr (!Epi::AFTER_DRAIN) { E(acc, cur, wr, wc, fr, fq); S.done(cur); }
        if (!has_next) break;
#pragma unroll
        for (int a = 0; a < 2; ++a)
#pragma unroll
            for (int b = 0; b < 2; ++b)
#pragma unroll
                for (int m = 0; m < 4; ++m)
#pragma unroll
                    for (int n = 0; n < 2; ++n) acc[a][b][m][n] = (f32x4){0.f, 0.f, 0.f, 0.f};
        cur = nxt; cA = nA; cB = nB; ++ui;
        if constexpr (ALIGN_EPI) { if (wr == 1) PG8_BAR; }
    }
    PG8_WAIT_V(0);
    if constexpr (!ALIGN_EPI) { if (wr == 0) PG8_BAR; }
    PG8_BAR;
    if constexpr (Epi::AFTER_DRAIN) { E.fused(acc, cur, wr, wc, fr, fq, lds, wid, lane); S.done(cur); }
#undef PG8_SA
#undef PG8_SB
#undef PG8_STAGE
#undef PG8_LDA
#undef PG8_LDB
#undef PG8_MMA
#undef PG8_WAIT_V
#undef PG8_WAIT_L
#undef PG8_BAR
#undef PG8_SCHED
}
}
#define GAS __attribute__((address_space(1)))
#define LAS __attribute__((address_space(3)))
typedef unsigned short bf16;
typedef unsigned v4u __attribute__((ext_vector_type(4)));
typedef unsigned v2u __attribute__((ext_vector_type(2)));
typedef float f32x4 __attribute__((ext_vector_type(4)));
typedef float f32x2 __attribute__((ext_vector_type(2)));
typedef float f32x16 __attribute__((ext_vector_type(16)));
typedef short bf16x8 __attribute__((ext_vector_type(8)));
typedef short s16x4 __attribute__((ext_vector_type(4)));
typedef GAS unsigned gu32;
#define RLX_AGENT __ATOMIC_RELAXED, __HIP_MEMORY_SCOPE_AGENT
#define LDS_WAIT() asm volatile("s_waitcnt lgkmcnt(0)" ::: "memory")
#define VM_WAIT() asm volatile("s_waitcnt vmcnt(0)" ::: "memory")
__device__ __forceinline__ unsigned pk2(float lo, float hi) { unsigned r; asm volatile("v_cvt_pk_bf16_f32 %0, %1, %2" : "=v"(r) : "v"(lo), "v"(hi)); return r; }
__device__ __forceinline__ float bf_lo(unsigned w) { return __uint_as_float(w << 16); }
__device__ __forceinline__ float bf_hi(unsigned w) { return __uint_as_float(w & 0xffff0000u); }
__device__ __forceinline__ float bf1(bf16 h) { return __uint_as_float(((unsigned)h) << 16); }
__device__ __forceinline__ int opq(int x) { asm volatile("" : "+v"(x)); return x; }
__device__ __forceinline__ float wave_sum(float v) {
#pragma unroll
    for (int o = 1; o < 64; o <<= 1) v += __shfl_xor(v, o);
    return v;
}
__device__ __forceinline__ int wave_sum_i(int v) {
#pragma unroll
    for (int o = 1; o < 64; o <<= 1) v += __shfl_xor(v, o);
    return v;
}

#define XB_TMO      128
#define XB_XCNT(j)  (256  + 64 * (j))
#define XB_XSUB(j)  (1280 + 64 * (j))
#define XB_XGEN(j)  (2304 + 64 * (j))
#define XB_TOP      3328
#define XB_TOPGEN   3392
#define XCD_BAR_WORDS 3456
#define XB_SPIN_CAP (1u << 18)

__device__ __forceinline__ unsigned xb_ld(unsigned* p)              { return __hip_atomic_load(p, __ATOMIC_RELAXED, __HIP_MEMORY_SCOPE_AGENT); }
__device__ __forceinline__ unsigned xb_add(unsigned* p, unsigned v) { return __hip_atomic_fetch_add(p, v, __ATOMIC_RELAXED, __HIP_MEMORY_SCOPE_AGENT); }
__device__ __forceinline__ unsigned xb_xcc_id() { return (unsigned)__builtin_amdgcn_s_getreg((3 << 11) | 20) & 0xFu; }
#define XB_SPIN(cond, bar) do { unsigned _sp = 0; while (cond) { __builtin_amdgcn_s_sleep(1); \
    if ((++_sp & 255u) == 0u) { if (xb_ld(&(bar)[XB_TMO])) break; if (_sp > XB_SPIN_CAP) { atomicAdd(&(bar)[XB_TMO], 1u); break; } } } } while (0)

struct XcdBarrier {
    unsigned* bar; unsigned x;
    volatile LAS unsigned* st;
};

__device__ __forceinline__ XcdBarrier xcd_barrier_post(unsigned* bar, volatile LAS unsigned* st) {
    XcdBarrier b; b.bar = bar; b.x = xb_xcc_id(); b.st = st;
    if (threadIdx.x == 0) (void)xb_add(&bar[XB_XCNT(b.x)], 1u);
    return b;
}
__device__ __forceinline__ void xcd_barrier_complete(unsigned* bar, unsigned x, unsigned& nloc, unsigned& nx) {
    const unsigned G = gridDim.x * gridDim.y * gridDim.z;
    unsigned sum, cnt, mine, sp = 0u;
    for (;;) {
        sum = 0u; cnt = 0u; mine = 0u;
#pragma unroll
        for (unsigned j = 0; j < 16; ++j) { const unsigned c = xb_ld(&bar[XB_XCNT(j)]); sum += c; cnt += (c > 0u) ? 1u : 0u; mine = (j == x) ? c : mine; }
        if (sum == G) break;
        __builtin_amdgcn_s_sleep(1);
        if ((++sp & 255u) == 0u) { if (xb_ld(&bar[XB_TMO])) break; if (sp > XB_SPIN_CAP) { atomicAdd(&bar[XB_TMO], 1u); break; } }
    }
    nloc = mine > 0u ? mine : 1u; nx = cnt > 0u ? cnt : 1u;
}

__device__ __forceinline__ void xcd_barrier(const XcdBarrier& b) {
    asm volatile("s_waitcnt vmcnt(0)" ::: "memory");
    __syncthreads();
    if (threadIdx.x == 0) {
        unsigned* bar = b.bar;
        __builtin_amdgcn_s_waitcnt(0);
        unsigned nloc = b.st[0], nx = b.st[1];
        if (nloc == 0u) { xcd_barrier_complete(bar, b.x, nloc, nx); b.st[0] = nloc; b.st[1] = nx; }
        const unsigned old = xb_add(&bar[XB_XSUB(b.x)], 1u);
        const unsigned gen = old / nloc;
        if (old + 1u == (gen + 1u) * nloc) {
            __builtin_amdgcn_fence(__ATOMIC_RELEASE, "agent");
            asm volatile("s_waitcnt vmcnt(0)" ::: "memory");
            const unsigned og = xb_add(&bar[XB_TOP], 1u);
            const unsigned tg = og / nx;
            if (og + 1u == (tg + 1u) * nx) xb_add(&bar[XB_TOPGEN], 1u);
            else XB_SPIN(xb_ld(&bar[XB_TOPGEN]) == tg, bar);
            __builtin_amdgcn_fence(__ATOMIC_ACQUIRE, "agent");
            xb_add(&bar[XB_XGEN(b.x)], 1u);
            asm volatile("s_waitcnt vmcnt(0)" ::: "memory");
        } else {
            XB_SPIN(xb_ld(&bar[XB_XGEN(b.x)]) == gen, bar);
            __builtin_amdgcn_fence(__ATOMIC_ACQUIRE, "agent");
            asm volatile("s_waitcnt vmcnt(0)" ::: "memory");
        }
    }
    __syncthreads();
}

constexpr int NWAVES = 8;
constexpr int DM = 2048, NB = 2, SEQ = 4096, CTXL = 256, LT = SEQ + CTXL  , MT = NB * LT  , MX = NB * SEQ  ;
constexpr int NH = 16, QRANK = 512, KVRANK = 256, INDIM = 832, INPAD = 1024, QW = NH * 192  , KVW = NH * 256  ;
constexpr int NE = 16, CAP = 512, FFD = 1024, MROWS = NB * NE * CAP  ;
constexpr float EPS = 1e-6f;
constexpr size_t MiB = 1u << 20;
constexpr size_t WS_CTL = 0, CTL_ZERO_BYTES = 1 * MiB;
constexpr size_t WS_MOD = 64 * 1024;
constexpr size_t WS_CS = 1 * MiB, WS_A2S = 2 * MiB  , WS_A2RS = 4 * MiB  , WS_W3S = 58 * MiB  , WS_TW = 6 * MiB  , WS_AFF = 7 * MiB  , WS_TOK = 7 * MiB + 512 * 1024  ;
constexpr size_t WS_WIN = 8 * MiB, WS_WUQ = 12 * MiB, WS_WUKV = 15 * MiB, WS_WO = 17 * MiB, WS_HYWOUT = 25 * MiB, WS_HYWIN = 33 * MiB;
constexpr size_t WS_WGU = 64 * MiB  , WS_WD = 320 * MiB  ;
constexpr size_t WS_H = 448 * MiB  , WS_PROJ = 482 * MiB  , WS_CQN = 516 * MiB, WS_CKVN = 525 * MiB, WS_KROPE = 530 * MiB;
constexpr size_t WS_Q = 532 * MiB, WS_KV = 583 * MiB, WS_O = 651 * MiB, WS_X1 = 683 * MiB  , WS_XG = 747 * MiB, WS_ACT = 811 * MiB, WS_Y = 843 * MiB, WS_HF = 907 * MiB  , WS_END = 1035 * MiB;
constexpr size_t WS_U = 532 * MiB  , WS_ZT = 628 * MiB  , WS_Z = 482 * MiB  ;
constexpr int CW_TMO = 0, CW_BAR = 4096;
constexpr int LDS_BYTES = 155648, MISC_OFF = 153600;
constexpr int NPHASE = 21;

struct Frame {
    LAS unsigned char* lds; unsigned char* ldsg;
    int tid, wave, vcu, G;
    float* out; unsigned char* ws;
};
__device__ __forceinline__ const float* arg_in(int i) {
    const __attribute__((address_space(4))) unsigned long long* ka = (const __attribute__((address_space(4))) unsigned long long*)__builtin_amdgcn_kernarg_segment_ptr();
    asm volatile("" : "+s"(ka));
    return (const float*)(const __attribute__((address_space(1))) float*)ka[i];
}
#define WSP(T, off) ((T*)(F.ws + (off)))

__device__ __forceinline__ int uq_srccol(int n) { const int hh = n / 192, jj = n - hh * 192; if (jj < 128) return n; const int r = jj - 128; return hh * 192 + 128 + (r >> 1) + 32 * (r & 1); }
template <bool VEC>
__device__ __forceinline__ void transpose_item(const float* src, int N, int c0, int k0, bf16* dst, int K, LAS float* scr, int lane) {
    if constexpr (VEC) {
        const float* s = src + (size_t)k0 * N + c0 + (lane & 15) * 4;
        f32x4 v[16];
#pragma unroll
        for (int i = 0; i < 16; ++i) v[i] = __builtin_nontemporal_load((const f32x4*)(s + (size_t)(4 * i + (lane >> 4)) * N));
#pragma unroll
        for (int i = 0; i < 16; ++i) { LAS float* d = scr + (4 * i + (lane >> 4)) * 65 + (lane & 15) * 4; d[0] = v[i][0]; d[1] = v[i][1]; d[2] = v[i][2]; d[3] = v[i][3]; }
    } else {
        const int sc = uq_srccol(c0 + lane);
        const float* s = src + (size_t)k0 * N + sc;
#pragma unroll 16
        for (int kk = 0; kk < 64; ++kk) scr[kk * 65 + lane] = s[(size_t)kk * N];
    }
    LDS_WAIT(); asm volatile("" ::: "memory");
    const int c = lane & 7;
#pragma unroll
    for (int jj = 0; jj < 8; ++jj) { const int n = (lane >> 3) + 8 * jj; const LAS float* s = scr + (8 * c) * 65 + n;
        v4u o; o.x = pk2(s[0 * 65], s[1 * 65]); o.y = pk2(s[2 * 65], s[3 * 65]); o.z = pk2(s[4 * 65], s[5 * 65]); o.w = pk2(s[6 * 65], s[7 * 65]);
        *(v4u*)(dst + (size_t)n * K + k0 + 8 * c) = o; }
    LDS_WAIT(); asm volatile("" ::: "memory");
}
__device__ __forceinline__ float silu_f(float x) { return x / (1.0f + __expf(-x)); }

constexpr int CI0 = 32 * 13, CI1 = 8 * 48, CI2 = 4 * 64, CI_EARLY = CI0 + CI1 + CI2;
constexpr int CI3 = 32 * 32, CI4 = 32 * 32, CI5 = 32 * 96, CI_GU = 32 * 1024, CI_D = 32 * 512, CI_LATE = CI3 + CI4 + CI5 + CI_GU + CI_D;
__device__ __forceinline__ void convert_early(Frame& F) {
    const int lane = opq(F.tid) & 63;
    const int gw = F.vcu * NWAVES + F.wave, NGW = F.G * NWAVES;
    LAS float* scr = (LAS float*)(F.lds + F.wave * 16640);
#pragma unroll 1
    for (int it = gw; it < CI_EARLY; it += NGW) {
        int r = it; const float* src; int N, c0, k0, K; bf16* dst; bool vec = true;
        if (r < CI0) { const int kb = r / 13, nb = r % 13; src = arg_in(8); N = INDIM; c0 = nb * 64; k0 = kb * 64; K = DM; dst = WSP(bf16, WS_WIN) + (size_t)nb * 64 * DM; }
        else if ((r -= CI0) < CI1) { const int kb = r / 48, nb = r % 48; src = arg_in(11); N = QW; c0 = nb * 64; k0 = kb * 64; K = QRANK; dst = WSP(bf16, WS_WUQ) + (size_t)nb * 64 * QRANK; vec = false; }
        else { r -= CI1; const int kb = r / 64, nb = r % 64; src = arg_in(12); N = KVW; c0 = nb * 64; k0 = kb * 64; K = KVRANK; dst = WSP(bf16, WS_WUKV) + (size_t)nb * 64 * KVRANK; }
        if (vec) transpose_item<true>(src, N, c0, k0, dst, K, scr, lane); else transpose_item<false>(src, N, c0, k0, dst, K, scr, lane);
    }
}
struct CvItem { const float* s; bf16* dst; int N, K; };
__device__ __forceinline__ CvItem cv_decode_late(Frame& F, int it, int lane) {
    int r = it; const float* src; int N, c0, k0, K; bf16* dst;
    if (r < CI3) { const int kb = r / 32, nb = r % 32; src = arg_in(13); N = DM; c0 = nb * 64; k0 = kb * 64; K = DM; dst = WSP(bf16, WS_WO) + (size_t)nb * 64 * DM; }
    else if ((r -= CI3) < CI4) { const int kb = r / 32, nb = r % 32; src = arg_in(25); N = DM; c0 = nb * 64; k0 = kb * 64; K = DM; dst = WSP(bf16, WS_HYWOUT) + (size_t)nb * 64 * DM; }
    else if ((r -= CI4) < CI5) { const int kb = r / 96, nb = r % 96; src = arg_in(14); N = 3 * DM; c0 = nb * 64; k0 = kb * 64; K = DM; dst = WSP(bf16, WS_HYWIN) + (size_t)nb * 64 * DM; }
    else if ((r -= CI5) < CI_GU) { const int le = r >> 10, q = r & 1023, kb = q >> 5, nb = q & 31;
        src = (((nb >> 1) & 1) ? arg_in(28) : arg_in(27)) + (size_t)le * DM * FFD; N = FFD; c0 = (nb >> 2) * 128 + (nb & 1) * 64; k0 = kb * 64; K = DM; dst = WSP(bf16, WS_WGU) + ((size_t)le * 2048 + nb * 64) * DM; }
    else { r -= CI_GU; const int le = r >> 9, q = r & 511, kb = q >> 5, nb = q & 31;
        src = arg_in(29) + (size_t)le * FFD * DM; N = DM; c0 = nb * 64; k0 = kb * 64; K = FFD; dst = WSP(bf16, WS_WD) + ((size_t)le * 2048 + nb * 64) * FFD; }
    CvItem d; d.s = src + (size_t)(k0 + (lane >> 4)) * N + c0 + (lane & 15) * 4; d.dst = dst + k0; d.N = N; d.K = K; return d;
}
__device__ __forceinline__ void cv_issue(const CvItem& d, f32x4 (&v)[16]) {
#pragma unroll
    for (int i = 0; i < 16; ++i) v[i] = __builtin_nontemporal_load((const f32x4*)(d.s + (size_t)(4 * i) * d.N));
}
__device__ __forceinline__ void cv_finish(const CvItem& d, const f32x4 (&v)[16], LAS float* scr, int lane) {
#pragma unroll
    for (int i = 0; i < 16; ++i) { LAS float* p = scr + (4 * i + (lane >> 4)) * 65 + (lane & 15) * 4; p[0] = v[i][0]; p[1] = v[i][1]; p[2] = v[i][2]; p[3] = v[i][3]; }
    LDS_WAIT(); asm volatile("" ::: "memory");
    const int c = lane & 7;
#pragma unroll
    for (int jj = 0; jj < 8; ++jj) { const int n = (lane >> 3) + 8 * jj; const LAS float* s = scr + (8 * c) * 65 + n;
        v4u o; o.x = pk2(s[0 * 65], s[1 * 65]); o.y = pk2(s[2 * 65], s[3 * 65]); o.z = pk2(s[4 * 65], s[5 * 65]); o.w = pk2(s[6 * 65], s[7 * 65]);
        *(v4u*)(d.dst + (size_t)n * d.K + 8 * c) = o; }
    LDS_WAIT(); asm volatile("" ::: "memory");
}
__device__ __forceinline__ void convert_late(Frame& F) {
    const int lane = opq(F.tid) & 63;
    const int gw = F.vcu * NWAVES + F.wave, NGW = F.G * NWAVES;
    LAS float* scr = (LAS float*)(F.lds + F.wave * 16640);
    __syncthreads();
    int it = gw; CvItem da, db; f32x4 va[16], vb[16];
    if (it < CI_LATE) { da = cv_decode_late(F, it, lane); cv_issue(da, va); }
#pragma unroll 1
    while (it < CI_LATE) {
        const int it2 = it + NGW; const bool h2 = it2 < CI_LATE;
        if (h2) { db = cv_decode_late(F, it2, lane); cv_issue(db, vb); }
        cv_finish(da, va, scr, lane);
        if (!h2) break;
        const int it3 = it2 + NGW; const bool h3 = it3 < CI_LATE;
        if (h3) { da = cv_decode_late(F, it3, lane); cv_issue(da, va); }
        cv_finish(db, vb, scr, lane);
        it = it3;
    }
    __syncthreads();
}
__device__ __forceinline__ void p0_prologue(Frame& F) {
    const int lane = opq(F.tid) & 63;
#ifndef NO_PA
    convert_early(F);
#endif
    __syncthreads();
#ifndef NO_PB
    {
        LAS float* sv = (LAS float*)F.lds;
        LAS float* part = sv + 3 * DM;
        { const float* cin = arg_in(1); const float* cctx = arg_in(3);
        for (int i = F.tid; i < 3 * DM; i += 512) { const float cv = i < 2 * DM ? cin[i] : cctx[i - 2 * DM]; sv[i] = silu_f(cv); } }
        __syncthreads();
        float* mod = WSP(float, WS_MOD); const float* adaw = arg_in(4); const float* adab = arg_in(5);
        const int q = F.tid % 24, kg = F.tid / 24;
        for (int un = F.vcu; un < 256; un += F.G) {
            const int layer = un >> 7, n0 = (un & 127) * 96;
            const float* W = adaw + (size_t)layer * DM * 6 * DM + n0 + q * 4;
            f32x4 a0 = {0.f, 0.f, 0.f, 0.f}, a1 = a0, a2 = a0;
            if (kg < 21) {
#pragma unroll 8
                for (int k = kg; k < DM; k += 21) { const f32x4 w = *(const f32x4*)(W + (size_t)k * (6 * DM)); a0 += sv[k] * w; a1 += sv[DM + k] * w; a2 += sv[2 * DM + k] * w; }
                LAS float* pp = part + kg * 288 + q * 4;
                *(LAS f32x4*)pp = a0; *(LAS f32x4*)(pp + 96) = a1; *(LAS f32x4*)(pp + 192) = a2;
            }
            __syncthreads();
            if (F.tid < 288) { const int m = F.tid / 96, nn = F.tid % 96; float s = adab[(size_t)layer * 6 * DM + n0 + nn];
#pragma unroll
                for (int g = 0; g < 21; ++g) s += part[g * 288 + F.tid];
                mod[((size_t)layer * 3 + m) * 6 * DM + n0 + nn] = s; }
            __syncthreads();
        }
    }
#endif
    __syncthreads();
#ifndef NO_PC
    {
        LAS float* h1s = (LAS float*)F.lds;
        const float* w1 = arg_in(17); const float* b1 = arg_in(18); const float* w2 = arg_in(19); const float* b2 = arg_in(20); const float* fr = arg_in(23);
        bf16* a2s = WSP(bf16, WS_A2S); bf16* a2rs = WSP(bf16, WS_A2RS);
        const int lp = F.tid >> 6, j = F.tid & 63;
        for (int un = F.vcu; un < SEQ / 8; un += F.G) {
            const int l = un * 8 + lp;
            const float t = (float)l / (float)SEQ, w = 6.283185307179586f * (float)l / (float)SEQ;
            float pre = b1[j] + t * w1[j];
#pragma unroll
            for (int i = 0; i < 16; ++i) { const float band = 1e-4f + (float)i * ((15.0f - 1e-4f) / 15.0f); const float ang = w * band;
                pre += cosf(ang) * w1[(1 + i) * 64 + j] - sinf(ang) * w1[(17 + i) * 64 + j]; }
            const float f = fr[j];
            __syncthreads();
            h1s[lp * 64 + j] = sinf(f * pre);
            __syncthreads();
            float p2 = b2[j];
#pragma unroll 8
            for (int i = 0; i < 64; ++i) p2 += h1s[lp * 64 + i] * w2[i * 64 + j];
            const float a = sinf(f * p2);
            const unsigned hi = pk2(a, 0.f) & 0xffffu; const unsigned lo = pk2(a - bf_lo(hi), 0.f) & 0xffffu;
            bf16* r0 = a2s + (size_t)l * 256; r0[j] = (bf16)hi; r0[64 + j] = (bf16)hi; r0[128 + j] = (bf16)lo; r0[192 + j] = 0;
            bf16* r1 = a2rs + (size_t)((SEQ - l) & (SEQ - 1)) * 256;
            if (l >= 1) { r1[j] = (bf16)hi; r1[64 + j] = (bf16)hi; r1[128 + j] = (bf16)lo; r1[192 + j] = 0; } else { r1[j] = 0; r1[64 + j] = 0; r1[128 + j] = 0; r1[192 + j] = 0; }
        }
        const float* w3 = arg_in(21); bf16* w3s = WSP(bf16, WS_W3S);
        for (int it = F.vcu * 512 + F.tid; it < 8192 * 8; it += F.G * 512) {
            const int j8 = it >> 13, r = it & 8191;
            const int dir = r >> 12, o = (r >> 11) & 1, d = r & 2047; const float* src = w3 + o * 4096 + dir * 2048 + d; bf16* dst = w3s + (size_t)r * 256;
            unsigned h[8], lw[8];
#pragma unroll
            for (int q = 0; q < 8; ++q) { const float v = src[(size_t)(j8 * 8 + q) * 8192]; h[q] = pk2(v, 0.f) & 0xffffu; lw[q] = pk2(v - bf_lo(h[q]), 0.f) & 0xffffu; }
            const v4u H = {h[0] | (h[1] << 16), h[2] | (h[3] << 16), h[4] | (h[5] << 16), h[6] | (h[7] << 16)}, Lw = {lw[0] | (lw[1] << 16), lw[2] | (lw[3] << 16), lw[4] | (lw[5] << 16), lw[6] | (lw[7] << 16)};
            *(v4u*)(dst + j8 * 8) = H; *(v4u*)(dst + 64 + j8 * 8) = Lw; *(v4u*)(dst + 128 + j8 * 8) = H; *(v4u*)(dst + 192 + j8 * 8) = (v4u){0u, 0u, 0u, 0u};
        }
    }
#endif
#ifndef NO_PD
    {
        f32x2* cs = WSP(f32x2, WS_CS);
        for (int i = F.vcu * 512 + F.tid; i < SEQ * 32; i += F.G * 512) { const int l = i >> 5, q = i & 31; const float pos = (float)((q < 16) ? (l >> 6) : (l & 63));
            const float inv = powf(10000.0f, -(float)(q & 15) / 16.0f); const float ang = pos * inv; cs[i] = (f32x2){cosf(ang), sinf(ang)}; }
        f32x2* tw = WSP(f32x2, WS_TW);
        for (int i = F.vcu * 512 + F.tid; i < 8192; i += F.G * 512) { float s, c; if (i < 4096) sincospif((float)i / 2048.0f, &s, &c); else sincospif((float)(i - 4096) / 4096.0f, &s, &c); tw[i] = (f32x2){c, -s}; }
    }
#endif
}

__device__ __forceinline__ void norm_store(const f32x4 (&v)[8], float rstd, const float* g, const float* shift, const float* scale, bf16* orow, int lane) {
#pragma unroll
    for (int j = 0; j < 8; ++j) { const int c = 4 * (64 * j + lane); const f32x4 g4 = *(const f32x4*)(g + c), sh = *(const f32x4*)(shift + c), sc = *(const f32x4*)(scale + c);
        const f32x4 y = v[j] * rstd * g4 * (1.0f + sc) + sh; v2u o; o.x = pk2(y[0], y[1]); o.y = pk2(y[2], y[3]); *(v2u*)(orow + c) = o; }
}
__device__ __forceinline__ void p1_norm0(Frame& F) {
    const int lane = opq(F.tid) & 63;
    const int gw = F.vcu * NWAVES + F.wave, NGW = F.G * NWAVES;
    const float* mod = WSP(float, WS_MOD); bf16* H = WSP(bf16, WS_H); const float* xin = arg_in(0); const float* cin = arg_in(2); const float* ng = arg_in(6);
    for (int row = gw; row < MT; row += NGW) {
        const int b = row >= LT ? 1 : 0, r = row - b * LT; const bool lat = r < SEQ;
        const float* xr = lat ? xin + ((size_t)b * SEQ + r) * DM : cin + ((size_t)b * CTXL + (r - SEQ)) * DM;
        const float* mr = mod + (size_t)(lat ? b : 2) * 6 * DM;
        f32x4 v[8]; float s = 0.f;
#pragma unroll
        for (int j = 0; j < 8; ++j) { v[j] = *(const f32x4*)(xr + 4 * (64 * j + lane)); s += (v[j][0] * v[j][0] + v[j][1] * v[j][1]) + (v[j][2] * v[j][2] + v[j][3] * v[j][3]); }
        const float rstd = 1.0f / sqrtf(wave_sum(s) * (1.0f / DM) + EPS);
        norm_store(v, rstd, ng, mr, mr + DM, H + (size_t)row * DM, lane);
    }
}
__device__ __forceinline__ void p3_latent(Frame& F) {
    const int lane = opq(F.tid) & 63;
    const int gw = F.vcu * NWAVES + F.wave, NGW = F.G * NWAVES;
    const float* proj = WSP(float, WS_PROJ); bf16* cqn = WSP(bf16, WS_CQN); bf16* ckvn = WSP(bf16, WS_CKVN); bf16* kro = WSP(bf16, WS_KROPE); const f32x2* cs = WSP(f32x2, WS_CS);
    const float* gq = arg_in(9); const float* gkv = arg_in(10);
    for (int row = gw; row < MT; row += NGW) {
        const float* pr = proj + (size_t)row * INPAD; const int l = row % LT;
        const f32x4 q0 = *(const f32x4*)(pr + 4 * lane), q1 = *(const f32x4*)(pr + 256 + 4 * lane), kv = *(const f32x4*)(pr + 512 + 4 * lane);
        float sq = (q0[0] * q0[0] + q0[1] * q0[1]) + (q0[2] * q0[2] + q0[3] * q0[3]) + (q1[0] * q1[0] + q1[1] * q1[1]) + (q1[2] * q1[2] + q1[3] * q1[3]);
        float sk = (kv[0] * kv[0] + kv[1] * kv[1]) + (kv[2] * kv[2] + kv[3] * kv[3]);
        const float rq = 1.0f / sqrtf(wave_sum(sq) * (1.0f / QRANK) + EPS), rk = 1.0f / sqrtf(wave_sum(sk) * (1.0f / KVRANK) + EPS);
        { const f32x4 g0 = *(const f32x4*)(gq + 4 * lane), g1 = *(const f32x4*)(gq + 256 + 4 * lane), g2 = *(const f32x4*)(gkv + 4 * lane);
          const f32x4 y0 = q0 * rq * g0, y1 = q1 * rq * g1, y2 = kv * rk * g2;
          v2u o; o.x = pk2(y0[0], y0[1]); o.y = pk2(y0[2], y0[3]); *(v2u*)(cqn + (size_t)row * QRANK + 4 * lane) = o;
          o.x = pk2(y1[0], y1[1]); o.y = pk2(y1[2], y1[3]); *(v2u*)(cqn + (size_t)row * QRANK + 256 + 4 * lane) = o;
          o.x = pk2(y2[0], y2[1]); o.y = pk2(y2[2], y2[3]); *(v2u*)(ckvn + (size_t)row * KVRANK + 4 * lane) = o; }
        if (lane < 32) { const float x1 = pr[768 + lane], x2 = pr[800 + lane]; float o1 = x1, o2 = x2;
            if (l < SEQ) { const f32x2 c = cs[(size_t)l * 32 + lane]; o1 = x1 * c.x - x2 * c.y; o2 = x2 * c.x + x1 * c.y; }
            ((unsigned*)(kro + (size_t)row * 64))[lane] = pk2(o1, o2); }
    }
}
__device__ __forceinline__ void p8_norm_router(Frame& F, int layer) {
    const int lane = opq(F.tid) & 63;
    const int gw = F.vcu * NWAVES + F.wave, NGW = F.G * NWAVES;
    const float* X = WSP(float, WS_X1); bf16* H = WSP(bf16, WS_H); float* aff = WSP(float, WS_AFF);
    const float* mod = WSP(float, WS_MOD) + (size_t)layer * 3 * 6 * DM; const float* g = arg_in(6) + (size_t)(layer * 2 + 1) * DM;
    LAS float* wr = (LAS float*)F.lds;
    __syncthreads();
    { const float* W = arg_in(26) + (size_t)layer * DM * NE;
      for (int i = F.tid; i < DM * NE / 4; i += 512) { const int c = i >> 2, q = i & 3; *(LAS f32x4*)(wr + c * 16 + (c >> 2) * 4 + q * 4) = *(const f32x4*)(W + (size_t)i * 4); } }
    __syncthreads();
    for (int row = gw; row < MX; row += NGW) {
        const int b = row >> 12, t = row & 4095; const float* xr = X + (size_t)row * DM; const float* shift = mod + (size_t)b * 6 * DM + 3 * DM; const float* scale = shift + DM;
        f32x4 v[8]; float s = 0.f;
#pragma unroll
        for (int j = 0; j < 8; ++j) { v[j] = *(const f32x4*)(xr + 4 * (64 * j + lane)); s += (v[j][0] * v[j][0] + v[j][1] * v[j][1]) + (v[j][2] * v[j][2] + v[j][3] * v[j][3]); }
        const float rstd = 1.0f / sqrtf(wave_sum(s) * (1.0f / DM) + EPS);
        f32x4 lg[4] = {{0.f, 0.f, 0.f, 0.f}, {0.f, 0.f, 0.f, 0.f}, {0.f, 0.f, 0.f, 0.f}, {0.f, 0.f, 0.f, 0.f}};
#pragma unroll
        for (int j = 0; j < 8; ++j) { const int c = 4 * (64 * j + lane); const f32x4 g4 = *(const f32x4*)(g + c), sh = *(const f32x4*)(shift + c), sc = *(const f32x4*)(scale + c);
            const f32x4 y = v[j] * rstd * g4 * (1.0f + sc) + sh; v2u o; o.x = pk2(y[0], y[1]); o.y = pk2(y[2], y[3]); *(v2u*)(H + (size_t)row * DM + c) = o;
            const LAS float* wp = wr + c * 16 + (c >> 2) * 4;
#pragma unroll
            for (int q = 0; q < 4; ++q) {
#pragma unroll
                for (int e4 = 0; e4 < 4; ++e4) lg[e4] += y[q] * *(const LAS f32x4*)(wp + q * 16 + e4 * 4); } }
        float lv[16];
#pragma unroll
        for (int e = 0; e < 16; ++e) lv[e] = wave_sum(lg[e >> 2][e & 3]);
        float mx = lv[0];
#pragma unroll
        for (int e = 1; e < 16; ++e) mx = fmaxf(mx, lv[e]);
        float den = 0.f;
#pragma unroll
        for (int e = 0; e < 16; ++e) { lv[e] = __expf(lv[e] - mx); den += lv[e]; }
        float mine = 0.f;
#pragma unroll
        for (int e = 0; e < 16; ++e) mine = (lane == e) ? lv[e] : mine;
        if (lane < 16) aff[((size_t)b * NE + lane) * SEQ + t] = mine / den;
    }
    __syncthreads();
}
__device__ __forceinline__ void p9_select_gather(Frame& F) {
    const int lane = opq(F.tid) & 63;
    const float* aff = WSP(float, WS_AFF); int* tok = WSP(int, WS_TOK); const bf16* H = WSP(bf16, WS_H); bf16* XG = WSP(bf16, WS_XG);
    LAS int* red = (LAS int*)F.lds;
    LAS int* sel = (LAS int*)(F.lds + 256);
    for (int un = F.vcu; un < NB * NE * 8; un += F.G) {
        const int be = un >> 3, part = un & 7, b = be >> 4, e = be & 15;
        const float* ar = aff + (size_t)be * SEQ + 8 * F.tid;
        const f32x4 a0 = *(const f32x4*)ar, a1 = *(const f32x4*)(ar + 4);
        unsigned key[8] = {__float_as_uint(a0[0]), __float_as_uint(a0[1]), __float_as_uint(a0[2]), __float_as_uint(a0[3]), __float_as_uint(a1[0]), __float_as_uint(a1[1]), __float_as_uint(a1[2]), __float_as_uint(a1[3])};
        __syncthreads();
        unsigned prefix = 0u;
        for (int bit = 30; bit >= 0; --bit) {
            const unsigned cand = prefix | (1u << bit); int c = 0;
#pragma unroll
            for (int i = 0; i < 8; ++i) c += (key[i] >= cand) ? 1 : 0;
            c = wave_sum_i(c);
            LAS int* slot = red + (bit & 1) * 8;
            if (lane == 0) slot[F.wave] = c;
            __syncthreads();
            int tot = 0;
#pragma unroll
            for (int w = 0; w < 8; ++w) tot += slot[w];
            if (tot >= CAP) prefix = cand;
        }
        int cgt = 0, ceq = 0;
#pragma unroll
        for (int i = 0; i < 8; ++i) { cgt += (key[i] > prefix) ? 1 : 0; ceq += (key[i] == prefix) ? 1 : 0; }
        int pk = (ceq << 16) | cgt, inc = pk;
#pragma unroll
        for (int o = 1; o < 64; o <<= 1) { const int y = __shfl_up(inc, o); if (lane >= o) inc += y; }
        __syncthreads();
        if (lane == 63) red[16 + F.wave] = inc;
        __syncthreads();
        int wpre = 0, total = 0;
#pragma unroll
        for (int w = 0; w < 8; ++w) { const int x = red[16 + w]; if (w < F.wave) wpre += x; total += x; }
        const int exc = wpre + inc - pk;
        const int need = CAP - (total & 0xffff);
        int eqb = exc >> 16, gtb = exc & 0xffff;
        int slotv[8];
#pragma unroll
        for (int i = 0; i < 8; ++i) { const bool gt = key[i] > prefix, eq = key[i] == prefix; const bool s = gt || (eq && eqb < need);
            const int before = gtb + (eqb < need ? eqb : need);
            slotv[i] = s ? before : -1; gtb += gt ? 1 : 0; eqb += eq ? 1 : 0; }
#pragma unroll
        for (int i = 0; i < 8; ++i) if (slotv[i] >= 0) sel[slotv[i]] = 8 * F.tid + i;
        if (part == 0) { int* tr = tok + (size_t)be * SEQ + 8 * F.tid; *(int4*)tr = make_int4(slotv[0], slotv[1], slotv[2], slotv[3]); *(int4*)(tr + 4) = make_int4(slotv[4], slotv[5], slotv[6], slotv[7]); }
        __syncthreads();
        { v4u rr[8][4];
#pragma unroll
        for (int i = 0; i < 8; ++i) { const int sl = part * 64 + F.wave * 8 + i; const int t = sel[sl];
            const v4u* src = (const v4u*)(H + ((size_t)b * SEQ + t) * DM) + lane;
#pragma unroll
            for (int q = 0; q < 4; ++q) rr[i][q] = src[64 * q]; }
#pragma unroll
        for (int i = 0; i < 8; ++i) { const int sl = part * 64 + F.wave * 8 + i; v4u* dst = (v4u*)(XG + ((size_t)e * 1024 + b * CAP + sl) * DM) + lane;
#pragma unroll
            for (int q = 0; q < 4; ++q) dst[64 * q] = rr[i][q]; } }
        __syncthreads();
    }
}
template <bool FINAL>
__device__ __forceinline__ void p12_combine_norm(Frame& F, int layer) {
    const int lane = opq(F.tid) & 63;
    const int gw = F.vcu * NWAVES + F.wave, NGW = F.G * NWAVES;
    float* X = WSP(float, WS_X1); bf16* H = WSP(bf16, WS_H); const float* aff = WSP(float, WS_AFF); const int* tok = WSP(int, WS_TOK); const bf16* Y = WSP(bf16, WS_Y);
    const float* modl = WSP(float, WS_MOD) + (size_t)layer * 3 * 6 * DM; const float* gfin = FINAL ? arg_in(7) : arg_in(6) + (size_t)((layer + 1) * 2) * DM;
    for (int row = gw; row < MX; row += NGW) {
        const int b = row >> 12, t = row & 4095; float* xr = X + (size_t)row * DM; const float* g5 = modl + (size_t)b * 6 * DM + 5 * DM;
        f32x4 v[8], acc[8];
#pragma unroll
        for (int j = 0; j < 8; ++j) { v[j] = *(const f32x4*)(xr + 4 * (64 * j + lane)); acc[j] = (f32x4){0.f, 0.f, 0.f, 0.f}; }
        int sv = -1; float av = 0.f;
        if (lane < 16) { sv = tok[((size_t)b * NE + lane) * SEQ + t]; av = aff[((size_t)b * NE + lane) * SEQ + t]; }
#pragma unroll
        for (int e = 0; e < 16; ++e) { const int s = __builtin_amdgcn_readlane(sv, e); const float a = __builtin_bit_cast(float, __builtin_amdgcn_readlane(__builtin_bit_cast(int, av), e));
            if (s >= 0) { const bf16* yr = Y + ((size_t)e * 1024 + b * CAP + s) * DM;
#pragma unroll
                for (int j = 0; j < 8; ++j) { const v2u w = *(const v2u*)(yr + 4 * (64 * j + lane)); acc[j] += a * (f32x4){bf_lo(w.x), bf_hi(w.x), bf_lo(w.y), bf_hi(w.y)}; } } }
        float s2 = 0.f;
#pragma unroll
        for (int j = 0; j < 8; ++j) { const f32x4 g4 = *(const f32x4*)(g5 + 4 * (64 * j + lane)); v[j] += g4 * acc[j]; s2 += (v[j][0] * v[j][0] + v[j][1] * v[j][1]) + (v[j][2] * v[j][2] + v[j][3] * v[j][3]); }
        const float rstd = 1.0f / sqrtf(wave_sum(s2) * (1.0f / DM) + EPS);
        if constexpr (FINAL) {
#pragma unroll
            for (int j = 0; j < 8; ++j) { const int c = 4 * (64 * j + lane); *(f32x4*)(F.out + (size_t)row * DM + c) = v[j] * rstd * *(const f32x4*)(gfin + c); }
        } else {
#pragma unroll
            for (int j = 0; j < 8; ++j) *(f32x4*)(xr + 4 * (64 * j + lane)) = v[j];
            const float* m1 = WSP(float, WS_MOD) + (size_t)(layer + 1) * 3 * 6 * DM + (size_t)b * 6 * DM;
            norm_store(v, rstd, gfin, m1, m1 + DM, H + (size_t)row * DM, lane);
        }
    }
}
__device__ __forceinline__ void p15_transpose(Frame& F) {
    const int lane = opq(F.tid) & 63;
    const int gw = F.vcu * NWAVES + F.wave, NGW = F.G * NWAVES;
    const bf16* ZT = WSP(bf16, WS_ZT); bf16* Z = WSP(bf16, WS_Z);
    LAS bf16* scr = (LAS bf16*)(F.lds + F.wave * 8704);
    for (int tl = gw; tl < (DM / 64) * (MX / 64); tl += NGW) {
        const int dt = tl & 31, tt = tl >> 5;
#pragma unroll
        for (int i = 0; i < 8; ++i) { const int d = 8 * i + (lane >> 3); const v4u w = *(const v4u*)(ZT + (size_t)(dt * 64 + d) * MX + tt * 64 + (lane & 7) * 8);
            LAS bf16* p = scr + d * 68 + (lane & 7) * 8; *(LAS v2u*)p = (v2u){w.x, w.y}; *(LAS v2u*)(p + 4) = (v2u){w.z, w.w}; }
        LDS_WAIT(); asm volatile("" ::: "memory");
#pragma unroll
        for (int i = 0; i < 8; ++i) { const int tk = 8 * i + (lane >> 3), d0 = (lane & 7) * 8; unsigned short h[8];
#pragma unroll
            for (int q = 0; q < 8; ++q) h[q] = scr[(d0 + q) * 68 + tk];
            v4u o; o.x = h[0] | ((unsigned)h[1] << 16); o.y = h[2] | ((unsigned)h[3] << 16); o.z = h[4] | ((unsigned)h[5] << 16); o.w = h[6] | ((unsigned)h[7] << 16);
            *(v4u*)(Z + (size_t)(tt * 64 + tk) * DM + dt * 64 + d0) = o; }
        LDS_WAIT(); asm volatile("" ::: "memory");
    }
}

namespace att {
constexpr int NW = 8, QBLK = 32, KVBLK = 64, KROW = 384  ;
constexpr float SCALE = 0.07216878364870322f;
constexpr float THR = 8.f;
#ifndef ATT_SDEPTH
#define ATT_SDEPTH 1
#endif
constexpr int SDEPTH = ATT_SDEPTH;
constexpr int SHM_V = KVBLK * 128 * 2, SHM_K = KVBLK * KROW, SHM_QR = 2 * SHM_V + 2 * SHM_K + NW * 64 * 4  , SHM_ATTN = SHM_QR + NW * 4096;
#define KSWZ(row, colB) ((row) * 384 + ((colB) ^ ((((row) ^ (((row) >> 3) & 3)) & 7) << 4)))
#define SBAR() __builtin_amdgcn_sched_barrier(0)
__device__ __forceinline__ int crow(int r, int hi) { return (r & 3) + 8 * (r >> 2) + 4 * hi; }
__device__ __forceinline__ void partialSM(f32x16& p0, f32x16& p1, float& m_reg, float& mn, float& alpha) {
  constexpr float C = SCALE * 1.4426950408889634f;
  float pmax = p0[0];
#pragma unroll
  for (int r = 1; r < 16; ++r) pmax = fmaxf(pmax, p0[r]);
#pragma unroll
  for (int r = 0; r < 16; ++r) pmax = fmaxf(pmax, p1[r]);
  { auto rr = __builtin_amdgcn_permlane32_swap(__float_as_uint(pmax), __float_as_uint(pmax), false, false);
    pmax = fmaxf(__uint_as_float(rr[0]), __uint_as_float(rr[1])); }
  if (__builtin_expect(__all(pmax - m_reg <= THR / SCALE), 1)) { mn = m_reg; alpha = 1.f; }
  else { mn = fmaxf(m_reg, pmax); alpha = __builtin_amdgcn_exp2f((m_reg - mn) * C); m_reg = mn; }
  const float mnC = -mn * C;
#pragma unroll
  for (int r = 0; r < 16; ++r) p0[r] = fmaf(p0[r], C, mnC);
#pragma unroll
  for (int r = 0; r < 16; ++r) p1[r] = fmaf(p1[r], C, mnC);
#pragma unroll
  for (int r = 0; r < 16; ++r) p0[r] = __builtin_amdgcn_exp2f(p0[r]);
}
__device__ __forceinline__ void finishSM(f32x16& p0, f32x16& p1, float alpha, float& l_reg, bf16x8& pa0, bf16x8& pa1, bf16x8& pa2, bf16x8& pa3) {
#pragma unroll
  for (int r = 0; r < 16; ++r) p1[r] = __builtin_amdgcn_exp2f(p1[r]);
  float ps = 0;
#pragma unroll
  for (int r = 0; r < 16; ++r) ps += p0[r];
#pragma unroll
  for (int r = 0; r < 16; ++r) ps += p1[r];
  { auto rr = __builtin_amdgcn_permlane32_swap(__float_as_uint(ps), __float_as_uint(ps), false, false);
    ps = __uint_as_float(rr[0]) + __uint_as_float(rr[1]); }
  l_reg = l_reg * alpha + ps;
#define PK4(P, BASE, OUT) do { unsigned a0 = pk2(P[BASE + 0], P[BASE + 1]), a1 = pk2(P[BASE + 2], P[BASE + 3]);   \
    unsigned b0 = pk2(P[BASE + 4], P[BASE + 5]), b1 = pk2(P[BASE + 6], P[BASE + 7]);                              \
    auto r0 = __builtin_amdgcn_permlane32_swap(a0, b0, false, false); auto r1 = __builtin_amdgcn_permlane32_swap(a1, b1, false, false); \
    v4u w = {r0[0], r1[0], r0[1], r1[1]}; OUT = *reinterpret_cast<bf16x8*>(&w); } while (0)
  PK4(p0, 0, pa0); PK4(p0, 8, pa1); PK4(p1, 0, pa2); PK4(p1, 8, pa3);
#undef PK4
}
__device__ __forceinline__ void qkt(f32x16& p0, f32x16& p1, const char* Ks, const bf16x8* qr, const char* qL, const int (&kb)[4]) {
  p0 = f32x16{}; p1 = f32x16{};
#pragma unroll
  for (int d0 = 0; d0 < 12; ++d0) {
    const bf16x8 qf = d0 < 8 ? qr[d0 < 8 ? d0 : 0] : *reinterpret_cast<const bf16x8*>(qL + (d0 - 8) * 1024);
    const bf16x8 b0 = *reinterpret_cast<const bf16x8*>(Ks + kb[d0 & 3] + (d0 >> 2) * 128);
    const bf16x8 b1 = *reinterpret_cast<const bf16x8*>(Ks + kb[d0 & 3] + (d0 >> 2) * 128 + 32 * 384);
    p0 = __builtin_amdgcn_mfma_f32_32x32x16_bf16(b0, qf, p0, 0, 0, 0);
    p1 = __builtin_amdgcn_mfma_f32_32x32x16_bf16(b1, qf, p1, 0, 0, 0); }
}
__device__ __forceinline__ int v_st(int k, int c) { const int kk = (k & ~0xC) | ((k & 4) << 1) | ((k & 8) >> 1); return ((kk >> 3) * 4 + (c >> 5)) * 512 + ((kk & 7) * 32 + (c & 31)) * 2; }
__device__ __forceinline__ int v_rd_base(int lane) { return ((lane & 3) << 3) | (((lane >> 2) & 3) << 6) | (((lane >> 4) & 1) << 5) | (((lane >> 5) & 1) << 8); }
constexpr int v_rd_off(int d0, int ks, int half) { return d0 * 512 + ks * 4096 + half * 2048; }
template <int OFF> __device__ __forceinline__ s16x4 tr_read(int vb) {
  s16x4 r; asm volatile("ds_read_b64_tr_b16 %0, %1 offset:%2" : "=&v"(r) : "v"(vb), "i"(OFF) : "memory"); return r;
}
template <int D0> __device__ __forceinline__ void pv_one(f32x16& od, int vb, bf16x8 pa0, bf16x8 pa1, bf16x8 pa2, bf16x8 pa3) {
  const s16x4 l0 = tr_read<v_rd_off(D0, 0, 0)>(vb), h0 = tr_read<v_rd_off(D0, 0, 1)>(vb), l1 = tr_read<v_rd_off(D0, 1, 0)>(vb), h1 = tr_read<v_rd_off(D0, 1, 1)>(vb);
  const s16x4 l2 = tr_read<v_rd_off(D0, 2, 0)>(vb), h2 = tr_read<v_rd_off(D0, 2, 1)>(vb), l3 = tr_read<v_rd_off(D0, 3, 0)>(vb), h3 = tr_read<v_rd_off(D0, 3, 1)>(vb);
  asm volatile("s_waitcnt lgkmcnt(0)" ::: "memory"); SBAR();
#define PKV(L, H) (bf16x8){L[0], L[1], L[2], L[3], H[0], H[1], H[2], H[3]}
  od = __builtin_amdgcn_mfma_f32_32x32x16_bf16(pa0, PKV(l0, h0), od, 0, 0, 0);
  od = __builtin_amdgcn_mfma_f32_32x32x16_bf16(pa1, PKV(l1, h1), od, 0, 0, 0);
  od = __builtin_amdgcn_mfma_f32_32x32x16_bf16(pa2, PKV(l2, h2), od, 0, 0, 0);
  od = __builtin_amdgcn_mfma_f32_32x32x16_bf16(pa3, PKV(l3, h3), od, 0, 0, 0);
#undef PKV
}
__device__ __forceinline__ void pv_d0(f32x16* o, int vb, bf16x8 pa0, bf16x8 pa1, bf16x8 pa2, bf16x8 pa3) {
  pv_one<0>(o[0], vb, pa0, pa1, pa2, pa3); pv_one<1>(o[1], vb, pa0, pa1, pa2, pa3); pv_one<2>(o[2], vb, pa0, pa1, pa2, pa3); pv_one<3>(o[3], vb, pa0, pa1, pa2, pa3);
}
__device__ __forceinline__ void attn_body(const bf16* __restrict__ Qb, const bf16* __restrict__ Kn, const bf16* __restrict__ Kr, const bf16* __restrict__ Vh, bf16* __restrict__ Ob, int seq, char* lds) {
  constexpr int LDQ = 3072, LDK = 4096, LDR = 64, LDO = 2048;
  const int tid = threadIdx.x, wid = tid >> 6, lane = tid & 63, r32 = lane & 31, hi = lane >> 5;
  char* V_lds = lds; char* K_lds = lds + 2 * SHM_V;
  float* ws = (float*)(lds + 2 * SHM_V + 2 * SHM_K) + wid * 64; float* li_l = ws; float* al_l = ws + 32;
  float m_reg = -1e30f, l_reg = 0; f32x16 o[4] = {}; bf16x8 qr[8];
  char* qL = lds + SHM_QR + wid * 4096 + lane * 16;
  const bf16* Qw = Qb + (unsigned)((wid * QBLK + r32) * LDQ + hi * 8);
#pragma unroll
  for (int d0 = 0; d0 < 8; ++d0) qr[d0] = *reinterpret_cast<const bf16x8*>(Qw + d0 * 16);
#pragma unroll
  for (int d0 = 8; d0 < 12; ++d0) *reinterpret_cast<bf16x8*>(qL + (d0 - 8) * 1024) = *reinterpret_cast<const bf16x8*>(Qw + d0 * 16);
  const int sr = tid >> 4, sc = (tid & 15) * 8, vst0 = v_st(sr, sc), vst1 = v_st(32 + sr, sc);
  const int rr = tid >> 3, rc = (tid & 7) * 8;
  const unsigned o_s0 = (unsigned)(sr * LDK + sc), o_s1 = (unsigned)((32 + sr) * LDK + sc), o_r = (unsigned)(rr * LDR + rc);
  int kb[4];
#pragma unroll
  for (int q = 0; q < 4; ++q) kb[q] = KSWZ(r32, q * 32 + hi * 16);
  const int vb0 = (int)(uintptr_t)V_lds + v_rd_base(lane);
  struct { bf16x8 vs0, vs1, ks0, ks1, kr0; } sr_[SDEPTH];
#define SLOAD(i, k0) do { const bf16* Vt = Vh + (size_t)(k0) * LDK; const bf16* Kt = Kn + (size_t)(k0) * LDK; const bf16* Rt = Kr + (size_t)(k0) * LDR; \
    sr_[i].vs0 = *(const bf16x8*)(Vt + o_s0); sr_[i].vs1 = *(const bf16x8*)(Vt + o_s1); sr_[i].ks0 = *(const bf16x8*)(Kt + o_s0); sr_[i].ks1 = *(const bf16x8*)(Kt + o_s1); \
    sr_[i].kr0 = *(const bf16x8*)(Rt + o_r); } while (0)
#define SWRITE(b, i) do { *(bf16x8*)(V_lds + (b) * SHM_V + vst0) = sr_[i].vs0; *(bf16x8*)(V_lds + (b) * SHM_V + vst1) = sr_[i].vs1; const int kc = sc * 2;               \
    *(bf16x8*)(K_lds + (b) * SHM_K + KSWZ(sr, kc)) = sr_[i].ks0; *(bf16x8*)(K_lds + (b) * SHM_K + KSWZ(32 + sr, kc)) = sr_[i].ks1;                       \
    *(bf16x8*)(K_lds + (b) * SHM_K + KSWZ(rr, 256 + rc * 2)) = sr_[i].kr0; } while (0)
#define SWAIT() do { if constexpr (SDEPTH == 2) asm volatile("s_waitcnt vmcnt(5)" ::: "memory"); else asm volatile("s_waitcnt vmcnt(0)" ::: "memory"); } while (0)
#define RESC(a) do { if (__any((a) < 1.f)) { if (hi == 0) al_l[r32] = (a); asm volatile("s_waitcnt lgkmcnt(0)" ::: "memory"); \
    _Pragma("unroll") for (int d = 0; d < 4; ++d) _Pragma("unroll") for (int r = 0; r < 16; ++r) o[d][r] *= al_l[crow(r, hi)]; } } while (0)
  f32x16 pA0, pA1, pB0, pB1; float mnA, mnB, alA, alB; bf16x8 pa0, pa1, pa2, pa3; const int NT = seq / KVBLK;
  constexpr int SE = 0, SO = SDEPTH - 1;
  SLOAD(SE, 0); asm volatile("s_waitcnt vmcnt(0)" ::: "memory"); SWRITE(0, SE); __syncthreads();
  qkt(pA0, pA1, K_lds, qr, qL, kb); partialSM(pA0, pA1, m_reg, mnA, alA);
  SLOAD(SO, KVBLK); if constexpr (SDEPTH == 2) { if (2 < NT) SLOAD(SE, 2 * KVBLK); }
  SWAIT(); SWRITE(1, SO); __syncthreads();
  for (int j = 1; j + 1 < NT; j += 2) {
    SBAR(); qkt(pB0, pB1, K_lds + SHM_K, qr, qL, kb);
    finishSM(pA0, pA1, alA, l_reg, pa0, pa1, pa2, pa3); SBAR();
    SLOAD(SO, (j + SDEPTH) * KVBLK); SBAR();
    pv_d0(o, vb0, pa0, pa1, pa2, pa3); partialSM(pB0, pB1, m_reg, mnB, alB);
    __syncthreads(); SWAIT(); SWRITE(0, SE);
    RESC(alB); __syncthreads();
    SBAR(); qkt(pA0, pA1, K_lds, qr, qL, kb);
    finishSM(pB0, pB1, alB, l_reg, pa0, pa1, pa2, pa3); SBAR();
    if (SDEPTH == 1 || j + 3 < NT) SLOAD(SE, (j + 1 + SDEPTH) * KVBLK); SBAR();
    pv_d0(o, vb0 + SHM_V, pa0, pa1, pa2, pa3); partialSM(pA0, pA1, m_reg, mnA, alA);
    __syncthreads(); SWAIT(); SWRITE(1, SO);
    RESC(alA); __syncthreads();
  }
  SBAR(); qkt(pB0, pB1, K_lds + SHM_K, qr, qL, kb);
  finishSM(pA0, pA1, alA, l_reg, pa0, pa1, pa2, pa3); SBAR();
  pv_d0(o, vb0, pa0, pa1, pa2, pa3); partialSM(pB0, pB1, m_reg, mnB, alB);
  __syncthreads(); RESC(alB);
  finishSM(pB0, pB1, alB, l_reg, pa0, pa1, pa2, pa3); SBAR();
  pv_d0(o, vb0 + SHM_V, pa0, pa1, pa2, pa3);
  if (hi == 0) li_l[r32] = l_reg; asm volatile("s_waitcnt lgkmcnt(0)" ::: "memory");
  float rli[16];
#pragma unroll
  for (int r = 0; r < 16; ++r) rli[r] = __builtin_amdgcn_rcpf(li_l[crow(r, hi)]);
  bf16* Ow = Ob + (size_t)(wid * QBLK) * LDO;
#pragma unroll
  for (int r = 0; r < 16; ++r) { const int orow = crow(r, hi);
#pragma unroll
    for (int d0 = 0; d0 < 4; ++d0) Ow[(unsigned)(orow * LDO + d0 * 32 + r32)] = (bf16)(pk2(o[d0][r] * rli[r], 0.f) & 0xffffu); }
#undef SLOAD
#undef SWRITE
#undef SWAIT
#undef RESC
}
}
__device__ __forceinline__ void p6_attention(Frame& F) {
    const bf16* Q = WSP(bf16, WS_Q); const bf16* KV = WSP(bf16, WS_KV); const bf16* KR = WSP(bf16, WS_KROPE); bf16* O = WSP(bf16, WS_O);
    const int cslot = (int)((blockIdx.x >> 3) % 3u);
    if (cslot == 0) convert_late(F);
    const int nun = NB * NH * (SEQ / 256);
    for (int i = 0; ; ++i) {
        int bh, qb;
        if (F.G == 256) { if (i >= 2) break; const int x = blockIdx.x & 7, j = blockIdx.x >> 3; bh = (i * 8 + x) * 2 + (j >> 4); qb = j & 15; }
        else { const int L = i * F.G + (int)blockIdx.x; if (L >= nun) break; bh = L >> 4; qb = L & 15; }
        const int b = bh >> 4, h = bh & 15;
        if (i == 1 && cslot == 1) convert_late(F);
        __syncthreads();
        att::attn_body(Q + ((size_t)b * LT + qb * 256) * QW + h * 192, KV + (size_t)b * LT * KVW + h * 256, KR + (size_t)b * LT * 64, KV + (size_t)b * LT * KVW + h * 256 + 128,
                       O + ((size_t)b * SEQ + qb * 256) * DM + h * 128, LT, (char*)F.ldsg);
    }
    __syncthreads();
    if (cslot == 2) convert_late(F);
}

namespace hy {
typedef float cpx __attribute__((ext_vector_type(2)));
__device__ __forceinline__ cpx cmul(cpx a, cpx b) { return (cpx){a.x * b.x - a.y * b.y, a.x * b.y + a.y * b.x}; }
__device__ __forceinline__ cpx cmulc(cpx a, cpx b) { return (cpx){a.x * b.x + a.y * b.y, a.y * b.x - a.x * b.y}; }
__device__ __forceinline__ float f_mul(float a, float b) { float r; asm("v_mul_f32 %0, %1, %2" : "=v"(r) : "v"(a), "v"(b)); return r; }
__device__ __forceinline__ float f_fma(float a, float b, float c) { float r; asm("v_fma_f32 %0, %1, %2, %3" : "=v"(r) : "v"(a), "v"(b), "v"(c)); return r; }
__device__ __forceinline__ float f_fms(float a, float b, float c) { float r; asm("v_fma_f32 %0, %1, %2, -%3" : "=v"(r) : "v"(a), "v"(b), "v"(c)); return r; }
__device__ __forceinline__ cpx cmul_s(cpx a, cpx b) { const float t = f_mul(a.y, b.y), u = f_mul(a.y, b.x); return (cpx){f_fms(a.x, b.x, t), f_fma(a.x, b.y, u)}; }
__device__ __forceinline__ cpx cmulc_s(cpx a, cpx b) { const float t = f_mul(a.y, b.y), u = f_mul(a.x, b.y); return (cpx){f_fma(a.x, b.x, t), f_fms(a.y, b.x, u)}; }
__device__ __forceinline__ cpx cadd(cpx a, cpx b) { return a + b; }
__device__ __forceinline__ cpx csub(cpx a, cpx b) { return a - b; }
template <int S> __device__ __forceinline__ cpx mul_i(cpx a) { return S < 0 ? (cpx){a.y, -a.x} : (cpx){-a.y, a.x}; }
template <int S> __device__ __forceinline__ void dft4(cpx& x0, cpx& x1, cpx& x2, cpx& x3) {
    const cpx t0 = cadd(x0, x2), t1 = csub(x0, x2), t2 = cadd(x1, x3), t3 = mul_i<S>(csub(x1, x3));
    x0 = cadd(t0, t2); x2 = csub(t0, t2); x1 = cadd(t1, t3); x3 = csub(t1, t3);
}
template <int S> __device__ __forceinline__ cpx tw16(cpx a, int m) {
    constexpr float C1 = 0.9238795325112867f, S1 = 0.3826834323650898f, R = 0.7071067811865476f;
    cpx w;
    switch (m) { case 0: return a; case 1: w = (cpx){C1, -S1}; break; case 2: w = (cpx){R, -R}; break; case 3: w = (cpx){S1, -C1}; break; case 4: w = (cpx){0.f, -1.f}; break; case 6: w = (cpx){-R, -R}; break; default: w = (cpx){-C1, S1}; break; }
    if (S > 0) w.y = -w.y;
    return cmul(a, w);
}
template <int S> __device__ __forceinline__ void dft16(cpx (&v)[16]) {
#pragma unroll
    for (int a = 0; a < 4; ++a) { dft4<S>(v[a], v[a + 4], v[a + 8], v[a + 12]);
#pragma unroll
        for (int d = 1; d < 4; ++d) v[a + 4 * d] = tw16<S>(v[a + 4 * d], a * d); }
#pragma unroll
    for (int d = 0; d < 4; ++d) dft4<S>(v[4 * d], v[4 * d + 1], v[4 * d + 2], v[4 * d + 3]);
}
__device__ __forceinline__ constexpr int SL(int k) { return 4 * (k & 3) + (k >> 2); }
template <int S> __device__ __forceinline__ void dft16p(cpx (&v)[16]) {
#pragma unroll
    for (int a = 0; a < 4; ++a) { dft4<S>(v[4 * a], v[4 * a + 1], v[4 * a + 2], v[4 * a + 3]);
#pragma unroll
        for (int d = 1; d < 4; ++d) v[4 * a + d] = tw16<S>(v[4 * a + d], a * d); }
#pragma unroll
    for (int d = 0; d < 4; ++d) dft4<S>(v[d], v[4 + d], v[8 + d], v[12 + d]);
}
__device__ __forceinline__ int PI(int i) { return i + (i >> 4); }
typedef LAS cpx* lbuf;
typedef const LAS cpx* ltab;
__device__ __forceinline__ cpx tw_lookup(ltab T, int m) { return cmul(T[64 + (m >> 6)], T[m & 63]); }
__device__ __forceinline__ void tw_powers(cpx b, cpx (&p)[16]) {
    p[0] = (cpx){1.f, 0.f}; p[1] = b; p[2] = cmul(b, b); p[3] = cmul(p[2], b); p[4] = cmul(p[2], p[2]); p[5] = cmul(p[4], b); p[6] = cmul(p[4], p[2]); p[7] = cmul(p[4], p[3]); p[8] = cmul(p[4], p[4]);
    p[9] = cmul(p[8], b); p[10] = cmul(p[8], p[2]); p[11] = cmul(p[8], p[3]); p[12] = cmul(p[8], p[4]); p[13] = cmul(p[8], p[5]); p[14] = cmul(p[8], p[6]); p[15] = cmul(p[8], p[7]);
}
struct Addr { int a1, a2, a3; };
__device__ __forceinline__ void fwd12(lbuf buf, Addr A, const cpx (&pw1)[16], cpx b2) {
    cpx v[16], pw2[16];
    { lbuf b = buf + A.a1;
#pragma unroll
      for (int n = 0; n < 16; ++n) v[n] = b[n * 272];
      dft16<-1>(v);
#pragma unroll
      for (int k = 0; k < 16; ++k) b[k * 272] = k ? cmul_s(v[SL(k)], pw1[k]) : v[SL(k)]; }
    __syncthreads();
    { lbuf b = buf + A.a2;
#pragma unroll
      for (int n = 0; n < 16; ++n) v[n] = b[n * 17];
      tw_powers(b2, pw2);
      dft16<-1>(v);
#pragma unroll
      for (int k = 0; k < 16; ++k) b[k * 17] = k ? cmul(v[SL(k)], pw2[k]) : v[SL(k)]; }
    __syncthreads();
}
__device__ __forceinline__ void inv21(lbuf buf, Addr A, const cpx (&pw1)[16], cpx b2) {
    cpx v[16], pw2[16];
    { lbuf b = buf + A.a2; tw_powers(b2, pw2);
#pragma unroll
      for (int k = 0; k < 16; ++k) { const cpx x = b[k * 17]; v[k] = k ? cmulc(x, pw2[k]) : x; }
      dft16<1>(v);
#pragma unroll
      for (int n = 0; n < 16; ++n) b[n * 17] = v[SL(n)]; }
    __syncthreads();
    { lbuf b = buf + A.a1;
#pragma unroll
      for (int k = 0; k < 16; ++k) { const cpx x = b[k * 272]; v[k] = k ? cmulc_s(x, pw1[k]) : x; }
      dft16<1>(v);
#pragma unroll
      for (int n = 0; n < 16; ++n) b[n * 272] = v[SL(n)]; }
    __syncthreads();
}
}

__device__ __forceinline__ void p14_hyena_conv(Frame& F) {
    const int lane = opq(F.tid) & 63;
    using namespace hy;
    lbuf bufX = (lbuf)F.lds; lbuf bufW = (lbuf)(F.lds + 69632);
    LAS float* red = (LAS float*)(F.lds + 139264);
    LAS cpx* tab = (LAS cpx*)(F.lds + 139264 + 64);
    const float* HF = WSP(float, WS_HF);
    const bf16* U = WSP(bf16, WS_U); bf16* ZT = WSP(bf16, WS_ZT);
    const float* b3 = arg_in(22); const float* cw = arg_in(15); const float* cb = arg_in(16); const float* skip = arg_in(24);
    __syncthreads();
    if (F.tid < 256) { const f32x2* twg = WSP(f32x2, WS_TW); const int q = F.tid >> 6, i = F.tid & 63; tab[F.tid] = twg[(q >> 1) * 4096 + ((q & 1) ? 64 * i : i)]; }
    __syncthreads();
    const int t0_ = F.tid, e = t0_ >> 8, j = t0_ & 255;
    cpx pw1[16];
    tw_powers(tw_lookup(tab, j), pw1); const cpx b2 = tw_lookup(tab, 16 * (j & 15));
    Addr A; A.a1 = j + (j >> 4); A.a2 = (j >> 4) * 272 + (j & 15); A.a3 = j * 17;
    const int k1 = j >> 4, k2 = j & 15; const bool special = (e == 0 && j == 0);
    const int ap = e ? (15 - k1) * 272 + (15 - k2) * 17 : (k1 ? (16 - k1) * 272 + (15 - k2) * 17 : (k2 ? (16 - k2) * 17 : 1));
    lbuf bx = bufX + e * 4352; lbuf bw = bufW + e * 4352;
#define HY_ISSUE(T, raw) do { const int ch = (T) * DM + d; \
        _Pragma("unroll") for (int b = 0; b < 2; ++b) { const bf16* pr = U + (size_t)ch * MX + b * SEQ + n0; raw.m[b] = *(const v4u*)pr; raw.l[b] = t > 0 ? pr[-1] : (bf16)0; raw.r[b] = t < 511 ? pr[8] : (bf16)0; } } while (0)
#define HY_CONV(T, raw, dst) do { const int ch = (T) * DM + d; const float w0 = cw[ch], w1 = cw[3 * DM + ch], w2 = cw[6 * DM + ch], bs = cb[ch]; \
        _Pragma("unroll") for (int b = 0; b < 2; ++b) { const v4u m = raw.m[b]; \
            const float p[10] = {bf1(raw.l[b]), bf_lo(m.x), bf_hi(m.x), bf_lo(m.y), bf_hi(m.y), bf_lo(m.z), bf_hi(m.z), bf_lo(m.w), bf_hi(m.w), bf1(raw.r[b])}; \
            _Pragma("unroll") for (int i = 0; i < 8; ++i) { const float uu = w0 * p[i] + w1 * p[i + 1] + w2 * p[i + 2] + bs; if (b == 0) dst[i].x = uu; else dst[i].y = uu; } } } while (0)
    struct Raw { v4u m[2]; bf16 l[2], r[2]; };
#define HY_TW8() cpx tw8[8]; { const cpx th = tab[192 + (t >> 3)]; _Pragma("unroll") for (int i = 0; i < 8; ++i) tw8[i] = cmul(th, tab[128 + 8 * (t & 7) + i]); }
#pragma unroll 1
    for (int d = F.vcu; d < DM; d += F.G) {
        const float sk0 = skip[d], sk1 = skip[DM + d];
        float rs0 = 0.f, rs1 = 0.f; cpx vv[8];
#pragma unroll 1
        for (int c = 0; c < 3; ++c) {
            int t = F.tid; asm volatile("" : "+v"(t));
            const int n0 = 8 * t, p0 = n0 + (t >> 1);
            lbuf bb = c ? bx : bw;
            if (c == 0) {
                __syncthreads();
                const float* h00 = HF + (size_t)d * SEQ + n0; const float* h10 = h00 + (size_t)2048 * SEQ; const float* h01 = h00 + (size_t)4096 * SEQ; const float* h11 = h01 + (size_t)2048 * SEQ;
                const f32x4 a00 = *(const f32x4*)h00, b00 = *(const f32x4*)(h00 + 4), a10 = *(const f32x4*)h10, b10 = *(const f32x4*)(h10 + 4);
                const f32x4 a01 = *(const f32x4*)h01, b01 = *(const f32x4*)(h01 + 4), a11 = *(const f32x4*)h11, b11 = *(const f32x4*)(h11 + 4);
                const float bb00 = b3[d], bb01 = b3[2048 + d], bb10 = b3[4096 + d], bb11 = b3[6144 + d];
                const float adel = 3.0701134573253944f + (float)d * ((15.350567286626972f - 3.0701134573253944f) / 2047.0f);
                float ss0 = 0.f, ss1 = 0.f; HY_TW8();
#pragma unroll
                for (int i = 0; i < 8; ++i) { const int n = n0 + i; const float df = __expf(-((float)n * (1.0f / 4096.0f)) * adel), db = __expf(-((float)(4096 - n) * (1.0f / 4096.0f)) * adel);
                    const float f00 = (i < 4 ? a00[i & 3] : b00[i & 3]) + bb00, f10 = (i < 4 ? a10[i & 3] : b10[i & 3]) + bb10, f01 = (i < 4 ? a01[i & 3] : b01[i & 3]) + bb01, f11 = (i < 4 ? a11[i & 3] : b11[i & 3]) + bb11;
                    const float a0 = f00 * df, a1 = f10 * df;
                    const float c0 = n ? f01 * db : 0.f, c1 = n ? f11 * db : 0.f;
                    ss0 += a0 * a0 + c0 * c0; ss1 += a1 * a1 + c1 * c1;
                    bufW[p0 + i] = (cpx){a0 + c0, a1 + c1};
                    bufW[4352 + p0 + i] = cmul((cpx){a0 - c0, a1 - c1}, tw8[i]); }
                ss0 = wave_sum(ss0); ss1 = wave_sum(ss1);
                if (lane == 0) { red[F.wave * 2] = ss0; red[F.wave * 2 + 1] = ss1; }
            } else if (c == 1) {
                Raw rv; HY_ISSUE(0, rv); HY_CONV(0, rv, vv); HY_TW8();
#pragma unroll
                for (int i = 0; i < 8; ++i) { bufX[p0 + i] = vv[i]; bufX[4352 + p0 + i] = cmul(vv[i], tw8[i]); }
            }
            __syncthreads();
            if (c == 0) {
#pragma unroll
                for (int w = 0; w < 8; ++w) { rs0 += red[w * 2]; rs1 += red[w * 2 + 1]; }
                rs0 = (1.0f / sqrtf(rs0 + EPS)) * (1.0f / 8192.0f); rs1 = (1.0f / sqrtf(rs1 + EPS)) * (1.0f / 8192.0f);
            }
            fwd12(bb, A, pw1, b2);
            cpx v[16];
            { lbuf q = bb + A.a3;
#pragma unroll
              for (int n = 0; n < 16; ++n) v[n] = q[n]; }
            dft16<-1>(v);
            if (c == 0) {
                lbuf q = bb + A.a3;
#pragma unroll
                for (int k = 0; k < 16; ++k) q[k] = v[SL(k)];
            } else {
                const float hs = 0.5f * (c == 1 ? rs0 : rs1); const bool o1 = c == 2;
                { lbuf bo = bw + A.a3; lbuf bp = bw + ap;
#pragma unroll
                  for (int k3 = 0; k3 < 16; ++k3) {
                    const cpx wf = bo[k3]; const cpx wp = (k3 == 0) ? bw[special ? ap - 1 : ap + 15] : bp[15 - k3];
                    const cpx K = o1 ? (cpx){(wf.y + wp.y) * hs, -(wf.x - wp.x) * hs} : (cpx){(wf.x + wp.x) * hs, (wf.y - wp.y) * hs};
                    v[SL(k3)] = cmul(v[SL(k3)], K); } }
                dft16p<1>(v);
                { lbuf q = bb + A.a3;
#pragma unroll
                  for (int n = 0; n < 16; ++n) q[n] = v[n]; }
                __syncthreads();
                inv21(bb, A, pw1, b2);
                if (c == 1) {
                    Raw r1; HY_ISSUE(1, r1); cpx x1c[8]; HY_CONV(1, r1, x1c); HY_TW8();
#pragma unroll
                    for (int i = 0; i < 8; ++i) { const cpx ye = bufX[p0 + i], yo = bufX[4352 + p0 + i]; const cpx y = cadd(ye, cmulc(yo, tw8[i]));
                        vv[i] = (cpx){x1c[i].x * (y.x + sk0 * vv[i].x), x1c[i].y * (y.y + sk0 * vv[i].y)};
                        bufX[p0 + i] = vv[i]; bufX[4352 + p0 + i] = cmul(vv[i], tw8[i]); }
                } else {
                    Raw r2; HY_ISSUE(2, r2); cpx x2c[8]; HY_CONV(2, r2, x2c); HY_TW8();
                    unsigned ob0[4], ob1[4];
#pragma unroll
                    for (int i = 0; i < 8; i += 2) { float z0[2], z1[2];
#pragma unroll
                        for (int q = 0; q < 2; ++q) { const cpx ye = bufX[p0 + i + q], yo = bufX[4352 + p0 + i + q]; const cpx y = cadd(ye, cmulc(yo, tw8[i + q]));
                            z0[q] = x2c[i + q].x * (y.x + sk1 * vv[i + q].x); z1[q] = x2c[i + q].y * (y.y + sk1 * vv[i + q].y); }
                        ob0[i >> 1] = pk2(z0[0], z0[1]); ob1[i >> 1] = pk2(z1[0], z1[1]); }
                    *(v4u*)(ZT + (size_t)d * MX + n0) = (v4u){ob0[0], ob0[1], ob0[2], ob0[3]};
                    *(v4u*)(ZT + (size_t)d * MX + SEQ + n0) = (v4u){ob1[0], ob1[1], ob1[2], ob1[3]};
                }
            }
        }
    }
    __syncthreads();
#undef HY_ISSUE
#undef HY_CONV
#undef HY_TW8
}

#ifndef MK_SINGLE
#define MK_SINGLE 1
#endif
struct Args { const float* in[30]; float* out; unsigned char* ws; int ph_lo, ph_hi; };
__global__ void __launch_bounds__(NWAVES * 64, 2) mk_fwd(Args args) {
    extern __shared__ __attribute__((aligned(16))) unsigned char lds[];
    Frame F;
    F.lds = (LAS unsigned char*)lds; F.ldsg = lds;
    F.tid = threadIdx.x; F.wave = __builtin_amdgcn_readfirstlane(F.tid >> 6);
    F.G = gridDim.x; { const int bx = blockIdx.x; F.vcu = (F.G % 8 == 0) ? (bx % 8) * (F.G / 8) + bx / 8 : bx; }
    F.out = args.out; F.ws = args.ws;
    volatile LAS unsigned* MISC = (volatile LAS unsigned*)(F.lds + MISC_OFF);
    if (F.tid < 32) MISC[F.tid] = 0u;
    __syncthreads();
    unsigned* ctl = (unsigned*)(F.ws + WS_CTL);
    XcdBarrier bar; bar.bar = ctl + CW_BAR; bar.x = 0; bar.st = nullptr;
    if (MK_SINGLE) bar = xcd_barrier_post(ctl + CW_BAR, MISC + 8);
    const int lo = args.ph_lo, hi = args.ph_hi;
#ifndef PH_MASK
#define PH_MASK 0x1fffff
#endif
#ifndef PROBE_DUP
#define PROBE_DUP 0
#endif
#define IN(k) (((PH_MASK >> (k)) & 1) && lo <= (k) && (k) < hi)
#define REP(k) for (int rep_ = 0; rep_ < (((PROBE_DUP >> (k)) & 1) ? 2 : 1); ++rep_)
#ifndef PROBE_XBAR
#define PROBE_XBAR 0
#endif
#define SEAM(k) do { if (MK_SINGLE && IN(k) && IN((k) + 1)) { xcd_barrier(bar); if (PROBE_XBAR) xcd_barrier(bar); } } while (0)
    using namespace pg8;
    const bf16_t* Hb = WSP(bf16_t, WS_H);
    float* mod = WSP(float, WS_MOD);

    if (IN(0)) REP(0) { p0_prologue(F); } SEAM(0);
    if (IN(1)) REP(1) { p1_norm0(F); } SEAM(1);
    if (IN(2)) REP(2) {
        Gemm g{Hb, WSP(bf16_t, WS_WIN), MT, INPAD, DM}; StaticOrder S; S.init(MT, INPAD, F.G, (int)blockIdx.x);
        EpiF32Plain E{WSP(float, WS_PROJ), INPAD, 0x7fffffff};
        gemm_phase<EpiF32Plain, StaticOrder, true, true>(F.lds, g, S, E);
        {
            __syncthreads();
            Gemm g2{WSP(bf16_t, WS_W3S), WSP(bf16_t, WS_A2S), 8192, 4096, 256}; HfOrder S2{F.G, (int)blockIdx.x, 136};
            EpiF32Plain E2{WSP(float, WS_HF), 4096, 15};
            gemm_phase<EpiF32Plain, HfOrder, true, true>(F.lds, g2, S2, E2);
        }
    } SEAM(2);
    if (IN(3)) REP(3) { p3_latent(F); } SEAM(3);
    if (IN(4)) REP(4) {
        { Gemm g{WSP(bf16_t, WS_CQN), WSP(bf16_t, WS_WUQ), MT, QW, QRANK}; StaticOrder S; S.init(MT, QW, F.G, (int)blockIdx.x);
          EpiQRope E{WSP(bf16_t, WS_Q), WSP(float, WS_CS)};
          gemm_phase<EpiQRope, StaticOrder, true, true>(F.lds, g, S, E); }
        __syncthreads();
        { Gemm g{WSP(bf16_t, WS_CKVN), WSP(bf16_t, WS_WUKV), MT, KVW, KVRANK}; StaticOrder S; S.init(MT, KVW, F.G, (int)(F.G - 1 - blockIdx.x));
          EpiBf16Plain E{WSP(bf16_t, WS_KV), KVW, 0x7fffffff};
          gemm_phase<EpiBf16Plain, StaticOrder, true, true>(F.lds, g, S, E); }
    } SEAM(4);
    if (IN(5)) REP(5) { p6_attention(F); } SEAM(5);
    if (IN(6)) REP(6) {
        Gemm g{WSP(bf16_t, WS_O), WSP(bf16_t, WS_WO), MX, DM, DM}; StaticOrder S; S.init(MX, DM, F.G, (int)blockIdx.x);
        EpiResid E{arg_in(0), WSP(float, WS_X1), mod + 2 * DM, 6 * DM};
        gemm_phase<EpiResid, StaticOrder, true, true>(F.lds, g, S, E);
    } SEAM(6);
#define MOE_PHASES(layer, pb) \
    if (IN(pb)) REP(pb) { p8_norm_router(F, layer); } SEAM(pb); \
    if (IN((pb) + 1)) REP((pb) + 1) { p9_select_gather(F); } SEAM((pb) + 1); \
    if (IN((pb) + 2)) REP((pb) + 2) {     \
        Gemm g{WSP(bf16_t, WS_XG), WSP(bf16_t, WS_WGU) + (size_t)(layer) * NE * 2048 * DM, MROWS, 2048, DM}; MoeOrder S{F.G, (int)blockIdx.x}; \
        EpiSwiGLU E{WSP(bf16_t, WS_ACT)}; \
        gemm_phase<EpiSwiGLU, MoeOrder, true, true>(F.lds, g, S, E); \
    } SEAM((pb) + 2); \
    if (IN((pb) + 3)) REP((pb) + 3) {     \
        Gemm g{WSP(bf16_t, WS_ACT), WSP(bf16_t, WS_WD) + (size_t)(layer) * NE * 2048 * FFD, MROWS, 2048, FFD}; MoeOrder S{F.G, (int)blockIdx.x}; \
        EpiBf16Plain E{WSP(bf16_t, WS_Y), DM, 7}; \
        gemm_phase<EpiBf16Plain, MoeOrder, true, true>(F.lds, g, S, E); \
    } SEAM((pb) + 3);
    MOE_PHASES(0, 7)
    if (IN(11)) REP(11) { p12_combine_norm<false>(F, 0); } SEAM(11);
    if (IN(12)) REP(12) {
        Gemm g{WSP(bf16_t, WS_HYWIN), Hb, 3 * DM, MX, DM}; StaticOrder S; S.init(3 * DM, MX, F.G, (int)blockIdx.x);
        EpiBf16Plain E{WSP(bf16_t, WS_U), MX, 0x7fffffff};
        gemm_phase<EpiBf16Plain, StaticOrder, true, true>(F.lds, g, S, E);
    } SEAM(12);
    if (IN(13)) REP(13) { p14_hyena_conv(F); } SEAM(13);
    if (IN(14)) REP(14) { p15_transpose(F); } SEAM(14);
    if (IN(15)) REP(15) {
        Gemm g{WSP(bf16_t, WS_Z), WSP(bf16_t, WS_HYWOUT), MX, DM, DM}; StaticOrder S; S.init(MX, DM, F.G, (int)blockIdx.x);
        EpiResid E{WSP(float, WS_X1), WSP(float, WS_X1), mod + 3 * 6 * DM + 2 * DM, 6 * DM};
        gemm_phase<EpiResid, StaticOrder, true, true>(F.lds, g, S, E);
    } SEAM(15);
    MOE_PHASES(1, 16)
    if (IN(20)) REP(20) { p12_combine_norm<true>(F, 1); }
#undef MOE_PHASES
#undef IN
#undef SEAM
}

extern "C" void kernel_launch(void* const* d_in, const int* in_sizes, int n_in, void* d_out, int out_size, void* d_ws, size_t ws_size, hipStream_t stream) {
    static int grid = 0;
    if (grid == 0) {
        if (n_in != 30 || out_size != MX * DM || ws_size < WS_END) { fprintf(stderr, "kernel_launch: shape/workspace mismatch: n_in %d out %d ws %zu (need %zu)\n", n_in, out_size, ws_size, (size_t)WS_END); grid = -1; return; }
        int dev = 0, cus = 0, per_cu = 0;
        if (hipGetDevice(&dev) != hipSuccess || hipDeviceGetAttribute(&cus, hipDeviceAttributeMultiprocessorCount, dev) != hipSuccess) { grid = -1; return; }
        if (hipFuncSetAttribute((const void*)mk_fwd, hipFuncAttributeMaxDynamicSharedMemorySize, LDS_BYTES) != hipSuccess) { fprintf(stderr, "kernel_launch: hipFuncSetAttribute failed\n"); grid = -1; return; }
        if (hipOccupancyMaxActiveBlocksPerMultiprocessor(&per_cu, (const void*)mk_fwd, NWAVES * 64, LDS_BYTES) != hipSuccess || per_cu < 1) { fprintf(stderr, "kernel_launch: occupancy query says %d blocks per CU\n", per_cu); }
        (void)hipGetLastError();
        grid = cus;
    }
    if (grid < 0) return;
    if (hipMemsetAsync((char*)d_ws + WS_CTL, 0, CTL_ZERO_BYTES, stream) != hipSuccess) return;
    Args a{};
    for (int i = 0; i < 30; ++i) a.in[i] = (const float*)d_in[i];
    a.out = (float*)d_out; a.ws = (unsigned char*)d_ws;
#if MK_SINGLE
    a.ph_lo = 0; a.ph_hi = NPHASE;
    hipLaunchKernelGGL(mk_fwd, dim3(grid), dim3(NWAVES * 64), LDS_BYTES, stream, a);
#else
    for (int p = 0; p < NPHASE; ++p) { a.ph_lo = p; a.ph_hi = p + 1; hipLaunchKernelGGL(mk_fwd, dim3(grid), dim3(NWAVES * 64), LDS_BYTES, stream, a); }
#endif
    const hipError_t le = hipPeekAtLastError();
    if (le != hipSuccess) fprintf(stderr, "kernel_launch: launch failed: %s\n", hipGetErrorName(le));
}
```

```cpp
#include <hip/hip_runtime.h>
#include <cstdio>
#include <cstdint>
namespace pg8 {
#define PG8_LAS __attribute__((address_space(3)))
typedef unsigned short bf16_t;
typedef short bf16x8 __attribute__((ext_vector_type(8)));
typedef float f32x4 __attribute__((ext_vector_type(4)));
typedef unsigned u32x4 __attribute__((ext_vector_type(4)));
constexpr int BM = 256, BK = 64, HALF = 128, HTB = HALF * BK * 2  , STAGE_BYTES = 8 * HTB, NXCD = 8, WGM = 8;

__host__ __device__ __forceinline__ int lds_byte(int r, int c) { const int st = (r >> 4) * 2 + (c >> 5), rr = r & 15, cc = c & 31, ob = rr * 64 + cc * 2; return st * 1024 + (ob ^ (((ob >> 9) & 1) << 5)); }
__host__ __device__ __forceinline__ void stage_rc(int b, int& R, int& C) { const int st = b / 1024, sb = b % 1024, swz = sb ^ (((sb >> 9) & 1) << 5); R = (st >> 1) * 16 + swz / 64; C = (st & 1) * 32 + (swz % 64) / 2; }
__host__ __device__ __forceinline__ int perm32(int rho) { const int n = rho >> 4, i = rho & 15; return 8 * (i >> 2) + 4 * n + (i & 3); }

struct Unit { int pm, pn; };
struct Gemm { const bf16_t* A; const bf16_t* Bt; int M, N, K; const int* rowidx; };

struct StaticOrder {
    int nM, nN, nwg, G, c;
    __host__ __device__ void init(int M, int N, int G_, int c_) { nM = M / BM; nN = N / BM; nwg = nM * nN; G = G_; c = c_; }
    __host__ __device__ bool next(int i, Unit& u) const {
        const long L = (long)i * G + c; if (L >= nwg) return false;
        int wgid = (int)L; { const int q = nwg / NXCD, r = nwg % NXCD, xcd = wgid % NXCD, off = wgid / NXCD; wgid = (xcd < r ? xcd * (q + 1) : r * (q + 1) + (xcd - r) * q) + off; }
        const int nig = WGM * nN, gid = wgid / nig, fm = gid * WGM, gsz = (nM - fm) < WGM ? (nM - fm) : WGM;
        u.pm = fm + ((wgid % nig) % gsz); u.pn = (wgid % nig) / gsz; return true;
    }
    __device__ __forceinline__ void a_ready(const Unit&) const {}
    __device__ __forceinline__ void done(const Unit&) const {}
};

__device__ __forceinline__ unsigned cvt_pk_bf16(float lo, float hi) { unsigned r; asm volatile("v_cvt_pk_bf16_f32 %0, %1, %2" : "=v"(r) : "v"(lo), "v"(hi)); return r; }
typedef float f32x2 __attribute__((ext_vector_type(2)));
struct EpiF32Plain {
    static constexpr bool PERM = false, AFTER_DRAIN = false;
    float* C; int ldc; int pn_mask; bool nt;
    __device__ __forceinline__ void operator()(const f32x4 (&acc)[2][2][4][2], const Unit& u, int wr, int wc, int fr, int fq) const {
        const int row0 = u.pm * BM + wr * 64 + fr, col0 = (u.pn & pn_mask) * BM + wc * 32 + 4 * fq;
#pragma unroll
        for (int ai = 0; ai < 2; ++ai)
#pragma unroll
            for (int m = 0; m < 4; ++m) { float* rowp = C + (size_t)(row0 + ai * HALF + m * 16) * ldc + col0;
#pragma unroll
                for (int bj = 0; bj < 2; ++bj)
#pragma unroll
                    for (int n = 0; n < 2; ++n) { if (nt) __builtin_nontemporal_store(acc[ai][bj][m][n], (f32x4*)(rowp + bj * HALF + n * 16)); else *(f32x4*)(rowp + bj * HALF + n * 16) = acc[ai][bj][m][n]; } }
    }
};
struct EpiBf16Plain {
    static constexpr bool PERM = true, AFTER_DRAIN = false;
    bf16_t* O; int ldc; int pn_mask;
    __device__ __forceinline__ void operator()(const f32x4 (&acc)[2][2][4][2], const Unit& u, int wr, int wc, int fr, int fq) const {
        const int row0 = u.pm * BM + wr * 64 + fr, col0 = (u.pn & pn_mask) * BM + wc * 32 + 8 * fq;
#pragma unroll
        for (int ai = 0; ai < 2; ++ai)
#pragma unroll
            for (int m = 0; m < 4; ++m) { bf16_t* rowp = O + (size_t)(row0 + ai * HALF + m * 16) * ldc + col0;
#pragma unroll
                for (int bj = 0; bj < 2; ++bj) { const f32x4 v0 = acc[ai][bj][m][0], v1 = acc[ai][bj][m][1];
                    u32x4 w; w.x = cvt_pk_bf16(v0[0], v0[1]); w.y = cvt_pk_bf16(v0[2], v0[3]); w.z = cvt_pk_bf16(v1[0], v1[1]); w.w = cvt_pk_bf16(v1[2], v1[3]);
                    *(u32x4*)(rowp + bj * HALF) = w; } }
    }
};
struct EpiQRope {
    static constexpr bool PERM = true, AFTER_DRAIN = false;
    bf16_t* O; const float* cs;
    __device__ __forceinline__ void operator()(const f32x4 (&acc)[2][2][4][2], const Unit& u, int wr, int wc, int fr, int fq) const {
        const int row0 = u.pm * BM + wr * 64 + fr;
#pragma unroll
        for (int ai = 0; ai < 2; ++ai)
#pragma unroll
            for (int m = 0; m < 4; ++m) { const int row = row0 + ai * HALF + m * 16; const int bb = row >= 4352 ? 1 : 0; const int l = row - bb * 4352; const bool lat = l < 4096; const int lp = lat ? l : 0;
#pragma unroll
                for (int bj = 0; bj < 2; ++bj) { const int c0 = u.pn * BM + bj * HALF + wc * 32 + 8 * fq; const int hh = c0 / 192, jj = c0 - hh * 192;
                    f32x4 v0 = acc[ai][bj][m][0], v1 = acc[ai][bj][m][1];
                    if (jj >= 128 && lat) { const f32x4* cp = (const f32x4*)(cs + ((size_t)lp * 32 + ((jj - 128) >> 1)) * 2); const f32x4 ca = cp[0], cb = cp[1];
                        const f32x4 a = v0, b = v1;
                        v0[0] = a[0] * ca[0] - a[1] * ca[1]; v0[1] = a[1] * ca[0] + a[0] * ca[1]; v0[2] = a[2] * ca[2] - a[3] * ca[3]; v0[3] = a[3] * ca[2] + a[2] * ca[3];
                        v1[0] = b[0] * cb[0] - b[1] * cb[1]; v1[1] = b[1] * cb[0] + b[0] * cb[1]; v1[2] = b[2] * cb[2] - b[3] * cb[3]; v1[3] = b[3] * cb[2] + b[2] * cb[3]; }
                    u32x4 w; w.x = cvt_pk_bf16(v0[0], v0[1]); w.y = cvt_pk_bf16(v0[2], v0[3]); w.z = cvt_pk_bf16(v1[0], v1[1]); w.w = cvt_pk_bf16(v1[2], v1[3]);
                    *(u32x4*)(O + (size_t)row * 3072 + c0) = w; } }
    }
};
struct EpiResid {
    static constexpr bool PERM = false, AFTER_DRAIN = false;
    const float* base; float* out; const float* gate; int gstride; bool ntbase;
    __device__ __forceinline__ void operator()(const f32x4 (&acc)[2][2][4][2], const Unit& u, int wr, int wc, int fr, int fq) const {
        const int row0 = u.pm * BM + wr * 64 + fr, col0 = u.pn * BM + wc * 32 + 4 * fq; const float* gp = gate + (size_t)(u.pm >> 4) * gstride + col0;
        f32x4 gv[2][2];
#pragma unroll
        for (int bj = 0; bj < 2; ++bj)
#pragma unroll
            for (int n = 0; n < 2; ++n) gv[bj][n] = *(const f32x4*)(gp + bj * HALF + n * 16);
#pragma unroll
        for (int ai = 0; ai < 2; ++ai)
#pragma unroll
            for (int m = 0; m < 4; ++m) { const size_t off = (size_t)(row0 + ai * HALF + m * 16) * 2048 + col0;
#pragma unroll
                for (int bj = 0; bj < 2; ++bj)
#pragma unroll
                    for (int n = 0; n < 2; ++n) { const f32x4 bs = ntbase ? __builtin_nontemporal_load((const f32x4*)(base + off + bj * HALF + n * 16)) : *(const f32x4*)(base + off + bj * HALF + n * 16); *(f32x4*)(out + off + bj * HALF + n * 16) = bs + gv[bj][n] * acc[ai][bj][m][n]; }
                asm volatile("" ::: "memory"); }
    }
};
struct EpiSwiGLU {
    static constexpr bool PERM = true, AFTER_DRAIN = false;
    bf16_t* O;
    __device__ __forceinline__ float silu(float g) const { return g * __builtin_amdgcn_rcpf(1.0f + __builtin_amdgcn_exp2f(-1.4426950408889634f * g)); }
    __device__ __forceinline__ void operator()(const f32x4 (&acc)[2][2][4][2], const Unit& u, int wr, int wc, int fr, int fq) const {
        const int row0 = u.pm * BM + wr * 64 + fr, col0 = (u.pn & 7) * 128 + wc * 32 + 8 * fq;
#pragma unroll
        for (int ai = 0; ai < 2; ++ai)
#pragma unroll
            for (int m = 0; m < 4; ++m) { const f32x4 g0 = acc[ai][0][m][0], g1 = acc[ai][0][m][1], u0 = acc[ai][1][m][0], u1 = acc[ai][1][m][1];
                u32x4 w; w.x = cvt_pk_bf16(silu(g0[0]) * u0[0], silu(g0[1]) * u0[1]); w.y = cvt_pk_bf16(silu(g0[2]) * u0[2], silu(g0[3]) * u0[3]);
                w.z = cvt_pk_bf16(silu(g1[0]) * u1[0], silu(g1[1]) * u1[1]); w.w = cvt_pk_bf16(silu(g1[2]) * u1[2], silu(g1[3]) * u1[3]);
                *(u32x4*)(O + (size_t)(row0 + ai * HALF + m * 16) * 1024 + col0) = w; }
    }
};
struct HfOrder {
    int G, c, skip;
    __device__ __forceinline__ bool next(int i, Unit& u) const {
        int L;
        if (G > skip + 8) { if (c < skip) return false; L = (c - skip) + i * (G - skip); } else L = i * G + c;
        if (L >= 512) return false;
        const int dir = L >> 8, w = L & 255; u.pm = dir * 16 + (w & 15); u.pn = dir * 16 + (w >> 4); return true;
    }
    __device__ __forceinline__ void a_ready(const Unit&) const {}
    __device__ __forceinline__ void done(const Unit&) const {}
};
struct MoeOrder {
    int G, c;
    __device__ __forceinline__ bool next(int i, Unit& u) const {
        int e, j;
        if (G == 256) { if (i >= 2) return false; e = i * 8 + (c & 7); j = c >> 3; }
        else { const int L = i * G + c; if (L >= 512) return false; e = L >> 5; j = L & 31; }
        u.pm = e * 4 + (j & 3); u.pn = e * 8 + (j >> 2); return true;
    }
    __device__ __forceinline__ void a_ready(const Unit&) const {}
    __device__ __forceinline__ void done(const Unit&) const {}
};

template <class Epi, class Sched, bool ALIGN_EPI = false, bool SP2 = false, bool GATHER = false  >
__device__ __forceinline__ void gemm_phase(PG8_LAS unsigned char* lds, const Gemm g, const Sched& S, const Epi& E) {
    const int tid = threadIdx.x, wid = __builtin_amdgcn_readfirstlane(tid >> 6), lane = tid & 63, wr = wid >> 2, wc = wid & 3, fr = lane & 15, fq = lane >> 4;
    const int K = g.K, nt = K / BK;
    unsigned voffA[2], voffB[2];
#pragma unroll
    for (int i = 0; i < 2; ++i) { int R, C; stage_rc(tid * 16 + i * 8192, R, C); const int Rb = Epi::PERM ? ((R & ~31) + perm32(R & 31)) : R;
        voffA[i] = (unsigned)(R * K + C) * 2u; voffB[i] = (unsigned)(Rb * K + C) * 2u; }
    unsigned gC[2][2] = {{0u, 0u}, {0u, 0u}}, gN[2][2] = {{0u, 0u}, {0u, 0u}}, g2[2][2] = {{0u, 0u}, {0u, 0u}};
    PG8_LAS unsigned* gl = (PG8_LAS unsigned*)(lds + STAGE_BYTES);
    if constexpr (GATHER) { static_assert(SP2, "GATHER is written for the SP2 loop");
        Unit u2;
#pragma unroll
        for (int q = 0; q < 2; ++q) if (S.next(q, u2)) {
#pragma unroll
            for (int h = 0; h < 2; ++h)
#pragma unroll
                for (int i = 0; i < 2; ++i) { int R, C; stage_rc(tid * 16 + i * 8192, R, C); const unsigned row = (unsigned)g.rowidx[u2.pm * BM + h * HALF + R]; gl[((q * 2 + h) * 2 + i) * 512 + tid] = (row * (unsigned)K + (unsigned)C) * 2u; } }
        asm volatile("s_waitcnt vmcnt(0) lgkmcnt(0)" ::: "memory");
#pragma unroll
        for (int h = 0; h < 2; ++h)
#pragma unroll
            for (int i = 0; i < 2; ++i) gC[h][i] = gl[((0 * 2 + h) * 2 + i) * 512 + tid];
    }
#define PG8_STA(b, h, base, offs2) do { if constexpr (GATHER) { PG8_STAGE(PG8_SA(b, h), base, offs2[h]); } else { PG8_STAGE(PG8_SA(b, h), (base) + (h) * hstep, voffA); } } while (0)
    const size_t kstep = (size_t)(BK * 2);
    const size_t hstep = (size_t)HALF * K * 2;
    const size_t tstep = 2 * hstep;
    const unsigned ldsw = (unsigned)wid * 1024u;
    const int aoff = lds_byte(wr * 64 + fr, fq * 8), boff = lds_byte(wc * 32 + fr, fq * 8);
#define PG8_SA(b, h) (((b) * 2 + (h)) * HTB)
#define PG8_SB(b, h) ((4 + (b) * 2 + (h)) * HTB)
#define PG8_STAGE(bufoff, gbase, voff) do { _Pragma("unroll") for (int _i = 0; _i < 2; ++_i) \
        __builtin_amdgcn_global_load_lds((const unsigned*)((const char*)(gbase) + (voff)[_i]), (PG8_LAS unsigned*)(lds + (bufoff) + ldsw + _i * 8192), 16, 0, 0); } while (0)
#define PG8_LDA(dst, b, h) do { _Pragma("unroll") for (int m = 0; m < 4; ++m) _Pragma("unroll") for (int k = 0; k < 2; ++k) dst[m][k] = *(const PG8_LAS bf16x8*)(lds + PG8_SA(b, h) + aoff + m * 2048 + k * 1024); } while (0)
#define PG8_LDB(dst, b, h) do { _Pragma("unroll") for (int n = 0; n < 2; ++n) _Pragma("unroll") for (int k = 0; k < 2; ++k) dst[n][k] = *(const PG8_LAS bf16x8*)(lds + PG8_SB(b, h) + boff + n * 2048 + k * 1024); } while (0)
#define PG8_MMA(ai, bj, At, Bt) do { __builtin_amdgcn_s_setprio(1); _Pragma("unroll") for (int m = 0; m < 4; ++m) _Pragma("unroll") for (int n = 0; n < 2; ++n) _Pragma("unroll") for (int k = 0; k < 2; ++k) \
        acc[ai][bj][m][n] = __builtin_amdgcn_mfma_f32_16x16x32_bf16(Bt[n][k], At[m][k], acc[ai][bj][m][n], 0, 0, 0); __builtin_amdgcn_s_setprio(0); } while (0)
#define PG8_WAIT_V(n) asm volatile("s_waitcnt vmcnt(" #n ")" ::: "memory")
#define PG8_WAIT_L(n) asm volatile("s_waitcnt lgkmcnt(" #n ")" ::: "memory")
#define PG8_BAR __builtin_amdgcn_s_barrier()
#define PG8_SCHED __builtin_amdgcn_sched_barrier(0)
    Unit cur, nxt; int ui = 0;
    if (!S.next(0, cur)) return;
    f32x4 acc[2][2][4][2];
#pragma unroll
    for (int a = 0; a < 2; ++a)
#pragma unroll
        for (int b = 0; b < 2; ++b)
#pragma unroll
            for (int m = 0; m < 4; ++m)
#pragma unroll
                for (int n = 0; n < 2; ++n) acc[a][b][m][n] = (f32x4){0.f, 0.f, 0.f, 0.f};
    bf16x8 At[4][2], B0[2][2], B1[2][2];
    const char* cA = (const char*)g.A + (GATHER ? (size_t)0 : (size_t)cur.pm * tstep); const char* cB = (const char*)g.Bt + (size_t)cur.pn * tstep;
    S.a_ready(cur);
    if constexpr (SP2) {
        PG8_STAGE(PG8_SB(0, 0), cB, voffB); PG8_STAGE(PG8_SB(0, 1), cB + hstep, voffB); PG8_STA(0, 0, cA, gC); PG8_STA(0, 1, cA, gC);
        if (wr == 1) PG8_BAR;
        PG8_WAIT_V(2); PG8_BAR;
        PG8_STAGE(PG8_SB(1, 0), cB + kstep, voffB); PG8_STA(1, 0, cA + kstep, gC); PG8_STAGE(PG8_SB(1, 1), cB + hstep + kstep, voffB);
        PG8_WAIT_V(6); PG8_BAR;
    } else {
        PG8_STAGE(PG8_SB(0, 0), cB, voffB); PG8_STA(0, 0, cA, gC); PG8_STAGE(PG8_SB(0, 1), cB + hstep, voffB); PG8_STA(0, 1, cA, gC);
        if (wr == 1) PG8_BAR;
        PG8_WAIT_V(4); PG8_BAR;
        PG8_STAGE(PG8_SB(1, 0), cB + kstep, voffB); PG8_STA(1, 0, cA + kstep, gC); PG8_STAGE(PG8_SB(1, 1), cB + hstep + kstep, voffB);
        PG8_WAIT_V(6); PG8_BAR;
    }
    for (;;) {
        const bool has_next = S.next(ui + 1, nxt);
        const char* nA = (has_next && !GATHER) ? (const char*)g.A + (size_t)nxt.pm * tstep : cA; const char* nB = has_next ? (const char*)g.Bt + (size_t)nxt.pn * tstep : cB;
        if constexpr (GATHER) {
#pragma unroll
            for (int h = 0; h < 2; ++h)
#pragma unroll
                for (int i = 0; i < 2; ++i) gN[h][i] = has_next ? gl[(((ui + 1) * 2 + h) * 2 + i) * 512 + tid] : gC[h][i]; }
        for (int t = 0; t < nt; t += 2) {
            const bool last = (t == nt - 2);
            const char* a1 = cA + (size_t)(t + 1) * kstep;
            const char* a2 = last ? nA : cA + (size_t)(t + 2) * kstep; const char* b2 = last ? nB : cB + (size_t)(t + 2) * kstep;
            const char* a3 = a2 + kstep; const char* b3 = b2 + kstep;
            if (last && has_next) S.a_ready(nxt);
            if constexpr (GATHER) {
#pragma unroll
                for (int h = 0; h < 2; ++h)
#pragma unroll
                    for (int i = 0; i < 2; ++i) g2[h][i] = last ? gN[h][i] : gC[h][i]; }
            if constexpr (SP2) {
            PG8_LDB(B0, 0, 0); PG8_LDB(B1, 0, 1); PG8_SCHED; PG8_LDA(At, 0, 0); PG8_STA(1, 1, a1, gC);
            PG8_WAIT_V(8); PG8_WAIT_L(0); PG8_BAR; PG8_MMA(0, 0, At, B0); PG8_MMA(0, 1, At, B1); PG8_BAR; PG8_SCHED;
            PG8_LDA(At, 0, 1); PG8_STAGE(PG8_SB(0, 0), b2, voffB); PG8_STAGE(PG8_SB(0, 1), b2 + hstep, voffB); PG8_STA(0, 0, a2, g2);
            PG8_WAIT_V(8); PG8_WAIT_L(0); PG8_BAR; PG8_MMA(1, 0, At, B0); PG8_MMA(1, 1, At, B1); PG8_BAR; PG8_SCHED;
            PG8_LDB(B0, 1, 0); PG8_LDB(B1, 1, 1); PG8_SCHED; PG8_LDA(At, 1, 0); PG8_STA(0, 1, a2, g2);
            PG8_WAIT_V(8); PG8_WAIT_L(0); PG8_BAR; PG8_MMA(0, 0, At, B0); PG8_MMA(0, 1, At, B1); PG8_BAR; PG8_SCHED;
            PG8_LDA(At, 1, 1); PG8_STAGE(PG8_SB(1, 0), b3, voffB); PG8_STAGE(PG8_SB(1, 1), b3 + hstep, voffB); PG8_STA(1, 0, a3, g2);
            PG8_WAIT_V(8); PG8_WAIT_L(0); PG8_BAR; PG8_MMA(1, 0, At, B0); PG8_MMA(1, 1, At, B1); PG8_BAR; PG8_SCHED;
            } else {
            PG8_LDB(B0, 0, 0); PG8_SCHED; PG8_LDA(At, 0, 0); PG8_STA(1, 1, a1, gC);
            PG8_WAIT_L(8); PG8_BAR; PG8_WAIT_L(0); PG8_MMA(0, 0, At, B0); PG8_BAR; PG8_SCHED;
            PG8_LDB(B1, 0, 1); PG8_STAGE(PG8_SB(0, 0), b2, voffB);
            PG8_BAR; PG8_WAIT_L(0); PG8_MMA(0, 1, At, B1); PG8_BAR;
            PG8_LDA(At, 0, 1); PG8_STA(0, 0, a2, g2);
            PG8_BAR; PG8_WAIT_L(0); PG8_MMA(1, 0, At, B0); PG8_BAR; PG8_SCHED;
            PG8_STAGE(PG8_SB(0, 1), b2 + hstep, voffB);
            PG8_WAIT_V(6); PG8_BAR; PG8_MMA(1, 1, At, B1); PG8_BAR;
            PG8_LDB(B0, 1, 0); PG8_SCHED; PG8_LDA(At, 1, 0); PG8_STA(0, 1, a2, g2);
            PG8_WAIT_L(8); PG8_BAR; PG8_WAIT_L(0); PG8_MMA(0, 0, At, B0); PG8_BAR; PG8_SCHED;
            PG8_LDB(B1, 1, 1); PG8_STAGE(PG8_SB(1, 0), b3, voffB);
            PG8_BAR; PG8_WAIT_L(0); PG8_MMA(0, 1, At, B1); PG8_BAR;
            PG8_LDA(At, 1, 1); PG8_STA(1, 0, a3, g2);
            PG8_BAR; PG8_WAIT_L(0); PG8_MMA(1, 0, At, B0); PG8_BAR; PG8_SCHED;
            PG8_STAGE(PG8_SB(1, 1), b3 + hstep, voffB);
            PG8_WAIT_V(6); PG8_BAR; PG8_MMA(1, 1, At, B1); PG8_BAR;
            }
        }
        if constexpr (ALIGN_EPI) { if (wr == 0) PG8_BAR; }
        if constexpr (!Epi::AFTER_DRAIN) { E(acc, cur, wr, wc, fr, fq); S.done(cur); }
        if (!has_next) break;
#pragma unroll
        for (int a = 0; a < 2; ++a)
#pragma unroll
            for (int b = 0; b < 2; ++b)
#pragma unroll
                for (int m = 0; m < 4; ++m)
#pragma unroll
                    for (int n = 0; n < 2; ++n) acc[a][b][m][n] = (f32x4){0.f, 0.f, 0.f, 0.f};
        cur = nxt; cA = nA; cB = nB; ++ui;
        if constexpr (GATHER) {
#pragma unroll
            for (int h = 0; h < 2; ++h)
#pragma unroll
                for (int i = 0; i < 2; ++i) gC[h][i] = gN[h][i]; }
        if constexpr (ALIGN_EPI) { if (wr == 1) PG8_BAR; }
    }
    PG8_WAIT_V(0);
    if constexpr (!ALIGN_EPI) { if (wr == 0) PG8_BAR; }
    PG8_BAR;
    if constexpr (Epi::AFTER_DRAIN) { E.fused(acc, cur, wr, wc, fr, fq, lds, wid, lane); S.done(cur); }
#undef PG8_SA
#undef PG8_SB
#undef PG8_STAGE
#undef PG8_STA
#undef PG8_LDA
#undef PG8_LDB
#undef PG8_MMA
#undef PG8_WAIT_V
#undef PG8_WAIT_L
#undef PG8_BAR
#undef PG8_SCHED
}
}
#define GAS __attribute__((address_space(1)))
#define LAS __attribute__((address_space(3)))
typedef unsigned short bf16;
typedef unsigned v4u __attribute__((ext_vector_type(4)));
typedef unsigned v2u __attribute__((ext_vector_type(2)));
typedef float f32x4 __attribute__((ext_vector_type(4)));
typedef float f32x2 __attribute__((ext_vector_type(2)));
typedef float f32x16 __attribute__((ext_vector_type(16)));
typedef short bf16x8 __attribute__((ext_vector_type(8)));
typedef short s16x4 __attribute__((ext_vector_type(4)));
typedef GAS unsigned gu32;
#define RLX_AGENT __ATOMIC_RELAXED, __HIP_MEMORY_SCOPE_AGENT
#define LDS_WAIT() asm volatile("s_waitcnt lgkmcnt(0)" ::: "memory")
#define VM_WAIT() asm volatile("s_waitcnt vmcnt(0)" ::: "memory")
__device__ __forceinline__ unsigned pk2(float lo, float hi) { unsigned r; asm volatile("v_cvt_pk_bf16_f32 %0, %1, %2" : "=v"(r) : "v"(lo), "v"(hi)); return r; }
__device__ __forceinline__ float bf_lo(unsigned w) { return __uint_as_float(w << 16); }
__device__ __forceinline__ float bf_hi(unsigned w) { return __uint_as_float(w & 0xffff0000u); }
__device__ __forceinline__ float bf1(bf16 h) { return __uint_as_float(((unsigned)h) << 16); }
__device__ __forceinline__ int opq(int x) { asm volatile("" : "+v"(x)); return x; }
__device__ __forceinline__ float wave_sum(float v) {
#pragma unroll
    for (int o = 1; o < 64; o <<= 1) v += __shfl_xor(v, o);
    return v;
}
__device__ __forceinline__ int wave_sum_i(int v) {
#pragma unroll
    for (int o = 1; o < 64; o <<= 1) v += __shfl_xor(v, o);
    return v;
}

#define XB_TMO      128
#define XB_XCNT(j)  (256  + 64 * (j))
#define XB_XSUB(j)  (1280 + 64 * (j))
#define XB_XGEN(j)  (2304 + 64 * (j))
#define XB_TOP      3328
#define XB_TOPGEN   3392
#define XCD_BAR_WORDS 3456
#define XB_SPIN_CAP (1u << 18)

__device__ __forceinline__ unsigned xb_ld(unsigned* p)              { return __hip_atomic_load(p, __ATOMIC_RELAXED, __HIP_MEMORY_SCOPE_AGENT); }
__device__ __forceinline__ unsigned xb_add(unsigned* p, unsigned v) { return __hip_atomic_fetch_add(p, v, __ATOMIC_RELAXED, __HIP_MEMORY_SCOPE_AGENT); }
__device__ __forceinline__ unsigned xb_xcc_id() { return (unsigned)__builtin_amdgcn_s_getreg((3 << 11) | 20) & 0xFu; }
#define XB_SPIN(cond, bar) do { unsigned _sp = 0; while (cond) { __builtin_amdgcn_s_sleep(1); \
    if ((++_sp & 255u) == 0u) { if (xb_ld(&(bar)[XB_TMO])) break; if (_sp > XB_SPIN_CAP) { atomicAdd(&(bar)[XB_TMO], 1u); break; } } } } while (0)

struct XcdBarrier {
    unsigned* bar; unsigned x;
    volatile LAS unsigned* st;
};

__device__ __forceinline__ XcdBarrier xcd_barrier_post(unsigned* bar, volatile LAS unsigned* st) {
    XcdBarrier b; b.bar = bar; b.x = xb_xcc_id(); b.st = st;
    if (threadIdx.x == 0) (void)xb_add(&bar[XB_XCNT(b.x)], 1u);
    return b;
}
__device__ __forceinline__ void xcd_barrier_complete(unsigned* bar, unsigned x, unsigned& nloc, unsigned& nx) {
    const unsigned G = gridDim.x * gridDim.y * gridDim.z;
    unsigned sum, cnt, mine, sp = 0u;
    for (;;) {
        sum = 0u; cnt = 0u; mine = 0u;
#pragma unroll
        for (unsigned j = 0; j < 16; ++j) { const unsigned c = xb_ld(&bar[XB_XCNT(j)]); sum += c; cnt += (c > 0u) ? 1u : 0u; mine = (j == x) ? c : mine; }
        if (sum == G) break;
        __builtin_amdgcn_s_sleep(1);
        if ((++sp & 255u) == 0u) { if (xb_ld(&bar[XB_TMO])) break; if (sp > XB_SPIN_CAP) { atomicAdd(&bar[XB_TMO], 1u); break; } }
    }
    nloc = mine > 0u ? mine : 1u; nx = cnt > 0u ? cnt : 1u;
}

__device__ __forceinline__ void xcd_barrier(const XcdBarrier& b) {
    asm volatile("s_waitcnt vmcnt(0)" ::: "memory");
    __syncthreads();
    if (threadIdx.x == 0) {
        unsigned* bar = b.bar;
        __builtin_amdgcn_s_waitcnt(0);
        unsigned nloc = b.st[0], nx = b.st[1];
        if (nloc == 0u) { xcd_barrier_complete(bar, b.x, nloc, nx); b.st[0] = nloc; b.st[1] = nx; }
        const unsigned old = xb_add(&bar[XB_XSUB(b.x)], 1u);
        const unsigned gen = old / nloc;
        if (old + 1u == (gen + 1u) * nloc) {
            __builtin_amdgcn_fence(__ATOMIC_RELEASE, "agent");
            asm volatile("s_waitcnt vmcnt(0)" ::: "memory");
            const unsigned og = xb_add(&bar[XB_TOP], 1u);
            const unsigned tg = og / nx;
            if (og + 1u == (tg + 1u) * nx) xb_add(&bar[XB_TOPGEN], 1u);
            else XB_SPIN(xb_ld(&bar[XB_TOPGEN]) == tg, bar);
            __builtin_amdgcn_fence(__ATOMIC_ACQUIRE, "agent");
            xb_add(&bar[XB_XGEN(b.x)], 1u);
            asm volatile("s_waitcnt vmcnt(0)" ::: "memory");
        } else {
            XB_SPIN(xb_ld(&bar[XB_XGEN(b.x)]) == gen, bar);
            __builtin_amdgcn_fence(__ATOMIC_ACQUIRE, "agent");
            asm volatile("s_waitcnt vmcnt(0)" ::: "memory");
        }
    }
    __syncthreads();
}

constexpr int NWAVES = 8;
constexpr int DM = 2048, NB = 2, SEQ = 4096, CTXL = 256, LT = SEQ + CTXL  , MT = NB * LT  , MX = NB * SEQ  ;
constexpr int NH = 16, QRANK = 512, KVRANK = 256, INDIM = 832, INPAD = 1024, QW = NH * 192  , KVW = NH * 256  ;
constexpr int NE = 16, CAP = 512, FFD = 1024, MROWS = NB * NE * CAP  ;
constexpr float EPS = 1e-6f;
constexpr size_t MiB = 1u << 20;
constexpr size_t WS_CTL = 0, CTL_ZERO_BYTES = 1 * MiB;
constexpr size_t WS_MOD = 64 * 1024;
constexpr size_t WS_CS = 1 * MiB, WS_A2S = 2 * MiB  , WS_A2RS = 4 * MiB  , WS_W3S = 58 * MiB  , WS_TW = 6 * MiB  , WS_SELROW = 6 * MiB + 128 * 1024  , WS_AFF = 7 * MiB  , WS_TOK = 7 * MiB + 512 * 1024  ;
constexpr size_t WS_WIN = 8 * MiB, WS_WUQ = 12 * MiB, WS_WUKV = 15 * MiB, WS_WO = 17 * MiB, WS_HYWOUT = 25 * MiB, WS_HYWIN = 33 * MiB;
constexpr size_t WS_WGU = 64 * MiB  , WS_WD = 320 * MiB  ;
constexpr size_t WS_H = 448 * MiB  , WS_PROJ = 482 * MiB  , WS_CQN = 516 * MiB, WS_CKVN = 525 * MiB, WS_KROPE = 530 * MiB;
constexpr size_t WS_Q = 532 * MiB, WS_KV = 583 * MiB, WS_O = 651 * MiB, WS_X1 = 683 * MiB  , WS_XG = 747 * MiB, WS_ACT = 811 * MiB, WS_Y = 843 * MiB, WS_HF = 907 * MiB  , WS_END = 1035 * MiB;
constexpr size_t WS_U = 532 * MiB  , WS_ZT = 628 * MiB  , WS_Z = 482 * MiB  ;
constexpr int CW_TMO = 0, CW_BAR = 4096;
constexpr int LDS_BYTES = 155648, MISC_OFF = 153600;
constexpr int NPHASE = 21;

struct Frame {
    LAS unsigned char* lds; unsigned char* ldsg;
    int tid, wave, vcu, G;
    float* out; unsigned char* ws;
};
__device__ __forceinline__ const float* arg_in(int i) {
    const __attribute__((address_space(4))) unsigned long long* ka = (const __attribute__((address_space(4))) unsigned long long*)__builtin_amdgcn_kernarg_segment_ptr();
    asm volatile("" : "+s"(ka));
    return (const float*)(const __attribute__((address_space(1))) float*)ka[i];
}
#define WSP(T, off) ((T*)(F.ws + (off)))

__device__ __forceinline__ int uq_srccol(int n) { const int hh = n / 192, jj = n - hh * 192; if (jj < 128) return n; const int r = jj - 128; return hh * 192 + 128 + (r >> 1) + 32 * (r & 1); }
template <bool VEC>
__device__ __forceinline__ void transpose_item(const float* src, int N, int c0, int k0, bf16* dst, int K, LAS float* scr, int lane) {
    if constexpr (VEC) {
        const float* s = src + (size_t)k0 * N + c0 + (lane & 15) * 4;
        f32x4 v[16];
#pragma unroll
        for (int i = 0; i < 16; ++i) v[i] = __builtin_nontemporal_load((const f32x4*)(s + (size_t)(4 * i + (lane >> 4)) * N));
#pragma unroll
        for (int i = 0; i < 16; ++i) { LAS float* d = scr + (4 * i + (lane >> 4)) * 65 + (lane & 15) * 4; d[0] = v[i][0]; d[1] = v[i][1]; d[2] = v[i][2]; d[3] = v[i][3]; }
    } else {
        const int sc = uq_srccol(c0 + lane);
        const float* s = src + (size_t)k0 * N + sc;
#pragma unroll 16
        for (int kk = 0; kk < 64; ++kk) scr[kk * 65 + lane] = s[(size_t)kk * N];
    }
    LDS_WAIT(); asm volatile("" ::: "memory");
    const int c = lane & 7;
#pragma unroll
    for (int jj = 0; jj < 8; ++jj) { const int n = (lane >> 3) + 8 * jj; const LAS float* s = scr + (8 * c) * 65 + n;
        v4u o; o.x = pk2(s[0 * 65], s[1 * 65]); o.y = pk2(s[2 * 65], s[3 * 65]); o.z = pk2(s[4 * 65], s[5 * 65]); o.w = pk2(s[6 * 65], s[7 * 65]);
        *(v4u*)(dst + (size_t)n * K + k0 + 8 * c) = o; }
    LDS_WAIT(); asm volatile("" ::: "memory");
}
__device__ __forceinline__ float silu_f(float x) { return x / (1.0f + __expf(-x)); }

constexpr int CI0 = 32 * 13, CI1 = 8 * 48, CI2 = 4 * 64, CI_EARLY = CI0 + CI1 + CI2;
constexpr int CI3 = 32 * 32, CI4 = 32 * 32, CI5 = 32 * 96, CI_GU = 32 * 1024, CI_D = 32 * 512, CI_LATE = CI3 + CI4 + CI5 + CI_GU + CI_D;
__device__ __forceinline__ void convert_early(Frame& F) {
    const int lane = opq(F.tid) & 63;
    const int gw = F.vcu * NWAVES + F.wave, NGW = F.G * NWAVES;
    LAS float* scr = (LAS float*)(F.lds + F.wave * 16640);
#pragma unroll 1
    for (int it = gw; it < CI_EARLY; it += NGW) {
        int r = it; const float* src; int N, c0, k0, K; bf16* dst; bool vec = true;
        if (r < CI0) { const int kb = r / 13, nb = r % 13; src = arg_in(8); N = INDIM; c0 = nb * 64; k0 = kb * 64; K = DM; dst = WSP(bf16, WS_WIN) + (size_t)nb * 64 * DM; }
        else if ((r -= CI0) < CI1) { const int kb = r / 48, nb = r % 48; src = arg_in(11); N = QW; c0 = nb * 64; k0 = kb * 64; K = QRANK; dst = WSP(bf16, WS_WUQ) + (size_t)nb * 64 * QRANK; vec = false; }
        else { r -= CI1; const int kb = r / 64, nb = r % 64; src = arg_in(12); N = KVW; c0 = nb * 64; k0 = kb * 64; K = KVRANK; dst = WSP(bf16, WS_WUKV) + (size_t)nb * 64 * KVRANK; }
        if (vec) transpose_item<true>(src, N, c0, k0, dst, K, scr, lane); else transpose_item<false>(src, N, c0, k0, dst, K, scr, lane);
    }
}
struct CvItem { const float* s; bf16* dst; int N, K; };
__device__ __forceinline__ CvItem cv_decode_late(Frame& F, int it, int lane) {
    int r = it; const float* src; int N, c0, k0, K; bf16* dst;
    if (r < CI3) { const int kb = r / 32, nb = r % 32; src = arg_in(13); N = DM; c0 = nb * 64; k0 = kb * 64; K = DM; dst = WSP(bf16, WS_WO) + (size_t)nb * 64 * DM; }
    else if ((r -= CI3) < CI4) { const int kb = r / 32, nb = r % 32; src = arg_in(25); N = DM; c0 = nb * 64; k0 = kb * 64; K = DM; dst = WSP(bf16, WS_HYWOUT) + (size_t)nb * 64 * DM; }
    else if ((r -= CI4) < CI5) { const int kb = r / 96, nb = r % 96; src = arg_in(14); N = 3 * DM; c0 = nb * 64; k0 = kb * 64; K = DM; dst = WSP(bf16, WS_HYWIN) + (size_t)nb * 64 * DM; }
    else if ((r -= CI5) < CI_GU) { const int le = r >> 10, q = r & 1023, kb = q >> 5, nb = q & 31;
        src = (((nb >> 1) & 1) ? arg_in(28) : arg_in(27)) + (size_t)le * DM * FFD; N = FFD; c0 = (nb >> 2) * 128 + (nb & 1) * 64; k0 = kb * 64; K = DM; dst = WSP(bf16, WS_WGU) + ((size_t)le * 2048 + nb * 64) * DM; }
    else { r -= CI_GU; const int le = r >> 9, q = r & 511, kb = q >> 5, nb = q & 31;
        src = arg_in(29) + (size_t)le * FFD * DM; N = DM; c0 = nb * 64; k0 = kb * 64; K = FFD; dst = WSP(bf16, WS_WD) + ((size_t)le * 2048 + nb * 64) * FFD; }
    CvItem d; d.s = src + (size_t)(k0 + (lane >> 4)) * N + c0 + (lane & 15) * 4; d.dst = dst + k0; d.N = N; d.K = K; return d;
}
__device__ __forceinline__ void cv_issue(const CvItem& d, f32x4 (&v)[16]) {
#pragma unroll
    for (int i = 0; i < 16; ++i) v[i] = __builtin_nontemporal_load((const f32x4*)(d.s + (size_t)(4 * i) * d.N));
}
__device__ __forceinline__ void cv_finish(const CvItem& d, const f32x4 (&v)[16], LAS float* scr, int lane) {
#pragma unroll
    for (int i = 0; i < 16; ++i) { LAS float* p = scr + (4 * i + (lane >> 4)) * 65 + (lane & 15) * 4; p[0] = v[i][0]; p[1] = v[i][1]; p[2] = v[i][2]; p[3] = v[i][3]; }
    LDS_WAIT(); asm volatile("" ::: "memory");
    const int c = lane & 7;
#pragma unroll
    for (int jj = 0; jj < 8; ++jj) { const int n = (lane >> 3) + 8 * jj; const LAS float* s = scr + (8 * c) * 65 + n;
        v4u o; o.x = pk2(s[0 * 65], s[1 * 65]); o.y = pk2(s[2 * 65], s[3 * 65]); o.z = pk2(s[4 * 65], s[5 * 65]); o.w = pk2(s[6 * 65], s[7 * 65]);
        __builtin_nontemporal_store(o, (v4u*)(d.dst + (size_t)n * d.K + 8 * c)); }
    LDS_WAIT(); asm volatile("" ::: "memory");
}
__device__ __forceinline__ void convert_late(Frame& F) {
    const int lane = opq(F.tid) & 63;
    const int gw = F.vcu * NWAVES + F.wave, NGW = F.G * NWAVES;
    LAS float* scr = (LAS float*)(F.lds + F.wave * 16640);
    __syncthreads();
    int it = gw; CvItem da, db; f32x4 va[16], vb[16];
    if (it < CI_LATE) { da = cv_decode_late(F, it, lane); cv_issue(da, va); }
#pragma unroll 1
    while (it < CI_LATE) {
        const int it2 = it + NGW; const bool h2 = it2 < CI_LATE;
        if (h2) { db = cv_decode_late(F, it2, lane); cv_issue(db, vb); }
        cv_finish(da, va, scr, lane);
        if (!h2) break;
        const int it3 = it2 + NGW; const bool h3 = it3 < CI_LATE;
        if (h3) { da = cv_decode_late(F, it3, lane); cv_issue(da, va); }
        cv_finish(db, vb, scr, lane);
        it = it3;
    }
    __syncthreads();
}
__device__ __forceinline__ void p0_prologue(Frame& F) {
    const int lane = opq(F.tid) & 63;
#ifndef NO_PA
    convert_early(F);
#endif
    __syncthreads();
#ifndef NO_PB
    {
        LAS float* sv = (LAS float*)F.lds;
        LAS float* part = sv + 3 * DM;
        { const float* cin = arg_in(1); const float* cctx = arg_in(3);
        for (int i = F.tid; i < 3 * DM; i += 512) { const float cv = i < 2 * DM ? cin[i] : cctx[i - 2 * DM]; sv[i] = silu_f(cv); } }
        __syncthreads();
        float* mod = WSP(float, WS_MOD); const float* adaw = arg_in(4); const float* adab = arg_in(5);
        const int q = F.tid % 24, kg = F.tid / 24;
        for (int un = F.vcu; un < 256; un += F.G) {
            const int layer = un >> 7, n0 = (un & 127) * 96;
            const float* W = adaw + (size_t)layer * DM * 6 * DM + n0 + q * 4;
            f32x4 a0 = {0.f, 0.f, 0.f, 0.f}, a1 = a0, a2 = a0;
            if (kg < 21) {
#pragma unroll 8
                for (int k = kg; k < DM; k += 21) { const f32x4 w = __builtin_nontemporal_load((const f32x4*)(W + (size_t)k * (6 * DM))); a0 += sv[k] * w; a1 += sv[DM + k] * w; a2 += sv[2 * DM + k] * w; }
                LAS float* pp = part + kg * 288 + q * 4;
                *(LAS f32x4*)pp = a0; *(LAS f32x4*)(pp + 96) = a1; *(LAS f32x4*)(pp + 192) = a2;
            }
            __syncthreads();
            if (F.tid < 288) { const int m = F.tid / 96, nn = F.tid % 96; float s = adab[(size_t)layer * 6 * DM + n0 + nn];
#pragma unroll
                for (int g = 0; g < 21; ++g) s += part[g * 288 + F.tid];
                mod[((size_t)layer * 3 + m) * 6 * DM + n0 + nn] = s; }
            __syncthreads();
        }
    }
#endif
    __syncthreads();
#ifndef NO_PC
    {
        LAS float* h1s = (LAS float*)F.lds;
        const float* w1 = arg_in(17); const float* b1 = arg_in(18); const float* w2 = arg_in(19); const float* b2 = arg_in(20); const float* fr = arg_in(23);
        bf16* a2s = WSP(bf16, WS_A2S); bf16* a2rs = WSP(bf16, WS_A2RS);
        const int lp = F.tid >> 6, j = F.tid & 63;
        for (int un = F.vcu; un < SEQ / 8; un += F.G) {
            const int l = un * 8 + lp;
            const float t = (float)l / (float)SEQ, w = 6.283185307179586f * (float)l / (float)SEQ;
            LAS float* zs = h1s + 512;
            __syncthreads();
            if (j < 32) { const int i = j & 15; const float band = 1e-4f + (float)i * ((15.0f - 1e-4f) / 15.0f); const float ang = w * band; zs[lp * 36 + 1 + j] = j < 16 ? cosf(ang) : -sinf(ang); }
            if (j == 32) zs[lp * 36] = t;
            __syncthreads();
            float pre = b1[j];
#pragma unroll
            for (int i = 0; i < 33; ++i) pre += zs[lp * 36 + i] * w1[i * 64 + j];
            const float f = fr[j];
            h1s[lp * 64 + j] = sinf(f * pre);
            __syncthreads();
            float p2 = b2[j];
#pragma unroll 8
            for (int i = 0; i < 64; ++i) p2 += h1s[lp * 64 + i] * w2[i * 64 + j];
            const float a = sinf(f * p2);
            const unsigned hi = pk2(a, 0.f) & 0xffffu; const unsigned lo = pk2(a - bf_lo(hi), 0.f) & 0xffffu;
            bf16* r0 = a2s + (size_t)l * 256; r0[j] = (bf16)hi; r0[64 + j] = (bf16)hi; r0[128 + j] = (bf16)lo; r0[192 + j] = 0;
            bf16* r1 = a2rs + (size_t)((SEQ - l) & (SEQ - 1)) * 256;
            if (l >= 1) { r1[j] = (bf16)hi; r1[64 + j] = (bf16)hi; r1[128 + j] = (bf16)lo; r1[192 + j] = 0; } else { r1[j] = 0; r1[64 + j] = 0; r1[128 + j] = 0; r1[192 + j] = 0; }
        }
        const float* w3 = arg_in(21); bf16* w3s = WSP(bf16, WS_W3S);
        for (int it = F.vcu * 512 + F.tid; it < 8192 * 8; it += F.G * 512) {
            const int j8 = it >> 13, r = it & 8191;
            const int dir = r >> 12, o = (r >> 11) & 1, d = r & 2047; const float* src = w3 + o * 4096 + dir * 2048 + d; bf16* dst = w3s + (size_t)r * 256;
            unsigned h[8], lw[8];
#pragma unroll
            for (int q = 0; q < 8; ++q) { const float v = src[(size_t)(j8 * 8 + q) * 8192]; h[q] = pk2(v, 0.f) & 0xffffu; lw[q] = pk2(v - bf_lo(h[q]), 0.f) & 0xffffu; }
            const v4u H = {h[0] | (h[1] << 16), h[2] | (h[3] << 16), h[4] | (h[5] << 16), h[6] | (h[7] << 16)}, Lw = {lw[0] | (lw[1] << 16), lw[2] | (lw[3] << 16), lw[4] | (lw[5] << 16), lw[6] | (lw[7] << 16)};
            *(v4u*)(dst + j8 * 8) = H; *(v4u*)(dst + 64 + j8 * 8) = Lw; *(v4u*)(dst + 128 + j8 * 8) = H; *(v4u*)(dst + 192 + j8 * 8) = (v4u){0u, 0u, 0u, 0u};
        }
    }
#endif
#ifndef NO_PD
    {
        f32x2* cs = WSP(f32x2, WS_CS);
        for (int i = F.vcu * 512 + F.tid; i < SEQ * 32; i += F.G * 512) { const int l = i >> 5, q = i & 31; const float pos = (float)((q < 16) ? (l >> 6) : (l & 63));
            const float inv = powf(10000.0f, -(float)(q & 15) / 16.0f); const float ang = pos * inv; cs[i] = (f32x2){cosf(ang), sinf(ang)}; }
        f32x2* tw = WSP(f32x2, WS_TW);
        for (int i = F.vcu * 512 + F.tid; i < 8192; i += F.G * 512) { float s, c; if (i < 4096) sincospif((float)i / 2048.0f, &s, &c); else sincospif((float)(i - 4096) / 4096.0f, &s, &c); tw[i] = (f32x2){c, -s}; }
    }
#endif
}

__device__ __forceinline__ void norm_store(const f32x4 (&v)[8], float rstd, const float* g, const float* shift, const float* scale, bf16* orow, int lane) {
#pragma unroll
    for (int j = 0; j < 8; ++j) { const int c = 4 * (64 * j + lane); const f32x4 g4 = *(const f32x4*)(g + c), sh = *(const f32x4*)(shift + c), sc = *(const f32x4*)(scale + c);
        const f32x4 y = v[j] * rstd * g4 * (1.0f + sc) + sh; v2u o; o.x = pk2(y[0], y[1]); o.y = pk2(y[2], y[3]); *(v2u*)(orow + c) = o; }
}
__device__ __forceinline__ void p1_norm0(Frame& F) {
    const int lane = opq(F.tid) & 63;
    const int gw = F.vcu * NWAVES + F.wave, NGW = F.G * NWAVES;
    const float* mod = WSP(float, WS_MOD); bf16* H = WSP(bf16, WS_H); const float* xin = arg_in(0); const float* cin = arg_in(2); const float* ng = arg_in(6);
    for (int row = gw; row < MT; row += NGW) {
        const int b = row >= LT ? 1 : 0, r = row - b * LT; const bool lat = r < SEQ;
        const float* xr = lat ? xin + ((size_t)b * SEQ + r) * DM : cin + ((size_t)b * CTXL + (r - SEQ)) * DM;
        const float* mr = mod + (size_t)(lat ? b : 2) * 6 * DM;
        f32x4 v[8]; float s = 0.f;
#pragma unroll
        for (int j = 0; j < 8; ++j) { v[j] = __builtin_nontemporal_load((const f32x4*)(xr + 4 * (64 * j + lane))); s += (v[j][0] * v[j][0] + v[j][1] * v[j][1]) + (v[j][2] * v[j][2] + v[j][3] * v[j][3]); }
        const float rstd = 1.0f / sqrtf(wave_sum(s) * (1.0f / DM) + EPS);
        norm_store(v, rstd, ng, mr, mr + DM, H + (size_t)row * DM, lane);
    }
}
__device__ __forceinline__ void p3_latent(Frame& F) {
    const int lane = opq(F.tid) & 63;
    const int gw = F.vcu * NWAVES + F.wave, NGW = F.G * NWAVES;
    const float* proj = WSP(float, WS_PROJ); bf16* cqn = WSP(bf16, WS_CQN); bf16* ckvn = WSP(bf16, WS_CKVN); bf16* kro = WSP(bf16, WS_KROPE); const f32x2* cs = WSP(f32x2, WS_CS);
    const float* gq = arg_in(9); const float* gkv = arg_in(10);
    for (int row = gw; row < MT; row += NGW) {
        const float* pr = proj + (size_t)row * INPAD; const int l = row % LT;
        const f32x4 q0 = *(const f32x4*)(pr + 4 * lane), q1 = *(const f32x4*)(pr + 256 + 4 * lane), kv = *(const f32x4*)(pr + 512 + 4 * lane);
        float sq = (q0[0] * q0[0] + q0[1] * q0[1]) + (q0[2] * q0[2] + q0[3] * q0[3]) + (q1[0] * q1[0] + q1[1] * q1[1]) + (q1[2] * q1[2] + q1[3] * q1[3]);
        float sk = (kv[0] * kv[0] + kv[1] * kv[1]) + (kv[2] * kv[2] + kv[3] * kv[3]);
        const float rq = 1.0f / sqrtf(wave_sum(sq) * (1.0f / QRANK) + EPS), rk = 1.0f / sqrtf(wave_sum(sk) * (1.0f / KVRANK) + EPS);
        { const f32x4 g0 = *(const f32x4*)(gq + 4 * lane), g1 = *(const f32x4*)(gq + 256 + 4 * lane), g2 = *(const f32x4*)(gkv + 4 * lane);
          const f32x4 y0 = q0 * rq * g0, y1 = q1 * rq * g1, y2 = kv * rk * g2;
          v2u o; o.x = pk2(y0[0], y0[1]); o.y = pk2(y0[2], y0[3]); *(v2u*)(cqn + (size_t)row * QRANK + 4 * lane) = o;
          o.x = pk2(y1[0], y1[1]); o.y = pk2(y1[2], y1[3]); *(v2u*)(cqn + (size_t)row * QRANK + 256 + 4 * lane) = o;
          o.x = pk2(y2[0], y2[1]); o.y = pk2(y2[2], y2[3]); *(v2u*)(ckvn + (size_t)row * KVRANK + 4 * lane) = o; }
        if (lane < 32) { const float x1 = pr[768 + lane], x2 = pr[800 + lane]; float o1 = x1, o2 = x2;
            if (l < SEQ) { const f32x2 c = cs[(size_t)l * 32 + lane]; o1 = x1 * c.x - x2 * c.y; o2 = x2 * c.x + x1 * c.y; }
            ((unsigned*)(kro + (size_t)row * 64))[lane] = pk2(o1, o2); }
    }
}
__device__ __forceinline__ void p8_norm_router(Frame& F, int layer) {
    const int lane = opq(F.tid) & 63;
    const int gw = F.vcu * NWAVES + F.wave, NGW = F.G * NWAVES;
    const float* X = WSP(float, WS_X1); bf16* H = WSP(bf16, WS_H); float* aff = WSP(float, WS_AFF);
    const float* mod = WSP(float, WS_MOD) + (size_t)layer * 3 * 6 * DM; const float* g = arg_in(6) + (size_t)(layer * 2 + 1) * DM;
    LAS float* wr = (LAS float*)F.lds;
    __syncthreads();
    { const float* W = arg_in(26) + (size_t)layer * DM * NE;
      for (int i = F.tid; i < DM * NE / 4; i += 512) { const int c = i >> 2, q = i & 3; *(LAS f32x4*)(wr + c * 16 + (c >> 2) * 4 + q * 4) = *(const f32x4*)(W + (size_t)i * 4); } }
    __syncthreads();
    for (int row = gw; row < MX; row += NGW) {
        const int b = row >> 12, t = row & 4095; const float* xr = X + (size_t)row * DM; const float* shift = mod + (size_t)b * 6 * DM + 3 * DM; const float* scale = shift + DM;
        f32x4 v[8]; float s = 0.f;
#pragma unroll
        for (int j = 0; j < 8; ++j) { v[j] = *(const f32x4*)(xr + 4 * (64 * j + lane)); s += (v[j][0] * v[j][0] + v[j][1] * v[j][1]) + (v[j][2] * v[j][2] + v[j][3] * v[j][3]); }
        const float rstd = 1.0f / sqrtf(wave_sum(s) * (1.0f / DM) + EPS);
        f32x4 lg[4] = {{0.f, 0.f, 0.f, 0.f}, {0.f, 0.f, 0.f, 0.f}, {0.f, 0.f, 0.f, 0.f}, {0.f, 0.f, 0.f, 0.f}};
#pragma unroll
        for (int j = 0; j < 8; ++j) { const int c = 4 * (64 * j + lane); const f32x4 g4 = *(const f32x4*)(g + c), sh = *(const f32x4*)(shift + c), sc = *(const f32x4*)(scale + c);
            const f32x4 y = v[j] * rstd * g4 * (1.0f + sc) + sh; v2u o; o.x = pk2(y[0], y[1]); o.y = pk2(y[2], y[3]); *(v2u*)(H + (size_t)row * DM + c) = o;
            const LAS float* wp = wr + c * 16 + (c >> 2) * 4;
#pragma unroll
            for (int q = 0; q < 4; ++q) {
#pragma unroll
                for (int e4 = 0; e4 < 4; ++e4) lg[e4] += y[q] * *(const LAS f32x4*)(wp + q * 16 + e4 * 4); } }
        float lv[16];
#pragma unroll
        for (int e = 0; e < 16; ++e) lv[e] = wave_sum(lg[e >> 2][e & 3]);
        float mx = lv[0];
#pragma unroll
        for (int e = 1; e < 16; ++e) mx = fmaxf(mx, lv[e]);
        float den = 0.f;
#pragma unroll
        for (int e = 0; e < 16; ++e) { lv[e] = __expf(lv[e] - mx); den += lv[e]; }
        float mine = 0.f;
#pragma unroll
        for (int e = 0; e < 16; ++e) mine = (lane == e) ? lv[e] : mine;
        if (lane < 16) aff[((size_t)b * NE + lane) * SEQ + t] = mine / den;
    }
    __syncthreads();
}
__device__ __forceinline__ void p9_select_gather(Frame& F) {
    const int lane = opq(F.tid) & 63;
    const float* aff = WSP(float, WS_AFF); int* tok = WSP(int, WS_TOK); const bf16* H = WSP(bf16, WS_H); bf16* XG = WSP(bf16, WS_XG);
    LAS int* red = (LAS int*)F.lds;
    LAS int* sel = (LAS int*)(F.lds + 256);
    for (int un = F.vcu; un < NB * NE * 8; un += F.G) {
        const int be = un >> 3, part = un & 7, b = be >> 4, e = be & 15;
        const float* ar = aff + (size_t)be * SEQ + 8 * F.tid;
        const f32x4 a0 = *(const f32x4*)ar, a1 = *(const f32x4*)(ar + 4);
        unsigned key[8] = {__float_as_uint(a0[0]), __float_as_uint(a0[1]), __float_as_uint(a0[2]), __float_as_uint(a0[3]), __float_as_uint(a1[0]), __float_as_uint(a1[1]), __float_as_uint(a1[2]), __float_as_uint(a1[3])};
        __syncthreads();
        unsigned prefix = 0u;
        for (int bit = 30; bit >= 0; --bit) {
            const unsigned cand = prefix | (1u << bit); int c = 0;
#pragma unroll
            for (int i = 0; i < 8; ++i) c += (key[i] >= cand) ? 1 : 0;
            c = wave_sum_i(c);
            LAS int* slot = red + (bit & 1) * 8;
            if (lane == 0) slot[F.wave] = c;
            __syncthreads();
            int tot = 0;
#pragma unroll
            for (int w = 0; w < 8; ++w) tot += slot[w];
            if (tot >= CAP) prefix = cand;
        }
        int cgt = 0, ceq = 0;
#pragma unroll
        for (int i = 0; i < 8; ++i) { cgt += (key[i] > prefix) ? 1 : 0; ceq += (key[i] == prefix) ? 1 : 0; }
        int pk = (ceq << 16) | cgt, inc = pk;
#pragma unroll
        for (int o = 1; o < 64; o <<= 1) { const int y = __shfl_up(inc, o); if (lane >= o) inc += y; }
        __syncthreads();
        if (lane == 63) red[16 + F.wave] = inc;
        __syncthreads();
        int wpre = 0, total = 0;
#pragma unroll
        for (int w = 0; w < 8; ++w) { const int x = red[16 + w]; if (w < F.wave) wpre += x; total += x; }
        const int exc = wpre + inc - pk;
        const int need = CAP - (total & 0xffff);
        int eqb = exc >> 16, gtb = exc & 0xffff;
        int slotv[8];
#pragma unroll
        for (int i = 0; i < 8; ++i) { const bool gt = key[i] > prefix, eq = key[i] == prefix; const bool s = gt || (eq && eqb < need);
            const int before = gtb + (eqb < need ? eqb : need);
            slotv[i] = s ? before : -1; gtb += gt ? 1 : 0; eqb += eq ? 1 : 0; }
#pragma unroll
        for (int i = 0; i < 8; ++i) if (slotv[i] >= 0) sel[slotv[i]] = 8 * F.tid + i;
        if (part == 0) { int* tr = tok + (size_t)be * SEQ + 8 * F.tid; *(int4*)tr = make_int4(slotv[0], slotv[1], slotv[2], slotv[3]); *(int4*)(tr + 4) = make_int4(slotv[4], slotv[5], slotv[6], slotv[7]); }
        __syncthreads();
        if (part == 0) WSP(int, WS_SELROW)[e * 1024 + b * CAP + F.tid] = b * SEQ + sel[F.tid];
        if (F.G != 256) { v4u rr[8][4];
#pragma unroll
        for (int i = 0; i < 8; ++i) { const int sl = part * 64 + F.wave * 8 + i; const int t = sel[sl];
            const v4u* src = (const v4u*)(H + ((size_t)b * SEQ + t) * DM) + lane;
#pragma unroll
            for (int q = 0; q < 4; ++q) rr[i][q] = src[64 * q]; }
#pragma unroll
        for (int i = 0; i < 8; ++i) { const int sl = part * 64 + F.wave * 8 + i; v4u* dst = (v4u*)(XG + ((size_t)e * 1024 + b * CAP + sl) * DM) + lane;
#pragma unroll
            for (int q = 0; q < 4; ++q) dst[64 * q] = rr[i][q]; } }
        __syncthreads();
    }
}
template <bool FINAL>
__device__ __forceinline__ void p12_combine_norm(Frame& F, int layer) {
    const int lane = opq(F.tid) & 63;
    const int gw = F.vcu * NWAVES + F.wave, NGW = F.G * NWAVES;
    float* X = WSP(float, WS_X1); bf16* H = WSP(bf16, WS_H); const float* aff = WSP(float, WS_AFF); const int* tok = WSP(int, WS_TOK); const bf16* Y = WSP(bf16, WS_Y);
    const float* modl = WSP(float, WS_MOD) + (size_t)layer * 3 * 6 * DM; const float* gfin = FINAL ? arg_in(7) : arg_in(6) + (size_t)((layer + 1) * 2) * DM;
    for (int row = gw; row < MX; row += NGW) {
        const int b = row >> 12, t = row & 4095; float* xr = X + (size_t)row * DM; const float* g5 = modl + (size_t)b * 6 * DM + 5 * DM;
        f32x4 v[8], acc[8];
#pragma unroll
        for (int j = 0; j < 8; ++j) { v[j] = *(const f32x4*)(xr + 4 * (64 * j + lane)); acc[j] = (f32x4){0.f, 0.f, 0.f, 0.f}; }
        int sv = -1; float av = 0.f;
        if (lane < 16) { sv = tok[((size_t)b * NE + lane) * SEQ + t]; av = aff[((size_t)b * NE + lane) * SEQ + t]; }
#pragma unroll
        for (int e = 0; e < 16; ++e) { const int s = __builtin_amdgcn_readlane(sv, e); const float a = __builtin_bit_cast(float, __builtin_amdgcn_readlane(__builtin_bit_cast(int, av), e));
            if (s >= 0) { const bf16* yr = Y + ((size_t)e * 1024 + b * CAP + s) * DM;
#pragma unroll
                for (int j = 0; j < 8; ++j) { const v2u w = *(const v2u*)(yr + 4 * (64 * j + lane)); acc[j] += a * (f32x4){bf_lo(w.x), bf_hi(w.x), bf_lo(w.y), bf_hi(w.y)}; } } }
        float s2 = 0.f;
#pragma unroll
        for (int j = 0; j < 8; ++j) { const f32x4 g4 = *(const f32x4*)(g5 + 4 * (64 * j + lane)); v[j] += g4 * acc[j]; s2 += (v[j][0] * v[j][0] + v[j][1] * v[j][1]) + (v[j][2] * v[j][2] + v[j][3] * v[j][3]); }
        const float rstd = 1.0f / sqrtf(wave_sum(s2) * (1.0f / DM) + EPS);
        if constexpr (FINAL) {
#pragma unroll
            for (int j = 0; j < 8; ++j) { const int c = 4 * (64 * j + lane); __builtin_nontemporal_store(v[j] * rstd * *(const f32x4*)(gfin + c), (f32x4*)(F.out + (size_t)row * DM + c)); }
        } else {
#pragma unroll
            for (int j = 0; j < 8; ++j) *(f32x4*)(xr + 4 * (64 * j + lane)) = v[j];
            const float* m1 = WSP(float, WS_MOD) + (size_t)(layer + 1) * 3 * 6 * DM + (size_t)b * 6 * DM;
            norm_store(v, rstd, gfin, m1, m1 + DM, H + (size_t)row * DM, lane);
        }
    }
}
__device__ __forceinline__ void p15_transpose(Frame& F) {
    const int lane = opq(F.tid) & 63;
    const int gw = F.vcu * NWAVES + F.wave, NGW = F.G * NWAVES;
    const bf16* ZT = WSP(bf16, WS_ZT); bf16* Z = WSP(bf16, WS_Z);
    LAS bf16* scr = (LAS bf16*)(F.lds + F.wave * 8704);
    for (int tl = gw; tl < (DM / 64) * (MX / 64); tl += NGW) {
        const int dt = tl & 31, tt = tl >> 5;
#pragma unroll
        for (int i = 0; i < 8; ++i) { const int d = 8 * i + (lane >> 3); const v4u w = *(const v4u*)(ZT + (size_t)(dt * 64 + d) * MX + tt * 64 + (lane & 7) * 8);
            LAS bf16* p = scr + d * 68 + (lane & 7) * 8; *(LAS v2u*)p = (v2u){w.x, w.y}; *(LAS v2u*)(p + 4) = (v2u){w.z, w.w}; }
        LDS_WAIT(); asm volatile("" ::: "memory");
#pragma unroll
        for (int i = 0; i < 8; ++i) { const int tk = 8 * i + (lane >> 3), d0 = (lane & 7) * 8; unsigned short h[8];
#pragma unroll
            for (int q = 0; q < 8; ++q) h[q] = scr[(d0 + q) * 68 + tk];
            v4u o; o.x = h[0] | ((unsigned)h[1] << 16); o.y = h[2] | ((unsigned)h[3] << 16); o.z = h[4] | ((unsigned)h[5] << 16); o.w = h[6] | ((unsigned)h[7] << 16);
            *(v4u*)(Z + (size_t)(tt * 64 + tk) * DM + dt * 64 + d0) = o; }
        LDS_WAIT(); asm volatile("" ::: "memory");
    }
}

namespace att {
constexpr int NW = 8, QBLK = 32, KVBLK = 64, KROW = 384  ;
constexpr float SCALE = 0.07216878364870322f;
constexpr float THR = 8.f;
#ifndef ATT_SDEPTH
#define ATT_SDEPTH 1
#endif
constexpr int SDEPTH = ATT_SDEPTH;
constexpr int SHM_V = KVBLK * 128 * 2, SHM_K = KVBLK * KROW, SHM_QR = 2 * SHM_V + 2 * SHM_K + NW * 64 * 4  , SHM_ATTN = SHM_QR + NW * 4096;
#define KSWZ(row, colB) ((row) * 384 + ((colB) ^ ((((row) ^ (((row) >> 3) & 3)) & 7) << 4)))
#define SBAR() __builtin_amdgcn_sched_barrier(0)
__device__ __forceinline__ int crow(int r, int hi) { return (r & 3) + 8 * (r >> 2) + 4 * hi; }
__device__ __forceinline__ void partialSM(f32x16& p0, f32x16& p1, float& m_reg, float& mn, float& alpha) {
  constexpr float C = SCALE * 1.4426950408889634f;
  float pmax = p0[0];
#pragma unroll
  for (int r = 1; r < 16; ++r) pmax = fmaxf(pmax, p0[r]);
#pragma unroll
  for (int r = 0; r < 16; ++r) pmax = fmaxf(pmax, p1[r]);
  { auto rr = __builtin_amdgcn_permlane32_swap(__float_as_uint(pmax), __float_as_uint(pmax), false, false);
    pmax = fmaxf(__uint_as_float(rr[0]), __uint_as_float(rr[1])); }
  if (__builtin_expect(__all(pmax - m_reg <= THR / SCALE), 1)) { mn = m_reg; alpha = 1.f; }
  else { mn = fmaxf(m_reg, pmax); alpha = __builtin_amdgcn_exp2f((m_reg - mn) * C); m_reg = mn; }
  const float mnC = -mn * C;
#pragma unroll
  for (int r = 0; r < 16; ++r) p0[r] = fmaf(p0[r], C, mnC);
#pragma unroll
  for (int r = 0; r < 16; ++r) p1[r] = fmaf(p1[r], C, mnC);
#pragma unroll
  for (int r = 0; r < 16; ++r) p0[r] = __builtin_amdgcn_exp2f(p0[r]);
}
__device__ __forceinline__ void finishSM(f32x16& p0, f32x16& p1, float alpha, float& l_reg, bf16x8& pa0, bf16x8& pa1, bf16x8& pa2, bf16x8& pa3) {
#pragma unroll
  for (int r = 0; r < 16; ++r) p1[r] = __builtin_amdgcn_exp2f(p1[r]);
  float ps = 0;
#pragma unroll
  for (int r = 0; r < 16; ++r) ps += p0[r];
#pragma unroll
  for (int r = 0; r < 16; ++r) ps += p1[r];
  { auto rr = __builtin_amdgcn_permlane32_swap(__float_as_uint(ps), __float_as_uint(ps), false, false);
    ps = __uint_as_float(rr[0]) + __uint_as_float(rr[1]); }
  l_reg = l_reg * alpha + ps;
#define PK4(P, BASE, OUT) do { unsigned a0 = pk2(P[BASE + 0], P[BASE + 1]), a1 = pk2(P[BASE + 2], P[BASE + 3]);   \
    unsigned b0 = pk2(P[BASE + 4], P[BASE + 5]), b1 = pk2(P[BASE + 6], P[BASE + 7]);                              \
    auto r0 = __builtin_amdgcn_permlane32_swap(a0, b0, false, false); auto r1 = __builtin_amdgcn_permlane32_swap(a1, b1, false, false); \
    v4u w = {r0[0], r1[0], r0[1], r1[1]}; OUT = *reinterpret_cast<bf16x8*>(&w); } while (0)
  PK4(p0, 0, pa0); PK4(p0, 8, pa1); PK4(p1, 0, pa2); PK4(p1, 8, pa3);
#undef PK4
}
__device__ __forceinline__ void qkt(f32x16& p0, f32x16& p1, const char* Ks, const bf16x8* qr, const char* qL, const int (&kb)[4]) {
  p0 = f32x16{}; p1 = f32x16{};
#pragma unroll
  for (int d0 = 0; d0 < 12; ++d0) {
    const bf16x8 qf = d0 < 8 ? qr[d0 < 8 ? d0 : 0] : *reinterpret_cast<const bf16x8*>(qL + (d0 - 8) * 1024);
    const bf16x8 b0 = *reinterpret_cast<const bf16x8*>(Ks + kb[d0 & 3] + (d0 >> 2) * 128);
    const bf16x8 b1 = *reinterpret_cast<const bf16x8*>(Ks + kb[d0 & 3] + (d0 >> 2) * 128 + 32 * 384);
    p0 = __builtin_amdgcn_mfma_f32_32x32x16_bf16(b0, qf, p0, 0, 0, 0);
    p1 = __builtin_amdgcn_mfma_f32_32x32x16_bf16(b1, qf, p1, 0, 0, 0); }
}
__device__ __forceinline__ int v_st(int k, int c) { const int kk = (k & ~0xC) | ((k & 4) << 1) | ((k & 8) >> 1); return ((kk >> 3) * 4 + (c >> 5)) * 512 + ((kk & 7) * 32 + (c & 31)) * 2; }
__device__ __forceinline__ int v_rd_base(int lane) { return ((lane & 3) << 3) | (((lane >> 2) & 3) << 6) | (((lane >> 4) & 1) << 5) | (((lane >> 5) & 1) << 8); }
constexpr int v_rd_off(int d0, int ks, int half) { return d0 * 512 + ks * 4096 + half * 2048; }
template <int OFF> __device__ __forceinline__ s16x4 tr_read(int vb) {
  s16x4 r; asm volatile("ds_read_b64_tr_b16 %0, %1 offset:%2" : "=&v"(r) : "v"(vb), "i"(OFF) : "memory"); return r;
}
template <int D0> __device__ __forceinline__ void pv_one(f32x16& od, int vb, bf16x8 pa0, bf16x8 pa1, bf16x8 pa2, bf16x8 pa3) {
  const s16x4 l0 = tr_read<v_rd_off(D0, 0, 0)>(vb), h0 = tr_read<v_rd_off(D0, 0, 1)>(vb), l1 = tr_read<v_rd_off(D0, 1, 0)>(vb), h1 = tr_read<v_rd_off(D0, 1, 1)>(vb);
  const s16x4 l2 = tr_read<v_rd_off(D0, 2, 0)>(vb), h2 = tr_read<v_rd_off(D0, 2, 1)>(vb), l3 = tr_read<v_rd_off(D0, 3, 0)>(vb), h3 = tr_read<v_rd_off(D0, 3, 1)>(vb);
  asm volatile("s_waitcnt lgkmcnt(0)" ::: "memory"); SBAR();
#define PKV(L, H) (bf16x8){L[0], L[1], L[2], L[3], H[0], H[1], H[2], H[3]}
  od = __builtin_amdgcn_mfma_f32_32x32x16_bf16(pa0, PKV(l0, h0), od, 0, 0, 0);
  od = __builtin_amdgcn_mfma_f32_32x32x16_bf16(pa1, PKV(l1, h1), od, 0, 0, 0);
  od = __builtin_amdgcn_mfma_f32_32x32x16_bf16(pa2, PKV(l2, h2), od, 0, 0, 0);
  od = __builtin_amdgcn_mfma_f32_32x32x16_bf16(pa3, PKV(l3, h3), od, 0, 0, 0);
#undef PKV
}
__device__ __forceinline__ void pv_d0(f32x16* o, int vb, bf16x8 pa0, bf16x8 pa1, bf16x8 pa2, bf16x8 pa3) {
  pv_one<0>(o[0], vb, pa0, pa1, pa2, pa3); pv_one<1>(o[1], vb, pa0, pa1, pa2, pa3); pv_one<2>(o[2], vb, pa0, pa1, pa2, pa3); pv_one<3>(o[3], vb, pa0, pa1, pa2, pa3);
}
__device__ __forceinline__ void attn_body(const bf16* __restrict__ Qb, const bf16* __restrict__ Kn, const bf16* __restrict__ Kr, const bf16* __restrict__ Vh, bf16* __restrict__ Ob, int seq, char* lds) {
  constexpr int LDQ = 3072, LDK = 4096, LDR = 64, LDO = 2048;
  const int tid = threadIdx.x, wid = tid >> 6, lane = tid & 63, r32 = lane & 31, hi = lane >> 5;
  char* V_lds = lds; char* K_lds = lds + 2 * SHM_V;
  float* ws = (float*)(lds + 2 * SHM_V + 2 * SHM_K) + wid * 64; float* li_l = ws; float* al_l = ws + 32;
  float m_reg = -1e30f, l_reg = 0; f32x16 o[4] = {}; bf16x8 qr[8];
  char* qL = lds + SHM_QR + wid * 4096 + lane * 16;
  const bf16* Qw = Qb + (unsigned)((wid * QBLK + r32) * LDQ + hi * 8);
#pragma unroll
  for (int d0 = 0; d0 < 8; ++d0) qr[d0] = *reinterpret_cast<const bf16x8*>(Qw + d0 * 16);
#pragma unroll
  for (int d0 = 8; d0 < 12; ++d0) *reinterpret_cast<bf16x8*>(qL + (d0 - 8) * 1024) = *reinterpret_cast<const bf16x8*>(Qw + d0 * 16);
  const int sr = tid >> 4, sc = (tid & 15) * 8, vst0 = v_st(sr, sc), vst1 = v_st(32 + sr, sc);
  const int rr = tid >> 3, rc = (tid & 7) * 8;
  const unsigned o_s0 = (unsigned)(sr * LDK + sc), o_s1 = (unsigned)((32 + sr) * LDK + sc), o_r = (unsigned)(rr * LDR + rc);
  int kb[4];
#pragma unroll
  for (int q = 0; q < 4; ++q) kb[q] = KSWZ(r32, q * 32 + hi * 16);
  const int vb0 = (int)(uintptr_t)V_lds + v_rd_base(lane);
  struct { bf16x8 vs0, vs1, ks0, ks1, kr0; } sr_[SDEPTH];
#define SLOAD(i, k0) do { const bf16* Vt = Vh + (size_t)(k0) * LDK; const bf16* Kt = Kn + (size_t)(k0) * LDK; const bf16* Rt = Kr + (size_t)(k0) * LDR; \
    sr_[i].vs0 = *(const bf16x8*)(Vt + o_s0); sr_[i].vs1 = *(const bf16x8*)(Vt + o_s1); sr_[i].ks0 = *(const bf16x8*)(Kt + o_s0); sr_[i].ks1 = *(const bf16x8*)(Kt + o_s1); \
    sr_[i].kr0 = *(const bf16x8*)(Rt + o_r); } while (0)
#define SWRITE(b, i) do { *(bf16x8*)(V_lds + (b) * SHM_V + vst0) = sr_[i].vs0; *(bf16x8*)(V_lds + (b) * SHM_V + vst1) = sr_[i].vs1; const int kc = sc * 2;               \
    *(bf16x8*)(K_lds + (b) * SHM_K + KSWZ(sr, kc)) = sr_[i].ks0; *(bf16x8*)(K_lds + (b) * SHM_K + KSWZ(32 + sr, kc)) = sr_[i].ks1;                       \
    *(bf16x8*)(K_lds + (b) * SHM_K + KSWZ(rr, 256 + rc * 2)) = sr_[i].kr0; } while (0)
#define SWAIT() do { if constexpr (SDEPTH == 2) asm volatile("s_waitcnt vmcnt(5)" ::: "memory"); else asm volatile("s_waitcnt vmcnt(0)" ::: "memory"); } while (0)
#define RESC(a) do { if (__any((a) < 1.f)) { if (hi == 0) al_l[r32] = (a); asm volatile("s_waitcnt lgkmcnt(0)" ::: "memory"); \
    _Pragma("unroll") for (int d = 0; d < 4; ++d) _Pragma("unroll") for (int r = 0; r < 16; ++r) o[d][r] *= al_l[crow(r, hi)]; } } while (0)
  f32x16 pA0, pA1, pB0, pB1; float mnA, mnB, alA, alB; bf16x8 pa0, pa1, pa2, pa3; const int NT = seq / KVBLK;
  constexpr int SE = 0, SO = SDEPTH - 1;
  SLOAD(SE, 0); asm volatile("s_waitcnt vmcnt(0)" ::: "memory"); SWRITE(0, SE); __syncthreads();
  qkt(pA0, pA1, K_lds, qr, qL, kb); partialSM(pA0, pA1, m_reg, mnA, alA);
  SLOAD(SO, KVBLK); if constexpr (SDEPTH == 2) { if (2 < NT) SLOAD(SE, 2 * KVBLK); }
  SWAIT(); SWRITE(1, SO); __syncthreads();
  for (int j = 1; j + 1 < NT; j += 2) {
    SBAR(); qkt(pB0, pB1, K_lds + SHM_K, qr, qL, kb);
    finishSM(pA0, pA1, alA, l_reg, pa0, pa1, pa2, pa3); SBAR();
    SLOAD(SO, (j + SDEPTH) * KVBLK); SBAR();
    pv_d0(o, vb0, pa0, pa1, pa2, pa3); partialSM(pB0, pB1, m_reg, mnB, alB);
    __syncthreads(); SWAIT(); SWRITE(0, SE);
    RESC(alB); __syncthreads();
    SBAR(); qkt(pA0, pA1, K_lds, qr, qL, kb);
    finishSM(pB0, pB1, alB, l_reg, pa0, pa1, pa2, pa3); SBAR();
    if (SDEPTH == 1 || j + 3 < NT) SLOAD(SE, (j + 1 + SDEPTH) * KVBLK); SBAR();
    pv_d0(o, vb0 + SHM_V, pa0, pa1, pa2, pa3); partialSM(pA0, pA1, m_reg, mnA, alA);
    __syncthreads(); SWAIT(); SWRITE(1, SO);
    RESC(alA); __syncthreads();
  }
  SBAR(); qkt(pB0, pB1, K_lds + SHM_K, qr, qL, kb);
  finishSM(pA0, pA1, alA, l_reg, pa0, pa1, pa2, pa3); SBAR();
  pv_d0(o, vb0, pa0, pa1, pa2, pa3); partialSM(pB0, pB1, m_reg, mnB, alB);
  __syncthreads(); RESC(alB);
  finishSM(pB0, pB1, alB, l_reg, pa0, pa1, pa2, pa3); SBAR();
  pv_d0(o, vb0 + SHM_V, pa0, pa1, pa2, pa3);
  if (hi == 0) li_l[r32] = l_reg; asm volatile("s_waitcnt lgkmcnt(0)" ::: "memory");
  float rli[16];
#pragma unroll
  for (int r = 0; r < 16; ++r) rli[r] = __builtin_amdgcn_rcpf(li_l[crow(r, hi)]);
  bf16* Ow = Ob + (size_t)(wid * QBLK) * LDO;
#pragma unroll
  for (int r = 0; r < 16; ++r) { const int orow = crow(r, hi);
#pragma unroll
    for (int d0 = 0; d0 < 4; ++d0) Ow[(unsigned)(orow * LDO + d0 * 32 + r32)] = (bf16)(pk2(o[d0][r] * rli[r], 0.f) & 0xffffu); }
#undef SLOAD
#undef SWRITE
#undef SWAIT
#undef RESC
}
}
__device__ __forceinline__ void p6_attention(Frame& F) {
    const bf16* Q = WSP(bf16, WS_Q); const bf16* KV = WSP(bf16, WS_KV); const bf16* KR = WSP(bf16, WS_KROPE); bf16* O = WSP(bf16, WS_O);
    const int cslot = (int)((blockIdx.x >> 3) % 3u);
    if (cslot == 0) convert_late(F);
    const int nun = NB * NH * (SEQ / 256);
    for (int i = 0; ; ++i) {
        int bh, qb;
        if (F.G == 256) { if (i >= 2) break; const int x = blockIdx.x & 7, j = blockIdx.x >> 3; bh = (i * 8 + x) * 2 + (j >> 4); qb = j & 15; }
        else { const int L = i * F.G + (int)blockIdx.x; if (L >= nun) break; bh = L >> 4; qb = L & 15; }
        const int b = bh >> 4, h = bh & 15;
        if (i == 1 && cslot == 1) convert_late(F);
        __syncthreads();
        att::attn_body(Q + ((size_t)b * LT + qb * 256) * QW + h * 192, KV + (size_t)b * LT * KVW + h * 256, KR + (size_t)b * LT * 64, KV + (size_t)b * LT * KVW + h * 256 + 128,
                       O + ((size_t)b * SEQ + qb * 256) * DM + h * 128, LT, (char*)F.ldsg);
    }
    __syncthreads();
    if (cslot == 2) convert_late(F);
}

namespace hy {
typedef float cpx __attribute__((ext_vector_type(2)));
__device__ __forceinline__ cpx cmul(cpx a, cpx b) { return (cpx){a.x * b.x - a.y * b.y, a.x * b.y + a.y * b.x}; }
__device__ __forceinline__ cpx cmulc(cpx a, cpx b) { return (cpx){a.x * b.x + a.y * b.y, a.y * b.x - a.x * b.y}; }
__device__ __forceinline__ float f_mul(float a, float b) { float r; asm("v_mul_f32 %0, %1, %2" : "=v"(r) : "v"(a), "v"(b)); return r; }
__device__ __forceinline__ float f_fma(float a, float b, float c) { float r; asm("v_fma_f32 %0, %1, %2, %3" : "=v"(r) : "v"(a), "v"(b), "v"(c)); return r; }
__device__ __forceinline__ float f_fms(float a, float b, float c) { float r; asm("v_fma_f32 %0, %1, %2, -%3" : "=v"(r) : "v"(a), "v"(b), "v"(c)); return r; }
__device__ __forceinline__ cpx cmul_s(cpx a, cpx b) { const float t = f_mul(a.y, b.y), u = f_mul(a.y, b.x); return (cpx){f_fms(a.x, b.x, t), f_fma(a.x, b.y, u)}; }
__device__ __forceinline__ cpx cmulc_s(cpx a, cpx b) { const float t = f_mul(a.y, b.y), u = f_mul(a.x, b.y); return (cpx){f_fma(a.x, b.x, t), f_fms(a.y, b.x, u)}; }
__device__ __forceinline__ cpx cadd(cpx a, cpx b) { return a + b; }
__device__ __forceinline__ cpx csub(cpx a, cpx b) { return a - b; }
template <int S> __device__ __forceinline__ cpx mul_i(cpx a) { return S < 0 ? (cpx){a.y, -a.x} : (cpx){-a.y, a.x}; }
template <int S> __device__ __forceinline__ void dft4(cpx& x0, cpx& x1, cpx& x2, cpx& x3) {
    const cpx t0 = cadd(x0, x2), t1 = csub(x0, x2), t2 = cadd(x1, x3), t3 = mul_i<S>(csub(x1, x3));
    x0 = cadd(t0, t2); x2 = csub(t0, t2); x1 = cadd(t1, t3); x3 = csub(t1, t3);
}
template <int S> __device__ __forceinline__ cpx tw16(cpx a, int m) {
    constexpr float C1 = 0.9238795325112867f, S1 = 0.3826834323650898f, R = 0.7071067811865476f;
    cpx w;
    switch (m) { case 0: return a; case 1: w = (cpx){C1, -S1}; break; case 2: w = (cpx){R, -R}; break; case 3: w = (cpx){S1, -C1}; break; case 4: w = (cpx){0.f, -1.f}; break; case 6: w = (cpx){-R, -R}; break; default: w = (cpx){-C1, S1}; break; }
    if (S > 0) w.y = -w.y;
    return cmul(a, w);
}
template <int S> __device__ __forceinline__ void dft16(cpx (&v)[16]) {
#pragma unroll
    for (int a = 0; a < 4; ++a) { dft4<S>(v[a], v[a + 4], v[a + 8], v[a + 12]);
#pragma unroll
        for (int d = 1; d < 4; ++d) v[a + 4 * d] = tw16<S>(v[a + 4 * d], a * d); }
#pragma unroll
    for (int d = 0; d < 4; ++d) dft4<S>(v[4 * d], v[4 * d + 1], v[4 * d + 2], v[4 * d + 3]);
}
__device__ __forceinline__ constexpr int SL(int k) { return 4 * (k & 3) + (k >> 2); }
template <int S> __device__ __forceinline__ void dft16p(cpx (&v)[16]) {
#pragma unroll
    for (int a = 0; a < 4; ++a) { dft4<S>(v[4 * a], v[4 * a + 1], v[4 * a + 2], v[4 * a + 3]);
#pragma unroll
        for (int d = 1; d < 4; ++d) v[4 * a + d] = tw16<S>(v[4 * a + d], a * d); }
#pragma unroll
    for (int d = 0; d < 4; ++d) dft4<S>(v[d], v[4 + d], v[8 + d], v[12 + d]);
}
__device__ __forceinline__ int PI(int i) { return i + (i >> 4); }
typedef LAS cpx* lbuf;
typedef const LAS cpx* ltab;
__device__ __forceinline__ cpx tw_lookup(ltab T, int m) { return cmul(T[64 + (m >> 6)], T[m & 63]); }
__device__ __forceinline__ void tw_powers(cpx b, cpx (&p)[16]) {
    p[0] = (cpx){1.f, 0.f}; p[1] = b; p[2] = cmul(b, b); p[3] = cmul(p[2], b); p[4] = cmul(p[2], p[2]); p[5] = cmul(p[4], b); p[6] = cmul(p[4], p[2]); p[7] = cmul(p[4], p[3]); p[8] = cmul(p[4], p[4]);
    p[9] = cmul(p[8], b); p[10] = cmul(p[8], p[2]); p[11] = cmul(p[8], p[3]); p[12] = cmul(p[8], p[4]); p[13] = cmul(p[8], p[5]); p[14] = cmul(p[8], p[6]); p[15] = cmul(p[8], p[7]);
}
struct Addr { int a1, a2, a3; };
__device__ __forceinline__ void fwd12(lbuf buf, Addr A, const cpx (&pw1)[16], cpx b2) {
    cpx v[16], pw2[16];
    { lbuf b = buf + A.a1;
#pragma unroll
      for (int n = 0; n < 16; ++n) v[n] = b[n * 272];
      dft16<-1>(v);
#pragma unroll
      for (int k = 0; k < 16; ++k) b[k * 272] = k ? cmul_s(v[SL(k)], pw1[k]) : v[SL(k)]; }
    __syncthreads();
    { lbuf b = buf + A.a2;
#pragma unroll
      for (int n = 0; n < 16; ++n) v[n] = b[n * 17];
      tw_powers(b2, pw2);
      dft16<-1>(v);
#pragma unroll
      for (int k = 0; k < 16; ++k) b[k * 17] = k ? cmul(v[SL(k)], pw2[k]) : v[SL(k)]; }
    __syncthreads();
}
__device__ __forceinline__ void inv21(lbuf buf, Addr A, const cpx (&pw1)[16], cpx b2) {
    cpx v[16], pw2[16];
    { lbuf b = buf + A.a2; tw_powers(b2, pw2);
#pragma unroll
      for (int k = 0; k < 16; ++k) { const cpx x = b[k * 17]; v[k] = k ? cmulc(x, pw2[k]) : x; }
      dft16<1>(v);
#pragma unroll
      for (int n = 0; n < 16; ++n) b[n * 17] = v[SL(n)]; }
    __syncthreads();
    { lbuf b = buf + A.a1;
#pragma unroll
      for (int k = 0; k < 16; ++k) { const cpx x = b[k * 272]; v[k] = k ? cmulc_s(x, pw1[k]) : x; }
      dft16<1>(v);
#pragma unroll
      for (int n = 0; n < 16; ++n) b[n * 272] = v[SL(n)]; }
    __syncthreads();
}
}

__device__ __forceinline__ void p14_hyena_conv(Frame& F) {
    const int lane = opq(F.tid) & 63;
    using namespace hy;
    lbuf bufX = (lbuf)F.lds; lbuf bufW = (lbuf)(F.lds + 69632);
    LAS float* red = (LAS float*)(F.lds + 139264);
    LAS cpx* tab = (LAS cpx*)(F.lds + 139264 + 64);
    const float* HF = WSP(float, WS_HF);
    const bf16* U = WSP(bf16, WS_U); bf16* ZT = WSP(bf16, WS_ZT);
    const float* b3 = arg_in(22); const float* cw = arg_in(15); const float* cb = arg_in(16); const float* skip = arg_in(24);
    __syncthreads();
    if (F.tid < 256) { const f32x2* twg = WSP(f32x2, WS_TW); const int q = F.tid >> 6, i = F.tid & 63; tab[F.tid] = twg[(q >> 1) * 4096 + ((q & 1) ? 64 * i : i)]; }
    __syncthreads();
    const int t0_ = F.tid, e = t0_ >> 8, j = t0_ & 255;
    cpx pw1[16];
    tw_powers(tw_lookup(tab, j), pw1); const cpx b2 = tw_lookup(tab, 16 * (j & 15));
    Addr A; A.a1 = j + (j >> 4); A.a2 = (j >> 4) * 272 + (j & 15); A.a3 = j * 17;
    const int k1 = j >> 4, k2 = j & 15; const bool special = (e == 0 && j == 0);
    const int ap = e ? (15 - k1) * 272 + (15 - k2) * 17 : (k1 ? (16 - k1) * 272 + (15 - k2) * 17 : (k2 ? (16 - k2) * 17 : 1));
    lbuf bx = bufX + e * 4352; lbuf bw = bufW + e * 4352;
#define HY_ISSUE(T, raw) do { const int ch = (T) * DM + d; \
        _Pragma("unroll") for (int b = 0; b < 2; ++b) { const bf16* pr = U + (size_t)ch * MX + b * SEQ + n0; raw.m[b] = *(const v4u*)pr; raw.l[b] = t > 0 ? pr[-1] : (bf16)0; raw.r[b] = t < 511 ? pr[8] : (bf16)0; } } while (0)
#define HY_CONV(T, raw, dst) do { const int ch = (T) * DM + d; const float w0 = cw[ch], w1 = cw[3 * DM + ch], w2 = cw[6 * DM + ch], bs = cb[ch]; \
        _Pragma("unroll") for (int b = 0; b < 2; ++b) { const v4u m = raw.m[b]; \
            const float p[10] = {bf1(raw.l[b]), bf_lo(m.x), bf_hi(m.x), bf_lo(m.y), bf_hi(m.y), bf_lo(m.z), bf_hi(m.z), bf_lo(m.w), bf_hi(m.w), bf1(raw.r[b])}; \
            _Pragma("unroll") for (int i = 0; i < 8; ++i) { const float uu = w0 * p[i] + w1 * p[i + 1] + w2 * p[i + 2] + bs; if (b == 0) dst[i].x = uu; else dst[i].y = uu; } } } while (0)
    struct Raw { v4u m[2]; bf16 l[2], r[2]; };
#define HY_TW8() cpx tw8[8]; { const cpx th = tab[192 + (t >> 3)]; _Pragma("unroll") for (int i = 0; i < 8; ++i) tw8[i] = cmul(th, tab[128 + 8 * (t & 7) + i]); }
#pragma unroll 1
    for (int d = F.vcu; d < DM; d += F.G) {
        const float sk0 = skip[d], sk1 = skip[DM + d];
        float rs0 = 0.f, rs1 = 0.f; cpx vv[8];
#pragma unroll 1
        for (int c = 0; c < 3; ++c) {
            int t = F.tid; asm volatile("" : "+v"(t));
            const int n0 = 8 * t, p0 = n0 + (t >> 1);
            lbuf bb = c ? bx : bw;
            if (c == 0) {
                __syncthreads();
                const float* h00 = HF + (size_t)d * SEQ + n0; const float* h10 = h00 + (size_t)2048 * SEQ; const float* h01 = h00 + (size_t)4096 * SEQ; const float* h11 = h01 + (size_t)2048 * SEQ;
                #define NTL(p) __builtin_nontemporal_load((const f32x4*)(p))
                const f32x4 a00 = NTL(h00), b00 = NTL(h00 + 4), a10 = NTL(h10), b10 = NTL(h10 + 4);
                const f32x4 a01 = NTL(h01), b01 = NTL(h01 + 4), a11 = NTL(h11), b11 = NTL(h11 + 4);
#undef NTL
                const float bb00 = b3[d], bb01 = b3[2048 + d], bb10 = b3[4096 + d], bb11 = b3[6144 + d];
                const float adel = 3.0701134573253944f + (float)d * ((15.350567286626972f - 3.0701134573253944f) / 2047.0f);
                float ss0 = 0.f, ss1 = 0.f; HY_TW8();
#pragma unroll
                for (int i = 0; i < 8; ++i) { const int n = n0 + i; const float df = __expf(-((float)n * (1.0f / 4096.0f)) * adel), db = __expf(-((float)(4096 - n) * (1.0f / 4096.0f)) * adel);
                    const float f00 = (i < 4 ? a00[i & 3] : b00[i & 3]) + bb00, f10 = (i < 4 ? a10[i & 3] : b10[i & 3]) + bb10, f01 = (i < 4 ? a01[i & 3] : b01[i & 3]) + bb01, f11 = (i < 4 ? a11[i & 3] : b11[i & 3]) + bb11;
                    const float a0 = f00 * df, a1 = f10 * df;
                    const float c0 = n ? f01 * db : 0.f, c1 = n ? f11 * db : 0.f;
                    ss0 += a0 * a0 + c0 * c0; ss1 += a1 * a1 + c1 * c1;
                    bufW[p0 + i] = (cpx){a0 + c0, a1 + c1};
                    bufW[4352 + p0 + i] = cmul((cpx){a0 - c0, a1 - c1}, tw8[i]); }
                ss0 = wave_sum(ss0); ss1 = wave_sum(ss1);
                if (lane == 0) { red[F.wave * 2] = ss0; red[F.wave * 2 + 1] = ss1; }
            } else if (c == 1) {
                Raw rv; HY_ISSUE(0, rv); HY_CONV(0, rv, vv); HY_TW8();
#pragma unroll
                for (int i = 0; i < 8; ++i) { bufX[p0 + i] = vv[i]; bufX[4352 + p0 + i] = cmul(vv[i], tw8[i]); }
            }
            __syncthreads();
            if (c == 0) {
#pragma unroll
                for (int w = 0; w < 8; ++w) { rs0 += red[w * 2]; rs1 += red[w * 2 + 1]; }
                rs0 = (1.0f / sqrtf(rs0 + EPS)) * (1.0f / 8192.0f); rs1 = (1.0f / sqrtf(rs1 + EPS)) * (1.0f / 8192.0f);
            }
            fwd12(bb, A, pw1, b2);
            cpx v[16];
            { lbuf q = bb + A.a3;
#pragma unroll
              for (int n = 0; n < 16; ++n) v[n] = q[n]; }
            dft16<-1>(v);
            if (c == 0) {
                lbuf q = bb + A.a3;
#pragma unroll
                for (int k = 0; k < 16; ++k) q[k] = v[SL(k)];
            } else {
                const float hs = 0.5f * (c == 1 ? rs0 : rs1); const bool o1 = c == 2;
                { lbuf bo = bw + A.a3; lbuf bp = bw + ap;
#pragma unroll
                  for (int k3 = 0; k3 < 16; ++k3) {
                    const cpx wf = bo[k3]; const cpx wp = (k3 == 0) ? bw[special ? ap - 1 : ap + 15] : bp[15 - k3];
                    const cpx K = o1 ? (cpx){(wf.y + wp.y) * hs, -(wf.x - wp.x) * hs} : (cpx){(wf.x + wp.x) * hs, (wf.y - wp.y) * hs};
                    v[SL(k3)] = cmul(v[SL(k3)], K); } }
                dft16p<1>(v);
                { lbuf q = bb + A.a3;
#pragma unroll
                  for (int n = 0; n < 16; ++n) q[n] = v[n]; }
                __syncthreads();
                inv21(bb, A, pw1, b2);
                if (c == 1) {
                    Raw r1; HY_ISSUE(1, r1); cpx x1c[8]; HY_CONV(1, r1, x1c); HY_TW8();
#pragma unroll
                    for (int i = 0; i < 8; ++i) { const cpx ye = bufX[p0 + i], yo = bufX[4352 + p0 + i]; const cpx y = cadd(ye, cmulc(yo, tw8[i]));
                        vv[i] = (cpx){x1c[i].x * (y.x + sk0 * vv[i].x), x1c[i].y * (y.y + sk0 * vv[i].y)};
                        bufX[p0 + i] = vv[i]; bufX[4352 + p0 + i] = cmul(vv[i], tw8[i]); }
                } else {
                    Raw r2; HY_ISSUE(2, r2); cpx x2c[8]; HY_CONV(2, r2, x2c); HY_TW8();
                    unsigned ob0[4], ob1[4];
#pragma unroll
                    for (int i = 0; i < 8; i += 2) { float z0[2], z1[2];
#pragma unroll
                        for (int q = 0; q < 2; ++q) { const cpx ye = bufX[p0 + i + q], yo = bufX[4352 + p0 + i + q]; const cpx y = cadd(ye, cmulc(yo, tw8[i + q]));
                            z0[q] = x2c[i + q].x * (y.x + sk1 * vv[i + q].x); z1[q] = x2c[i + q].y * (y.y + sk1 * vv[i + q].y); }
                        ob0[i >> 1] = pk2(z0[0], z0[1]); ob1[i >> 1] = pk2(z1[0], z1[1]); }
                    *(v4u*)(ZT + (size_t)d * MX + n0) = (v4u){ob0[0], ob0[1], ob0[2], ob0[3]};
                    *(v4u*)(ZT + (size_t)d * MX + SEQ + n0) = (v4u){ob1[0], ob1[1], ob1[2], ob1[3]};
                }
            }
        }
    }
    __syncthreads();
#undef HY_ISSUE
#undef HY_CONV
#undef HY_TW8
}

#ifndef MK_SINGLE
#define MK_SINGLE 1
#endif
struct Args { const float* in[30]; float* out; unsigned char* ws; int ph_lo, ph_hi; };
__global__ void __launch_bounds__(NWAVES * 64, 2) mk_fwd(Args args) {
    extern __shared__ __attribute__((aligned(16))) unsigned char lds[];
    Frame F;
    F.lds = (LAS unsigned char*)lds; F.ldsg = lds;
    F.tid = threadIdx.x; F.wave = __builtin_amdgcn_readfirstlane(F.tid >> 6);
    F.G = gridDim.x; { const int bx = blockIdx.x; F.vcu = (F.G % 8 == 0) ? (bx % 8) * (F.G / 8) + bx / 8 : bx; }
    F.out = args.out; F.ws = args.ws;
    volatile LAS unsigned* MISC = (volatile LAS unsigned*)(F.lds + MISC_OFF);
    if (F.tid < 32) MISC[F.tid] = 0u;
    __syncthreads();
    unsigned* ctl = (unsigned*)(F.ws + WS_CTL);
    XcdBarrier bar; bar.bar = ctl + CW_BAR; bar.x = 0; bar.st = nullptr;
    if (MK_SINGLE) bar = xcd_barrier_post(ctl + CW_BAR, MISC + 8);
    const int lo = args.ph_lo, hi = args.ph_hi;
#ifndef PH_MASK
#define PH_MASK 0x1fffff
#endif
#ifndef PROBE_DUP
#define PROBE_DUP 0
#endif
#define IN(k) (((PH_MASK >> (k)) & 1) && lo <= (k) && (k) < hi)
#define REP(k) for (int rep_ = 0; rep_ < (((PROBE_DUP >> (k)) & 1) ? 2 : 1); ++rep_)
#ifndef PROBE_XBAR
#define PROBE_XBAR 0
#endif
#define SEAM(k) do { if (MK_SINGLE && IN(k) && IN((k) + 1)) { xcd_barrier(bar); if (PROBE_XBAR) xcd_barrier(bar); } } while (0)
    using namespace pg8;
    const bf16_t* Hb = WSP(bf16_t, WS_H);
    float* mod = WSP(float, WS_MOD);

    if (IN(0)) REP(0) { p0_prologue(F); } SEAM(0);
    if (IN(1)) REP(1) { p1_norm0(F); } SEAM(1);
    if (IN(2)) REP(2) {
        Gemm g{Hb, WSP(bf16_t, WS_WIN), MT, INPAD, DM}; StaticOrder S; S.init(MT, INPAD, F.G, (int)blockIdx.x);
        EpiF32Plain E{WSP(float, WS_PROJ), INPAD, 0x7fffffff, false};
        gemm_phase<EpiF32Plain, StaticOrder, true, true>(F.lds, g, S, E);
        {
            __syncthreads();
            Gemm g2{WSP(bf16_t, WS_W3S), WSP(bf16_t, WS_A2S), 8192, 4096, 256}; HfOrder S2{F.G, (int)blockIdx.x, 136};
            EpiF32Plain E2{WSP(float, WS_HF), 4096, 15, true};
            gemm_phase<EpiF32Plain, HfOrder, true, true>(F.lds, g2, S2, E2);
        }
    } SEAM(2);
    if (IN(3)) REP(3) { p3_latent(F); } SEAM(3);
    if (IN(4)) REP(4) {
        { Gemm g{WSP(bf16_t, WS_CQN), WSP(bf16_t, WS_WUQ), MT, QW, QRANK}; StaticOrder S; S.init(MT, QW, F.G, (int)blockIdx.x);
          EpiQRope E{WSP(bf16_t, WS_Q), WSP(float, WS_CS)};
          gemm_phase<EpiQRope, StaticOrder, true, true>(F.lds, g, S, E); }
        __syncthreads();
        { Gemm g{WSP(bf16_t, WS_CKVN), WSP(bf16_t, WS_WUKV), MT, KVW, KVRANK}; StaticOrder S; S.init(MT, KVW, F.G, (int)(F.G - 1 - blockIdx.x));
          EpiBf16Plain E{WSP(bf16_t, WS_KV), KVW, 0x7fffffff};
          gemm_phase<EpiBf16Plain, StaticOrder, true, true>(F.lds, g, S, E); }
    } SEAM(4);
    if (IN(5)) REP(5) { p6_attention(F); } SEAM(5);
    if (IN(6)) REP(6) {
        Gemm g{WSP(bf16_t, WS_O), WSP(bf16_t, WS_WO), MX, DM, DM}; StaticOrder S; S.init(MX, DM, F.G, (int)blockIdx.x);
        EpiResid E{arg_in(0), WSP(float, WS_X1), mod + 2 * DM, 6 * DM, true};
        gemm_phase<EpiResid, StaticOrder, true, true>(F.lds, g, S, E);
    } SEAM(6);
#define MOE_PHASES(layer, pb) \
    if (IN(pb)) REP(pb) { p8_norm_router(F, layer); } SEAM(pb); \
    if (IN((pb) + 1)) REP((pb) + 1) { p9_select_gather(F); } SEAM((pb) + 1); \
    if (IN((pb) + 2)) REP((pb) + 2) {     \
        MoeOrder S{F.G, (int)blockIdx.x}; EpiSwiGLU E{WSP(bf16_t, WS_ACT)}; \
        if (F.G == 256) { Gemm g{Hb, WSP(bf16_t, WS_WGU) + (size_t)(layer) * NE * 2048 * DM, MROWS, 2048, DM, WSP(int, WS_SELROW)}; gemm_phase<EpiSwiGLU, MoeOrder, true, true, true>(F.lds, g, S, E); }     \
        else { Gemm g{WSP(bf16_t, WS_XG), WSP(bf16_t, WS_WGU) + (size_t)(layer) * NE * 2048 * DM, MROWS, 2048, DM}; gemm_phase<EpiSwiGLU, MoeOrder, true, true>(F.lds, g, S, E); } \
    } SEAM((pb) + 2); \
    if (IN((pb) + 3)) REP((pb) + 3) {     \
        Gemm g{WSP(bf16_t, WS_ACT), WSP(bf16_t, WS_WD) + (size_t)(layer) * NE * 2048 * FFD, MROWS, 2048, FFD}; MoeOrder S{F.G, (int)blockIdx.x}; \
        EpiBf16Plain E{WSP(bf16_t, WS_Y), DM, 7}; \
        gemm_phase<EpiBf16Plain, MoeOrder, true, true>(F.lds, g, S, E); \
    } SEAM((pb) + 3);
    MOE_PHASES(0, 7)
    if (IN(11)) REP(11) { p12_combine_norm<false>(F, 0); } SEAM(11);
    if (IN(12)) REP(12) {
        Gemm g{WSP(bf16_t, WS_HYWIN), Hb, 3 * DM, MX, DM}; StaticOrder S; S.init(3 * DM, MX, F.G, (int)blockIdx.x);
        EpiBf16Plain E{WSP(bf16_t, WS_U), MX, 0x7fffffff};
        gemm_phase<EpiBf16Plain, StaticOrder, true, true>(F.lds, g, S, E);
    } SEAM(12);
    if (IN(13)) REP(13) { p14_hyena_conv(F); } SEAM(13);
    if (IN(14)) REP(14) { p15_transpose(F); } SEAM(14);
    if (IN(15)) REP(15) {
        Gemm g{WSP(bf16_t, WS_Z), WSP(bf16_t, WS_HYWOUT), MX, DM, DM}; StaticOrder S; S.init(MX, DM, F.G, (int)blockIdx.x);
        EpiResid E{WSP(float, WS_X1), WSP(float, WS_X1), mod + 3 * 6 * DM + 2 * DM, 6 * DM, true};
        gemm_phase<EpiResid, StaticOrder, true, true>(F.lds, g, S, E);
    } SEAM(15);
    MOE_PHASES(1, 16)
    if (IN(20)) REP(20) { p12_combine_norm<true>(F, 1); }
#undef MOE_PHASES
#undef IN
#undef SEAM
}

extern "C" void kernel_launch(void* const* d_in, const int* in_sizes, int n_in, void* d_out, int out_size, void* d_ws, size_t ws_size, hipStream_t stream) {
    static int grid = 0;
    if (grid == 0) {
        if (n_in != 30 || out_size != MX * DM || ws_size < WS_END) { fprintf(stderr, "kernel_launch: shape/workspace mismatch: n_in %d out %d ws %zu (need %zu)\n", n_in, out_size, ws_size, (size_t)WS_END); grid = -1; return; }
        int dev = 0, cus = 0, per_cu = 0;
        if (hipGetDevice(&dev) != hipSuccess || hipDeviceGetAttribute(&cus, hipDeviceAttributeMultiprocessorCount, dev) != hipSuccess) { grid = -1; return; }
        if (hipFuncSetAttribute((const void*)mk_fwd, hipFuncAttributeMaxDynamicSharedMemorySize, LDS_BYTES) != hipSuccess) { fprintf(stderr, "kernel_launch: hipFuncSetAttribute failed\n"); grid = -1; return; }
        if (hipOccupancyMaxActiveBlocksPerMultiprocessor(&per_cu, (const void*)mk_fwd, NWAVES * 64, LDS_BYTES) != hipSuccess || per_cu < 1) { fprintf(stderr, "kernel_launch: occupancy query says %d blocks per CU\n", per_cu); }
        (void)hipGetLastError();
        grid = cus;
    }
    if (grid < 0) return;
    if (hipMemsetAsync((char*)d_ws + WS_CTL, 0, CTL_ZERO_BYTES, stream) != hipSuccess) return;
    Args a{};
    for (int i = 0; i < 30; ++i) a.in[i] = (const float*)d_in[i];
    a.out = (float*)d_out; a.ws = (unsigned char*)d_ws;
#if MK_SINGLE
    a.ph_lo = 0; a.ph_hi = NPHASE;
    hipLaunchKernelGGL(mk_fwd, dim3(grid), dim3(NWAVES * 64), LDS_BYTES, stream, a);
#else
    for (int p = 0; p < NPHASE; ++p) { a.ph_lo = p; a.ph_hi = p + 1; hipLaunchKernelGGL(mk_fwd, dim3(grid), dim3(NWAVES * 64), LDS_BYTES, stream, a); }
#endif
    const hipError_t le = hipPeekAtLastError();
    if (le != hipSuccess) fprintf(stderr, "kernel_launch: launch failed: %s\n", hipGetErrorName(le));
}
```

```cpp
#include <hip/hip_runtime.h>
#include <cstdio>
#include <cstdint>
namespace pg8 {
#define PG8_LAS __attribute__((address_space(3)))
typedef unsigned short bf16_t;
typedef short bf16x8 __attribute__((ext_vector_type(8)));
typedef float f32x4 __attribute__((ext_vector_type(4)));
typedef unsigned u32x4 __attribute__((ext_vector_type(4)));
constexpr int BM = 256, BK = 64, HALF = 128, HTB = HALF * BK * 2  , STAGE_BYTES = 8 * HTB, NXCD = 8, WGM = 8;

__host__ __device__ __forceinline__ int lds_byte(int r, int c) { const int st = (r >> 4) * 2 + (c >> 5), rr = r & 15, cc = c & 31, ob = rr * 64 + cc * 2; return st * 1024 + (ob ^ (((ob >> 9) & 1) << 5)); }
__host__ __device__ __forceinline__ void stage_rc(int b, int& R, int& C) { const int st = b / 1024, sb = b % 1024, swz = sb ^ (((sb >> 9) & 1) << 5); R = (st >> 1) * 16 + swz / 64; C = (st & 1) * 32 + (swz % 64) / 2; }
__host__ __device__ __forceinline__ int perm32(int rho) { const int n = rho >> 4, i = rho & 15; return 8 * (i >> 2) + 4 * n + (i & 3); }

struct Unit { int pm, pn; };
struct Gemm { const bf16_t* A; const bf16_t* Bt; int M, N, K; const int* rowidx; };

struct StaticOrder {
    int nM, nN, nwg, G, c;
    __host__ __device__ void init(int M, int N, int G_, int c_) { nM = M / BM; nN = N / BM; nwg = nM * nN; G = G_; c = c_; }
    __host__ __device__ bool next(int i, Unit& u) const {
        const long L = (long)i * G + c; if (L >= nwg) return false;
        int wgid = (int)L; { const int q = nwg / NXCD, r = nwg % NXCD, xcd = wgid % NXCD, off = wgid / NXCD; wgid = (xcd < r ? xcd * (q + 1) : r * (q + 1) + (xcd - r) * q) + off; }
        const int nig = WGM * nN, gid = wgid / nig, fm = gid * WGM, gsz = (nM - fm) < WGM ? (nM - fm) : WGM;
        u.pm = fm + ((wgid % nig) % gsz); u.pn = (wgid % nig) / gsz; return true;
    }
    __device__ __forceinline__ void a_ready(const Unit&) const {}
    __device__ __forceinline__ void done(const Unit&) const {}
};

__device__ __forceinline__ unsigned cvt_pk_bf16(float lo, float hi) { unsigned r; asm volatile("v_cvt_pk_bf16_f32 %0, %1, %2" : "=v"(r) : "v"(lo), "v"(hi)); return r; }
typedef float f32x2 __attribute__((ext_vector_type(2)));
struct EpiF32Plain {
    static constexpr bool PERM = false, AFTER_DRAIN = false;
    float* C; int ldc; int pn_mask; bool nt;
    __device__ __forceinline__ void operator()(const f32x4 (&acc)[2][2][4][2], const Unit& u, int wr, int wc, int fr, int fq) const {
        const int row0 = u.pm * BM + wr * 64 + fr, col0 = (u.pn & pn_mask) * BM + wc * 32 + 4 * fq;
#pragma unroll
        for (int ai = 0; ai < 2; ++ai)
#pragma unroll
            for (int m = 0; m < 4; ++m) { float* rowp = C + (size_t)(row0 + ai * HALF + m * 16) * ldc + col0;
#pragma unroll
                for (int bj = 0; bj < 2; ++bj)
#pragma unroll
                    for (int n = 0; n < 2; ++n) { if (nt) __builtin_nontemporal_store(acc[ai][bj][m][n], (f32x4*)(rowp + bj * HALF + n * 16)); else *(f32x4*)(rowp + bj * HALF + n * 16) = acc[ai][bj][m][n]; } }
    }
};
struct EpiBf16Plain {
    static constexpr bool PERM = true, AFTER_DRAIN = false;
    bf16_t* O; int ldc; int pn_mask;
    __device__ __forceinline__ void operator()(const f32x4 (&acc)[2][2][4][2], const Unit& u, int wr, int wc, int fr, int fq) const {
        const int row0 = u.pm * BM + wr * 64 + fr, col0 = (u.pn & pn_mask) * BM + wc * 32 + 8 * fq;
#pragma unroll
        for (int ai = 0; ai < 2; ++ai)
#pragma unroll
            for (int m = 0; m < 4; ++m) { bf16_t* rowp = O + (size_t)(row0 + ai * HALF + m * 16) * ldc + col0;
#pragma unroll
                for (int bj = 0; bj < 2; ++bj) { const f32x4 v0 = acc[ai][bj][m][0], v1 = acc[ai][bj][m][1];
                    u32x4 w; w.x = cvt_pk_bf16(v0[0], v0[1]); w.y = cvt_pk_bf16(v0[2], v0[3]); w.z = cvt_pk_bf16(v1[0], v1[1]); w.w = cvt_pk_bf16(v1[2], v1[3]);
                    *(u32x4*)(rowp + bj * HALF) = w; } }
    }
};
struct EpiQRope {
    static constexpr bool PERM = true, AFTER_DRAIN = false;
    bf16_t* O; const float* cs;
    __device__ __forceinline__ void operator()(const f32x4 (&acc)[2][2][4][2], const Unit& u, int wr, int wc, int fr, int fq) const {
        const int row0 = u.pm * BM + wr * 64 + fr;
#pragma unroll
        for (int ai = 0; ai < 2; ++ai)
#pragma unroll
            for (int m = 0; m < 4; ++m) { const int row = row0 + ai * HALF + m * 16; const int bb = row >= 4352 ? 1 : 0; const int l = row - bb * 4352; const bool lat = l < 4096; const int lp = lat ? l : 0;
#pragma unroll
                for (int bj = 0; bj < 2; ++bj) { const int c0 = u.pn * BM + bj * HALF + wc * 32 + 8 * fq; const int hh = c0 / 192, jj = c0 - hh * 192;
                    f32x4 v0 = acc[ai][bj][m][0], v1 = acc[ai][bj][m][1];
                    if (jj >= 128 && lat) { const f32x4* cp = (const f32x4*)(cs + ((size_t)lp * 32 + ((jj - 128) >> 1)) * 2); const f32x4 ca = cp[0], cb = cp[1];
                        const f32x4 a = v0, b = v1;
                        v0[0] = a[0] * ca[0] - a[1] * ca[1]; v0[1] = a[1] * ca[0] + a[0] * ca[1]; v0[2] = a[2] * ca[2] - a[3] * ca[3]; v0[3] = a[3] * ca[2] + a[2] * ca[3];
                        v1[0] = b[0] * cb[0] - b[1] * cb[1]; v1[1] = b[1] * cb[0] + b[0] * cb[1]; v1[2] = b[2] * cb[2] - b[3] * cb[3]; v1[3] = b[3] * cb[2] + b[2] * cb[3]; }
                    u32x4 w; w.x = cvt_pk_bf16(v0[0], v0[1]); w.y = cvt_pk_bf16(v0[2], v0[3]); w.z = cvt_pk_bf16(v1[0], v1[1]); w.w = cvt_pk_bf16(v1[2], v1[3]);
                    *(u32x4*)(O + (size_t)row * 3072 + c0) = w; } }
    }
};
struct EpiResid {
    static constexpr bool PERM = false, AFTER_DRAIN = false;
    const float* base; float* out; const float* gate; int gstride; bool ntbase;
    __device__ __forceinline__ void operator()(const f32x4 (&acc)[2][2][4][2], const Unit& u, int wr, int wc, int fr, int fq) const {
        const int row0 = u.pm * BM + wr * 64 + fr, col0 = u.pn * BM + wc * 32 + 4 * fq; const float* gp = gate + (size_t)(u.pm >> 4) * gstride + col0;
        f32x4 gv[2][2];
#pragma unroll
        for (int bj = 0; bj < 2; ++bj)
#pragma unroll
            for (int n = 0; n < 2; ++n) gv[bj][n] = *(const f32x4*)(gp + bj * HALF + n * 16);
#pragma unroll
        for (int ai = 0; ai < 2; ++ai)
#pragma unroll
            for (int m = 0; m < 4; ++m) { const size_t off = (size_t)(row0 + ai * HALF + m * 16) * 2048 + col0;
#pragma unroll
                for (int bj = 0; bj < 2; ++bj)
#pragma unroll
                    for (int n = 0; n < 2; ++n) { const f32x4 bs = ntbase ? __builtin_nontemporal_load((const f32x4*)(base + off + bj * HALF + n * 16)) : *(const f32x4*)(base + off + bj * HALF + n * 16); *(f32x4*)(out + off + bj * HALF + n * 16) = bs + gv[bj][n] * acc[ai][bj][m][n]; }
                asm volatile("" ::: "memory"); }
    }
};
struct EpiSwiGLU {
    static constexpr bool PERM = true, AFTER_DRAIN = false;
    bf16_t* O;
    __device__ __forceinline__ float silu(float g) const { return g * __builtin_amdgcn_rcpf(1.0f + __builtin_amdgcn_exp2f(-1.4426950408889634f * g)); }
    __device__ __forceinline__ void operator()(const f32x4 (&acc)[2][2][4][2], const Unit& u, int wr, int wc, int fr, int fq) const {
        const int row0 = u.pm * BM + wr * 64 + fr, col0 = (u.pn & 7) * 128 + wc * 32 + 8 * fq;
#pragma unroll
        for (int ai = 0; ai < 2; ++ai)
#pragma unroll
            for (int m = 0; m < 4; ++m) { const f32x4 g0 = acc[ai][0][m][0], g1 = acc[ai][0][m][1], u0 = acc[ai][1][m][0], u1 = acc[ai][1][m][1];
                u32x4 w; w.x = cvt_pk_bf16(silu(g0[0]) * u0[0], silu(g0[1]) * u0[1]); w.y = cvt_pk_bf16(silu(g0[2]) * u0[2], silu(g0[3]) * u0[3]);
                w.z = cvt_pk_bf16(silu(g1[0]) * u1[0], silu(g1[1]) * u1[1]); w.w = cvt_pk_bf16(silu(g1[2]) * u1[2], silu(g1[3]) * u1[3]);
                *(u32x4*)(O + (size_t)(row0 + ai * HALF + m * 16) * 1024 + col0) = w; }
    }
};
struct HfOrder {
    int G, c, skip;
    __device__ __forceinline__ bool next(int i, Unit& u) const {
        int L;
        if (G > skip + 8) { if (c < skip) return false; L = (c - skip) + i * (G - skip); } else L = i * G + c;
        if (L >= 512) return false;
        const int dir = L >> 8, w = L & 255; u.pm = dir * 16 + (w & 15); u.pn = dir * 16 + (w >> 4); return true;
    }
    __device__ __forceinline__ void a_ready(const Unit&) const {}
    __device__ __forceinline__ void done(const Unit&) const {}
};
struct MoeOrder {
    int G, c;
    __device__ __forceinline__ bool next(int i, Unit& u) const {
        int e, j;
        if (G == 256) { if (i >= 2) return false; e = i * 8 + (c & 7); j = c >> 3; }
        else { const int L = i * G + c; if (L >= 512) return false; e = L >> 5; j = L & 31; }
        u.pm = e * 4 + (j & 3); u.pn = e * 8 + (j >> 2); return true;
    }
    __device__ __forceinline__ void a_ready(const Unit&) const {}
    __device__ __forceinline__ void done(const Unit&) const {}
};

template <class Epi, class Sched, bool ALIGN_EPI = false, bool SP2 = false, bool GATHER = false  >
__device__ __forceinline__ void gemm_phase(PG8_LAS unsigned char* lds, const Gemm g, const Sched& S, const Epi& E) {
    const int tid = threadIdx.x, wid = __builtin_amdgcn_readfirstlane(tid >> 6), lane = tid & 63, wr = wid >> 2, wc = wid & 3, fr = lane & 15, fq = lane >> 4;
    const int K = g.K, nt = K / BK;
    unsigned voffA[2], voffB[2];
#pragma unroll
    for (int i = 0; i < 2; ++i) { int R, C; stage_rc(tid * 16 + i * 8192, R, C); const int Rb = Epi::PERM ? ((R & ~31) + perm32(R & 31)) : R;
        voffA[i] = (unsigned)(R * K + C) * 2u; voffB[i] = (unsigned)(Rb * K + C) * 2u; }
    unsigned gC[2][2] = {{0u, 0u}, {0u, 0u}}, gN[2][2] = {{0u, 0u}, {0u, 0u}}, g2[2][2] = {{0u, 0u}, {0u, 0u}};
    PG8_LAS unsigned* gl = (PG8_LAS unsigned*)(lds + STAGE_BYTES);
    if constexpr (GATHER) { static_assert(SP2, "GATHER is written for the SP2 loop");
        Unit u2;
#pragma unroll
        for (int q = 0; q < 2; ++q) if (S.next(q, u2)) {
#pragma unroll
            for (int h = 0; h < 2; ++h)
#pragma unroll
                for (int i = 0; i < 2; ++i) { int R, C; stage_rc(tid * 16 + i * 8192, R, C); const unsigned row = (unsigned)g.rowidx[u2.pm * BM + h * HALF + R]; gl[((q * 2 + h) * 2 + i) * 512 + tid] = (row * (unsigned)K + (unsigned)C) * 2u; } }
        asm volatile("s_waitcnt vmcnt(0) lgkmcnt(0)" ::: "memory");
#pragma unroll
        for (int h = 0; h < 2; ++h)
#pragma unroll
            for (int i = 0; i < 2; ++i) gC[h][i] = gl[((0 * 2 + h) * 2 + i) * 512 + tid];
    }
#define PG8_STA(b, h, base, offs2) do { if constexpr (GATHER) { PG8_STAGE(PG8_SA(b, h), base, offs2[h]); } else { PG8_STAGE(PG8_SA(b, h), (base) + (h) * hstep, voffA); } } while (0)
    const size_t kstep = (size_t)(BK * 2);
    const size_t hstep = (size_t)HALF * K * 2;
    const size_t tstep = 2 * hstep;
    const unsigned ldsw = (unsigned)wid * 1024u;
    const int aoff = lds_byte(wr * 64 + fr, fq * 8), boff = lds_byte(wc * 32 + fr, fq * 8);
#define PG8_SA(b, h) (((b) * 2 + (h)) * HTB)
#define PG8_SB(b, h) ((4 + (b) * 2 + (h)) * HTB)
#define PG8_STAGE(bufoff, gbase, voff) do { _Pragma("unroll") for (int _i = 0; _i < 2; ++_i) \
        __builtin_amdgcn_global_load_lds((const unsigned*)((const char*)(gbase) + (voff)[_i]), (PG8_LAS unsigned*)(lds + (bufoff) + ldsw + _i * 8192), 16, 0, 0); } while (0)
#define PG8_LDA(dst, b, h) do { _Pragma("unroll") for (int m = 0; m < 4; ++m) _Pragma("unroll") for (int k = 0; k < 2; ++k) dst[m][k] = *(const PG8_LAS bf16x8*)(lds + PG8_SA(b, h) + aoff + m * 2048 + k * 1024); } while (0)
#define PG8_LDB(dst, b, h) do { _Pragma("unroll") for (int n = 0; n < 2; ++n) _Pragma("unroll") for (int k = 0; k < 2; ++k) dst[n][k] = *(const PG8_LAS bf16x8*)(lds + PG8_SB(b, h) + boff + n * 2048 + k * 1024); } while (0)
#define PG8_MMA(ai, bj, At, Bt) do { __builtin_amdgcn_s_setprio(1); _Pragma("unroll") for (int m = 0; m < 4; ++m) _Pragma("unroll") for (int n = 0; n < 2; ++n) _Pragma("unroll") for (int k = 0; k < 2; ++k) \
        acc[ai][bj][m][n] = __builtin_amdgcn_mfma_f32_16x16x32_bf16(Bt[n][k], At[m][k], acc[ai][bj][m][n], 0, 0, 0); __builtin_amdgcn_s_setprio(0); } while (0)
#define PG8_WAIT_V(n) asm volatile("s_waitcnt vmcnt(" #n ")" ::: "memory")
#define PG8_WAIT_L(n) asm volatile("s_waitcnt lgkmcnt(" #n ")" ::: "memory")
#define PG8_BAR __builtin_amdgcn_s_barrier()
#define PG8_SCHED __builtin_amdgcn_sched_barrier(0)
    Unit cur, nxt; int ui = 0;
    if (!S.next(0, cur)) return;
    f32x4 acc[2][2][4][2];
#pragma unroll
    for (int a = 0; a < 2; ++a)
#pragma unroll
        for (int b = 0; b < 2; ++b)
#pragma unroll
            for (int m = 0; m < 4; ++m)
#pragma unroll
                for (int n = 0; n < 2; ++n) acc[a][b][m][n] = (f32x4){0.f, 0.f, 0.f, 0.f};
    bf16x8 At[4][2], B0[2][2], B1[2][2];
    const char* cA = (const char*)g.A + (GATHER ? (size_t)0 : (size_t)cur.pm * tstep); const char* cB = (const char*)g.Bt + (size_t)cur.pn * tstep;
    S.a_ready(cur);
    if constexpr (SP2) {
        PG8_STAGE(PG8_SB(0, 0), cB, voffB); PG8_STAGE(PG8_SB(0, 1), cB + hstep, voffB); PG8_STA(0, 0, cA, gC); PG8_STA(0, 1, cA, gC);
        if (wr == 1) PG8_BAR;
        PG8_WAIT_V(2); PG8_BAR;
        PG8_STAGE(PG8_SB(1, 0), cB + kstep, voffB); PG8_STA(1, 0, cA + kstep, gC); PG8_STAGE(PG8_SB(1, 1), cB + hstep + kstep, voffB);
        PG8_WAIT_V(6); PG8_BAR;
    } else {
        PG8_STAGE(PG8_SB(0, 0), cB, voffB); PG8_STA(0, 0, cA, gC); PG8_STAGE(PG8_SB(0, 1), cB + hstep, voffB); PG8_STA(0, 1, cA, gC);
        if (wr == 1) PG8_BAR;
        PG8_WAIT_V(4); PG8_BAR;
        PG8_STAGE(PG8_SB(1, 0), cB + kstep, voffB); PG8_STA(1, 0, cA + kstep, gC); PG8_STAGE(PG8_SB(1, 1), cB + hstep + kstep, voffB);
        PG8_WAIT_V(6); PG8_BAR;
    }
    for (;;) {
        const bool has_next = S.next(ui + 1, nxt);
        const char* nA = (has_next && !GATHER) ? (const char*)g.A + (size_t)nxt.pm * tstep : cA; const char* nB = has_next ? (const char*)g.Bt + (size_t)nxt.pn * tstep : cB;
        if constexpr (GATHER) {
#pragma unroll
            for (int h = 0; h < 2; ++h)
#pragma unroll
                for (int i = 0; i < 2; ++i) gN[h][i] = has_next ? gl[(((ui + 1) * 2 + h) * 2 + i) * 512 + tid] : gC[h][i]; }
        for (int t = 0; t < nt; t += 2) {
            const bool last = (t == nt - 2);
            const char* a1 = cA + (size_t)(t + 1) * kstep;
            const char* a2 = last ? nA : cA + (size_t)(t + 2) * kstep; const char* b2 = last ? nB : cB + (size_t)(t + 2) * kstep;
            const char* a3 = a2 + kstep; const char* b3 = b2 + kstep;
            if (last && has_next) S.a_ready(nxt);
            if constexpr (GATHER) {
#pragma unroll
                for (int h = 0; h < 2; ++h)
#pragma unroll
                    for (int i = 0; i < 2; ++i) g2[h][i] = last ? gN[h][i] : gC[h][i]; }
            if constexpr (SP2) {
            PG8_LDB(B0, 0, 0); PG8_LDB(B1, 0, 1); PG8_SCHED; PG8_LDA(At, 0, 0); PG8_STA(1, 1, a1, gC);
            PG8_WAIT_V(8); PG8_WAIT_L(0); PG8_BAR; PG8_MMA(0, 0, At, B0); PG8_MMA(0, 1, At, B1); PG8_BAR; PG8_SCHED;
            PG8_LDA(At, 0, 1); PG8_STAGE(PG8_SB(0, 0), b2, voffB); PG8_STAGE(PG8_SB(0, 1), b2 + hstep, voffB); PG8_STA(0, 0, a2, g2);
            PG8_WAIT_V(8); PG8_WAIT_L(0); PG8_BAR; PG8_MMA(1, 0, At, B0); PG8_MMA(1, 1, At, B1); PG8_BAR; PG8_SCHED;
            PG8_LDB(B0, 1, 0); PG8_LDB(B1, 1, 1); PG8_SCHED; PG8_LDA(At, 1, 0); PG8_STA(0, 1, a2, g2);
            PG8_WAIT_V(8); PG8_WAIT_L(0); PG8_BAR; PG8_MMA(0, 0, At, B0); PG8_MMA(0, 1, At, B1); PG8_BAR; PG8_SCHED;
            PG8_LDA(At, 1, 1); PG8_STAGE(PG8_SB(1, 0), b3, voffB); PG8_STAGE(PG8_SB(1, 1), b3 + hstep, voffB); PG8_STA(1, 0, a3, g2);
            PG8_WAIT_V(8); PG8_WAIT_L(0); PG8_BAR; PG8_MMA(1, 0, At, B0); PG8_MMA(1, 1, At, B1); PG8_BAR; PG8_SCHED;
            } else {
            PG8_LDB(B0, 0, 0); PG8_SCHED; PG8_LDA(At, 0, 0); PG8_STA(1, 1, a1, gC);
            PG8_WAIT_L(8); PG8_BAR; PG8_WAIT_L(0); PG8_MMA(0, 0, At, B0); PG8_BAR; PG8_SCHED;
            PG8_LDB(B1, 0, 1); PG8_STAGE(PG8_SB(0, 0), b2, voffB);
            PG8_BAR; PG8_WAIT_L(0); PG8_MMA(0, 1, At, B1); PG8_BAR;
            PG8_LDA(At, 0, 1); PG8_STA(0, 0, a2, g2);
            PG8_BAR; PG8_WAIT_L(0); PG8_MMA(1, 0, At, B0); PG8_BAR; PG8_SCHED;
            PG8_STAGE(PG8_SB(0, 1), b2 + hstep, voffB);
            PG8_WAIT_V(6); PG8_BAR; PG8_MMA(1, 1, At, B1); PG8_BAR;
            PG8_LDB(B0, 1, 0); PG8_SCHED; PG8_LDA(At, 1, 0); PG8_STA(0, 1, a2, g2);
            PG8_WAIT_L(8); PG8_BAR; PG8_WAIT_L(0); PG8_MMA(0, 0, At, B0); PG8_BAR; PG8_SCHED;
            PG8_LDB(B1, 1, 1); PG8_STAGE(PG8_SB(1, 0), b3, voffB);
            PG8_BAR; PG8_WAIT_L(0); PG8_MMA(0, 1, At, B1); PG8_BAR;
            PG8_LDA(At, 1, 1); PG8_STA(1, 0, a3, g2);
            PG8_BAR; PG8_WAIT_L(0); PG8_MMA(1, 0, At, B0); PG8_BAR; PG8_SCHED;
            PG8_STAGE(PG8_SB(1, 1), b3 + hstep, voffB);
            PG8_WAIT_V(6); PG8_BAR; PG8_MMA(1, 1, At, B1); PG8_BAR;
            }
        }
        if constexpr (ALIGN_EPI) { if (wr == 0) PG8_BAR; }
        if constexpr (!Epi::AFTER_DRAIN) { E(acc, cur, wr, wc, fr, fq); S.done(cur); }
        if (!has_next) break;
#pragma unroll
        for (int a = 0; a < 2; ++a)
#pragma unroll
            for (int b = 0; b < 2; ++b)
#pragma unroll
                for (int m = 0; m < 4; ++m)
#pragma unroll
                    for (int n = 0; n < 2; ++n) acc[a][b][m][n] = (f32x4){0.f, 0.f, 0.f, 0.f};
        cur = nxt; cA = nA; cB = nB; ++ui;
        if constexpr (GATHER) {
#pragma unroll
            for (int h = 0; h < 2; ++h)
#pragma unroll
                for (int i = 0; i < 2; ++i) gC[h][i] = gN[h][i]; }
        if constexpr (ALIGN_EPI) { if (wr == 1) PG8_BAR; }
    }
    PG8_WAIT_V(0);
    if constexpr (!ALIGN_EPI) { if (wr == 0) PG8_BAR; }
    PG8_BAR;
    if constexpr (Epi::AFTER_DRAIN) { E.fused(acc, cur, wr, wc, fr, fq, lds, wid, lane); S.done(cur); }
#undef PG8_SA
#undef PG8_SB
#undef PG8_STAGE
#undef PG8_STA
#undef PG8_LDA
#undef PG8_LDB
#undef PG8_MMA
#undef PG8_WAIT_V
#undef PG8_WAIT_L
#undef PG8_BAR
#undef PG8_SCHED
}
}
#define GAS __attribute__((address_space(1)))
#define LAS __attribute__((address_space(3)))
typedef unsigned short bf16;
typedef unsigned v4u __attribute__((ext_vector_type(4)));
typedef unsigned v2u __attribute__((ext_vector_type(2)));
typedef float f32x4 __attribute__((ext_vector_type(4)));
typedef float f32x2 __attribute__((ext_vector_type(2)));
typedef float f32x16 __attribute__((ext_vector_type(16)));
typedef short bf16x8 __attribute__((ext_vector_type(8)));
typedef short s16x4 __attribute__((ext_vector_type(4)));
typedef GAS unsigned gu32;
#define RLX_AGENT __ATOMIC_RELAXED, __HIP_MEMORY_SCOPE_AGENT
#define LDS_WAIT() asm volatile("s_waitcnt lgkmcnt(0)" ::: "memory")
#define VM_WAIT() asm volatile("s_waitcnt vmcnt(0)" ::: "memory")
__device__ __forceinline__ unsigned pk2(float lo, float hi) { unsigned r; asm volatile("v_cvt_pk_bf16_f32 %0, %1, %2" : "=v"(r) : "v"(lo), "v"(hi)); return r; }
__device__ __forceinline__ float bf_lo(unsigned w) { return __uint_as_float(w << 16); }
__device__ __forceinline__ float bf_hi(unsigned w) { return __uint_as_float(w & 0xffff0000u); }
__device__ __forceinline__ float bf1(bf16 h) { return __uint_as_float(((unsigned)h) << 16); }
__device__ __forceinline__ int opq(int x) { asm volatile("" : "+v"(x)); return x; }
__device__ __forceinline__ float wave_sum(float v) {
#pragma unroll
    for (int o = 1; o < 64; o <<= 1) v += __shfl_xor(v, o);
    return v;
}
__device__ __forceinline__ int wave_sum_i(int v) {
#pragma unroll
    for (int o = 1; o < 64; o <<= 1) v += __shfl_xor(v, o);
    return v;
}

#define XB_TMO      128
#define XB_XCNT(j)  (256  + 64 * (j))
#define XB_XSUB(j)  (1280 + 64 * (j))
#define XB_XGEN(j)  (2304 + 64 * (j))
#define XB_TOP      3328
#define XB_TOPGEN   3392
#define XCD_BAR_WORDS 3456
#define XB_SPIN_CAP (1u << 18)

__device__ __forceinline__ unsigned xb_ld(unsigned* p)              { return __hip_atomic_load(p, __ATOMIC_RELAXED, __HIP_MEMORY_SCOPE_AGENT); }
__device__ __forceinline__ unsigned xb_add(unsigned* p, unsigned v) { return __hip_atomic_fetch_add(p, v, __ATOMIC_RELAXED, __HIP_MEMORY_SCOPE_AGENT); }
__device__ __forceinline__ unsigned xb_xcc_id() { return (unsigned)__builtin_amdgcn_s_getreg((3 << 11) | 20) & 0xFu; }
#define XB_SPIN(cond, bar) do { unsigned _sp = 0; while (cond) { __builtin_amdgcn_s_sleep(1); \
    if ((++_sp & 255u) == 0u) { if (xb_ld(&(bar)[XB_TMO])) break; if (_sp > XB_SPIN_CAP) { atomicAdd(&(bar)[XB_TMO], 1u); break; } } } } while (0)

struct XcdBarrier {
    unsigned* bar; unsigned x;
    volatile LAS unsigned* st;
};

__device__ __forceinline__ XcdBarrier xcd_barrier_post(unsigned* bar, volatile LAS unsigned* st) {
    XcdBarrier b; b.bar = bar; b.x = xb_xcc_id(); b.st = st;
    if (threadIdx.x == 0) (void)xb_add(&bar[XB_XCNT(b.x)], 1u);
    return b;
}
__device__ __forceinline__ void xcd_barrier_complete(unsigned* bar, unsigned x, unsigned& nloc, unsigned& nx) {
    const unsigned G = gridDim.x * gridDim.y * gridDim.z;
    unsigned sum, cnt, mine, sp = 0u;
    for (;;) {
        sum = 0u; cnt = 0u; mine = 0u;
#pragma unroll
        for (unsigned j = 0; j < 16; ++j) { const unsigned c = xb_ld(&bar[XB_XCNT(j)]); sum += c; cnt += (c > 0u) ? 1u : 0u; mine = (j == x) ? c : mine; }
        if (sum == G) break;
        __builtin_amdgcn_s_sleep(1);
        if ((++sp & 255u) == 0u) { if (xb_ld(&bar[XB_TMO])) break; if (sp > XB_SPIN_CAP) { atomicAdd(&bar[XB_TMO], 1u); break; } }
    }
    nloc = mine > 0u ? mine : 1u; nx = cnt > 0u ? cnt : 1u;
}

__device__ __forceinline__ void xcd_barrier(const XcdBarrier& b) {
    asm volatile("s_waitcnt vmcnt(0)" ::: "memory");
    __syncthreads();
    if (threadIdx.x == 0) {
        unsigned* bar = b.bar;
        __builtin_amdgcn_s_waitcnt(0);
        unsigned nloc = b.st[0], nx = b.st[1];
        if (nloc == 0u) { xcd_barrier_complete(bar, b.x, nloc, nx); b.st[0] = nloc; b.st[1] = nx; }
        const unsigned old = xb_add(&bar[XB_XSUB(b.x)], 1u);
        const unsigned gen = old / nloc;
        if (old + 1u == (gen + 1u) * nloc) {
            __builtin_amdgcn_fence(__ATOMIC_RELEASE, "agent");
            asm volatile("s_waitcnt vmcnt(0)" ::: "memory");
            const unsigned og = xb_add(&bar[XB_TOP], 1u);
            const unsigned tg = og / nx;
            if (og + 1u == (tg + 1u) * nx) xb_add(&bar[XB_TOPGEN], 1u);
            else XB_SPIN(xb_ld(&bar[XB_TOPGEN]) == tg, bar);
            __builtin_amdgcn_fence(__ATOMIC_ACQUIRE, "agent");
            xb_add(&bar[XB_XGEN(b.x)], 1u);
            asm volatile("s_waitcnt vmcnt(0)" ::: "memory");
        } else {
            XB_SPIN(xb_ld(&bar[XB_XGEN(b.x)]) == gen, bar);
            __builtin_amdgcn_fence(__ATOMIC_ACQUIRE, "agent");
            asm volatile("s_waitcnt vmcnt(0)" ::: "memory");
        }
    }
    __syncthreads();
}

constexpr int NWAVES = 8;
constexpr int DM = 2048, NB = 2, SEQ = 4096, CTXL = 256, LT = SEQ + CTXL  , MT = NB * LT  , MX = NB * SEQ  ;
constexpr int NH = 16, QRANK = 512, KVRANK = 256, INDIM = 832, INPAD = 1024, QW = NH * 192  , KVW = NH * 256  ;
constexpr int NE = 16, CAP = 512, FFD = 1024, MROWS = NB * NE * CAP  ;
constexpr float EPS = 1e-6f;
constexpr size_t MiB = 1u << 20;
constexpr size_t WS_CTL = 0, CTL_ZERO_BYTES = 1 * MiB;
constexpr size_t WS_MOD = 64 * 1024;
constexpr size_t WS_CS = 1 * MiB, WS_A2S = 2 * MiB  , WS_A2RS = 4 * MiB  , WS_W3S = 58 * MiB  , WS_TW = 6 * MiB  , WS_SELROW = 6 * MiB + 128 * 1024  , WS_AFF = 7 * MiB  , WS_TOK = 7 * MiB + 512 * 1024  ;
constexpr size_t WS_WIN = 8 * MiB, WS_WUQ = 12 * MiB, WS_WUKV = 15 * MiB, WS_WO = 17 * MiB, WS_HYWOUT = 25 * MiB, WS_HYWIN = 33 * MiB;
constexpr size_t WS_WGU = 64 * MiB  , WS_WD = 320 * MiB  ;
constexpr size_t WS_H = 448 * MiB  , WS_PROJ = 482 * MiB  , WS_CQN = 516 * MiB, WS_CKVN = 525 * MiB, WS_KROPE = 530 * MiB;
constexpr size_t WS_Q = 532 * MiB, WS_KV = 583 * MiB, WS_O = 651 * MiB, WS_X1 = 683 * MiB  , WS_XG = 747 * MiB, WS_ACT = 811 * MiB, WS_Y = 843 * MiB, WS_HF = 907 * MiB  , WS_END = 1035 * MiB;
constexpr size_t WS_U = 532 * MiB  , WS_ZT = 628 * MiB  , WS_Z = 482 * MiB  ;
constexpr int CW_TMO = 0, CW_BAR = 4096;
constexpr int LDS_BYTES = 155648, MISC_OFF = 153600;
constexpr int NPHASE = 21;

struct Frame {
    LAS unsigned char* lds; unsigned char* ldsg;
    int tid, wave, vcu, G;
    float* out; unsigned char* ws;
};
__device__ __forceinline__ const float* arg_in(int i) {
    const __attribute__((address_space(4))) unsigned long long* ka = (const __attribute__((address_space(4))) unsigned long long*)__builtin_amdgcn_kernarg_segment_ptr();
    asm volatile("" : "+s"(ka));
    return (const float*)(const __attribute__((address_space(1))) float*)ka[i];
}
#define WSP(T, off) ((T*)(F.ws + (off)))

__device__ __forceinline__ int uq_srccol(int n) { const int hh = n / 192, jj = n - hh * 192; if (jj < 128) return n; const int r = jj - 128; return hh * 192 + 128 + (r >> 1) + 32 * (r & 1); }
template <bool VEC>
__device__ __forceinline__ void transpose_item(const float* src, int N, int c0, int k0, bf16* dst, int K, LAS float* scr, int lane) {
    if constexpr (VEC) {
        const float* s = src + (size_t)k0 * N + c0 + (lane & 15) * 4;
        f32x4 v[16];
#pragma unroll
        for (int i = 0; i < 16; ++i) v[i] = __builtin_nontemporal_load((const f32x4*)(s + (size_t)(4 * i + (lane >> 4)) * N));
#pragma unroll
        for (int i = 0; i < 16; ++i) { LAS float* d = scr + (4 * i + (lane >> 4)) * 65 + (lane & 15) * 4; d[0] = v[i][0]; d[1] = v[i][1]; d[2] = v[i][2]; d[3] = v[i][3]; }
    } else {
        const int sc = uq_srccol(c0 + lane);
        const float* s = src + (size_t)k0 * N + sc;
#pragma unroll 16
        for (int kk = 0; kk < 64; ++kk) scr[kk * 65 + lane] = s[(size_t)kk * N];
    }
    LDS_WAIT(); asm volatile("" ::: "memory");
    const int c = lane & 7;
#pragma unroll
    for (int jj = 0; jj < 8; ++jj) { const int n = (lane >> 3) + 8 * jj; const LAS float* s = scr + (8 * c) * 65 + n;
        v4u o; o.x = pk2(s[0 * 65], s[1 * 65]); o.y = pk2(s[2 * 65], s[3 * 65]); o.z = pk2(s[4 * 65], s[5 * 65]); o.w = pk2(s[6 * 65], s[7 * 65]);
        *(v4u*)(dst + (size_t)n * K + k0 + 8 * c) = o; }
    LDS_WAIT(); asm volatile("" ::: "memory");
}
__device__ __forceinline__ float silu_f(float x) { return x / (1.0f + __expf(-x)); }

constexpr int CI0 = 32 * 13, CI1 = 8 * 48, CI2 = 4 * 64, CI_EARLY = CI0 + CI1 + CI2;
constexpr int CI3 = 32 * 32, CI4 = 32 * 32, CI5 = 32 * 96, CI_GU = 32 * 1024, CI_D = 32 * 512, CI_LATE = CI3 + CI4 + CI5 + CI_GU + CI_D;
__device__ __forceinline__ void convert_early(Frame& F) {
    const int lane = opq(F.tid) & 63;
    const int gw = F.vcu * NWAVES + F.wave, NGW = F.G * NWAVES;
    LAS float* scr = (LAS float*)(F.lds + F.wave * 16640);
#pragma unroll 1
    for (int it = gw; it < CI_EARLY; it += NGW) {
        int r = it; const float* src; int N, c0, k0, K; bf16* dst; bool vec = true;
        if (r < CI0) { const int kb = r / 13, nb = r % 13; src = arg_in(8); N = INDIM; c0 = nb * 64; k0 = kb * 64; K = DM; dst = WSP(bf16, WS_WIN) + (size_t)nb * 64 * DM; }
        else if ((r -= CI0) < CI1) { const int kb = r / 48, nb = r % 48; src = arg_in(11); N = QW; c0 = nb * 64; k0 = kb * 64; K = QRANK; dst = WSP(bf16, WS_WUQ) + (size_t)nb * 64 * QRANK; vec = false; }
        else { r -= CI1; const int kb = r / 64, nb = r % 64; src = arg_in(12); N = KVW; c0 = nb * 64; k0 = kb * 64; K = KVRANK; dst = WSP(bf16, WS_WUKV) + (size_t)nb * 64 * KVRANK; }
        if (vec) transpose_item<true>(src, N, c0, k0, dst, K, scr, lane); else transpose_item<false>(src, N, c0, k0, dst, K, scr, lane);
    }
}
struct CvItem { const float* s; bf16* dst; int N, K; };
__device__ __forceinline__ CvItem cv_decode_late(Frame& F, int it, int lane) {
    int r = it; const float* src; int N, c0, k0, K; bf16* dst;
    if (r < CI3) { const int kb = r / 32, nb = r % 32; src = arg_in(13); N = DM; c0 = nb * 64; k0 = kb * 64; K = DM; dst = WSP(bf16, WS_WO) + (size_t)nb * 64 * DM; }
    else if ((r -= CI3) < CI4) { const int kb = r / 32, nb = r % 32; src = arg_in(25); N = DM; c0 = nb * 64; k0 = kb * 64; K = DM; dst = WSP(bf16, WS_HYWOUT) + (size_t)nb * 64 * DM; }
    else if ((r -= CI4) < CI5) { const int kb = r / 96, nb = r % 96; src = arg_in(14); N = 3 * DM; c0 = nb * 64; k0 = kb * 64; K = DM; dst = WSP(bf16, WS_HYWIN) + (size_t)nb * 64 * DM; }
    else if ((r -= CI5) < CI_GU) { const int le = r >> 10, q = r & 1023, kb = q >> 5, nb = q & 31;
        src = (((nb >> 1) & 1) ? arg_in(28) : arg_in(27)) + (size_t)le * DM * FFD; N = FFD; c0 = (nb >> 2) * 128 + (nb & 1) * 64; k0 = kb * 64; K = DM; dst = WSP(bf16, WS_WGU) + ((size_t)le * 2048 + nb * 64) * DM; }
    else { r -= CI_GU; const int le = r >> 9, q = r & 511, kb = q >> 5, nb = q & 31;
        src = arg_in(29) + (size_t)le * FFD * DM; N = DM; c0 = nb * 64; k0 = kb * 64; K = FFD; dst = WSP(bf16, WS_WD) + ((size_t)le * 2048 + nb * 64) * FFD; }
    CvItem d; d.s = src + (size_t)(k0 + (lane >> 4)) * N + c0 + (lane & 15) * 4; d.dst = dst + k0; d.N = N; d.K = K; return d;
}
__device__ __forceinline__ void cv_issue(const CvItem& d, f32x4 (&v)[16]) {
#pragma unroll
    for (int i = 0; i < 16; ++i) v[i] = __builtin_nontemporal_load((const f32x4*)(d.s + (size_t)(4 * i) * d.N));
}
__device__ __forceinline__ void cv_finish(const CvItem& d, const f32x4 (&v)[16], LAS float* scr, int lane) {
#pragma unroll
    for (int i = 0; i < 16; ++i) { LAS float* p = scr + (4 * i + (lane >> 4)) * 65 + (lane & 15) * 4; p[0] = v[i][0]; p[1] = v[i][1]; p[2] = v[i][2]; p[3] = v[i][3]; }
    LDS_WAIT(); asm volatile("" ::: "memory");
    const int c = lane & 7;
#pragma unroll
    for (int jj = 0; jj < 8; ++jj) { const int n = (lane >> 3) + 8 * jj; const LAS float* s = scr + (8 * c) * 65 + n;
        v4u o; o.x = pk2(s[0 * 65], s[1 * 65]); o.y = pk2(s[2 * 65], s[3 * 65]); o.z = pk2(s[4 * 65], s[5 * 65]); o.w = pk2(s[6 * 65], s[7 * 65]);
        __builtin_nontemporal_store(o, (v4u*)(d.dst + (size_t)n * d.K + 8 * c)); }
    LDS_WAIT(); asm volatile("" ::: "memory");
}
__device__ __forceinline__ void convert_late(Frame& F) {
    const int lane = opq(F.tid) & 63;
    const int gw = F.vcu * NWAVES + F.wave, NGW = F.G * NWAVES;
    LAS float* scr = (LAS float*)(F.lds + F.wave * 16640);
    __syncthreads();
    int it = gw; CvItem da, db; f32x4 va[16], vb[16];
    if (it < CI_LATE) { da = cv_decode_late(F, it, lane); cv_issue(da, va); }
#pragma unroll 1
    while (it < CI_LATE) {
        const int it2 = it + NGW; const bool h2 = it2 < CI_LATE;
        if (h2) { db = cv_decode_late(F, it2, lane); cv_issue(db, vb); }
        cv_finish(da, va, scr, lane);
        if (!h2) break;
        const int it3 = it2 + NGW; const bool h3 = it3 < CI_LATE;
        if (h3) { da = cv_decode_late(F, it3, lane); cv_issue(da, va); }
        cv_finish(db, vb, scr, lane);
        it = it3;
    }
    __syncthreads();
}
__device__ __forceinline__ void p0_prologue(Frame& F) {
    const int lane = opq(F.tid) & 63;
#ifndef NO_PA
    convert_early(F);
#endif
    __syncthreads();
#ifndef NO_PB
    {
        LAS float* sv = (LAS float*)F.lds;
        LAS float* part = sv + 3 * DM;
        { const float* cin = arg_in(1); const float* cctx = arg_in(3);
        for (int i = F.tid; i < 3 * DM; i += 512) { const float cv = i < 2 * DM ? cin[i] : cctx[i - 2 * DM]; sv[i] = silu_f(cv); } }
        __syncthreads();
        float* mod = WSP(float, WS_MOD); const float* adaw = arg_in(4); const float* adab = arg_in(5);
        const int q = F.tid % 24, kg = F.tid / 24;
        for (int un = F.vcu; un < 256; un += F.G) {
            const int layer = un >> 7, n0 = (un & 127) * 96;
            const float* W = adaw + (size_t)layer * DM * 6 * DM + n0 + q * 4;
            f32x4 a0 = {0.f, 0.f, 0.f, 0.f}, a1 = a0, a2 = a0;
            if (kg < 21) {
#pragma unroll 8
                for (int k = kg; k < DM; k += 21) { const f32x4 w = __builtin_nontemporal_load((const f32x4*)(W + (size_t)k * (6 * DM))); a0 += sv[k] * w; a1 += sv[DM + k] * w; a2 += sv[2 * DM + k] * w; }
                LAS float* pp = part + kg * 288 + q * 4;
                *(LAS f32x4*)pp = a0; *(LAS f32x4*)(pp + 96) = a1; *(LAS f32x4*)(pp + 192) = a2;
            }
            __syncthreads();
            if (F.tid < 288) { const int m = F.tid / 96, nn = F.tid % 96; float s = adab[(size_t)layer * 6 * DM + n0 + nn];
#pragma unroll
                for (int g = 0; g < 21; ++g) s += part[g * 288 + F.tid];
                mod[((size_t)layer * 3 + m) * 6 * DM + n0 + nn] = s; }
            __syncthreads();
        }
    }
#endif
    __syncthreads();
#ifndef NO_PC
    {
        LAS float* h1s = (LAS float*)F.lds;
        const float* w1 = arg_in(17); const float* b1 = arg_in(18); const float* w2 = arg_in(19); const float* b2 = arg_in(20); const float* fr = arg_in(23);
        bf16* a2s = WSP(bf16, WS_A2S); bf16* a2rs = WSP(bf16, WS_A2RS);
        const int lp = F.tid >> 6, j = F.tid & 63;
        for (int un = F.vcu; un < SEQ / 8; un += F.G) {
            const int l = un * 8 + lp;
            const float t = (float)l / (float)SEQ, w = 6.283185307179586f * (float)l / (float)SEQ;
            LAS float* zs = h1s + 512;
            __syncthreads();
            if (j < 32) { const int i = j & 15; const float band = 1e-4f + (float)i * ((15.0f - 1e-4f) / 15.0f); const float ang = w * band; zs[lp * 36 + 1 + j] = j < 16 ? cosf(ang) : -sinf(ang); }
            if (j == 32) zs[lp * 36] = t;
            __syncthreads();
            float pre = b1[j];
#pragma unroll
            for (int i = 0; i < 33; ++i) pre += zs[lp * 36 + i] * w1[i * 64 + j];
            const float f = fr[j];
            h1s[lp * 64 + j] = sinf(f * pre);
            __syncthreads();
            float p2 = b2[j];
#pragma unroll 8
            for (int i = 0; i < 64; ++i) p2 += h1s[lp * 64 + i] * w2[i * 64 + j];
            const float a = sinf(f * p2);
            const unsigned hi = pk2(a, 0.f) & 0xffffu; const unsigned lo = pk2(a - bf_lo(hi), 0.f) & 0xffffu;
            bf16* r0 = a2s + (size_t)l * 256; r0[j] = (bf16)hi; r0[64 + j] = (bf16)hi; r0[128 + j] = (bf16)lo; r0[192 + j] = 0;
            bf16* r1 = a2rs + (size_t)((SEQ - l) & (SEQ - 1)) * 256;
            if (l >= 1) { r1[j] = (bf16)hi; r1[64 + j] = (bf16)hi; r1[128 + j] = (bf16)lo; r1[192 + j] = 0; } else { r1[j] = 0; r1[64 + j] = 0; r1[128 + j] = 0; r1[192 + j] = 0; }
        }
        const float* w3 = arg_in(21); bf16* w3s = WSP(bf16, WS_W3S);
        for (int it = F.vcu * 512 + F.tid; it < 8192 * 8; it += F.G * 512) {
            const int j8 = it >> 13, r = it & 8191;
            const int dir = r >> 12, o = (r >> 11) & 1, d = r & 2047; const float* src = w3 + o * 4096 + dir * 2048 + d; bf16* dst = w3s + (size_t)r * 256;
            unsigned h[8], lw[8];
#pragma unroll
            for (int q = 0; q < 8; ++q) { const float v = src[(size_t)(j8 * 8 + q) * 8192]; h[q] = pk2(v, 0.f) & 0xffffu; lw[q] = pk2(v - bf_lo(h[q]), 0.f) & 0xffffu; }
            const v4u H = {h[0] | (h[1] << 16), h[2] | (h[3] << 16), h[4] | (h[5] << 16), h[6] | (h[7] << 16)}, Lw = {lw[0] | (lw[1] << 16), lw[2] | (lw[3] << 16), lw[4] | (lw[5] << 16), lw[6] | (lw[7] << 16)};
            *(v4u*)(dst + j8 * 8) = H; *(v4u*)(dst + 64 + j8 * 8) = Lw; *(v4u*)(dst + 128 + j8 * 8) = H; *(v4u*)(dst + 192 + j8 * 8) = (v4u){0u, 0u, 0u, 0u};
        }
    }
#endif
#ifndef NO_PD
    {
        f32x2* cs = WSP(f32x2, WS_CS);
        for (int i = F.vcu * 512 + F.tid; i < SEQ * 32; i += F.G * 512) { const int l = i >> 5, q = i & 31; const float pos = (float)((q < 16) ? (l >> 6) : (l & 63));
            const float inv = powf(10000.0f, -(float)(q & 15) / 16.0f); const float ang = pos * inv; cs[i] = (f32x2){cosf(ang), sinf(ang)}; }
        f32x2* tw = WSP(f32x2, WS_TW);
        for (int i = F.vcu * 512 + F.tid; i < 8192; i += F.G * 512) { float s, c; if (i < 4096) sincospif((float)i / 2048.0f, &s, &c); else sincospif((float)(i - 4096) / 4096.0f, &s, &c); tw[i] = (f32x2){c, -s}; }
    }
#endif
}

__device__ __forceinline__ void norm_store(const f32x4 (&v)[8], float rstd, const float* g, const float* shift, const float* scale, bf16* orow, int lane) {
#pragma unroll
    for (int j = 0; j < 8; ++j) { const int c = 4 * (64 * j + lane); const f32x4 g4 = *(const f32x4*)(g + c), sh = *(const f32x4*)(shift + c), sc = *(const f32x4*)(scale + c);
        const f32x4 y = v[j] * rstd * g4 * (1.0f + sc) + sh; v2u o; o.x = pk2(y[0], y[1]); o.y = pk2(y[2], y[3]); *(v2u*)(orow + c) = o; }
}
__device__ __forceinline__ void p1_norm0(Frame& F) {
    const int lane = opq(F.tid) & 63;
    const int gw = F.vcu * NWAVES + F.wave, NGW = F.G * NWAVES;
    const float* mod = WSP(float, WS_MOD); bf16* H = WSP(bf16, WS_H); const float* xin = arg_in(0); const float* cin = arg_in(2); const float* ng = arg_in(6);
    for (int row = gw; row < MT; row += NGW) {
        const int b = row >= LT ? 1 : 0, r = row - b * LT; const bool lat = r < SEQ;
        const float* xr = lat ? xin + ((size_t)b * SEQ + r) * DM : cin + ((size_t)b * CTXL + (r - SEQ)) * DM;
        const float* mr = mod + (size_t)(lat ? b : 2) * 6 * DM;
        f32x4 v[8]; float s = 0.f;
#pragma unroll
        for (int j = 0; j < 8; ++j) { v[j] = __builtin_nontemporal_load((const f32x4*)(xr + 4 * (64 * j + lane))); s += (v[j][0] * v[j][0] + v[j][1] * v[j][1]) + (v[j][2] * v[j][2] + v[j][3] * v[j][3]); }
        const float rstd = 1.0f / sqrtf(wave_sum(s) * (1.0f / DM) + EPS);
        norm_store(v, rstd, ng, mr, mr + DM, H + (size_t)row * DM, lane);
    }
}
__device__ __forceinline__ void p3_latent(Frame& F) {
    const int lane = opq(F.tid) & 63;
    const int gw = F.vcu * NWAVES + F.wave, NGW = F.G * NWAVES;
    const float* proj = WSP(float, WS_PROJ); bf16* cqn = WSP(bf16, WS_CQN); bf16* ckvn = WSP(bf16, WS_CKVN); bf16* kro = WSP(bf16, WS_KROPE); const f32x2* cs = WSP(f32x2, WS_CS);
    const float* gq = arg_in(9); const float* gkv = arg_in(10);
    for (int row = gw; row < MT; row += NGW) {
        const float* pr = proj + (size_t)row * INPAD; const int l = row % LT;
        const f32x4 q0 = *(const f32x4*)(pr + 4 * lane), q1 = *(const f32x4*)(pr + 256 + 4 * lane), kv = *(const f32x4*)(pr + 512 + 4 * lane);
        float sq = (q0[0] * q0[0] + q0[1] * q0[1]) + (q0[2] * q0[2] + q0[3] * q0[3]) + (q1[0] * q1[0] + q1[1] * q1[1]) + (q1[2] * q1[2] + q1[3] * q1[3]);
        float sk = (kv[0] * kv[0] + kv[1] * kv[1]) + (kv[2] * kv[2] + kv[3] * kv[3]);
        const float rq = 1.0f / sqrtf(wave_sum(sq) * (1.0f / QRANK) + EPS), rk = 1.0f / sqrtf(wave_sum(sk) * (1.0f / KVRANK) + EPS);
        { const f32x4 g0 = *(const f32x4*)(gq + 4 * lane), g1 = *(const f32x4*)(gq + 256 + 4 * lane), g2 = *(const f32x4*)(gkv + 4 * lane);
          const f32x4 y0 = q0 * rq * g0, y1 = q1 * rq * g1, y2 = kv * rk * g2;
          v2u o; o.x = pk2(y0[0], y0[1]); o.y = pk2(y0[2], y0[3]); *(v2u*)(cqn + (size_t)row * QRANK + 4 * lane) = o;
          o.x = pk2(y1[0], y1[1]); o.y = pk2(y1[2], y1[3]); *(v2u*)(cqn + (size_t)row * QRANK + 256 + 4 * lane) = o;
          o.x = pk2(y2[0], y2[1]); o.y = pk2(y2[2], y2[3]); *(v2u*)(ckvn + (size_t)row * KVRANK + 4 * lane) = o; }
        if (lane < 32) { const float x1 = pr[768 + lane], x2 = pr[800 + lane]; float o1 = x1, o2 = x2;
            if (l < SEQ) { const f32x2 c = cs[(size_t)l * 32 + lane]; o1 = x1 * c.x - x2 * c.y; o2 = x2 * c.x + x1 * c.y; }
            ((unsigned*)(kro + (size_t)row * 64))[lane] = pk2(o1, o2); }
    }
}
__device__ __forceinline__ void p8_norm_router(Frame& F, int layer) {
    const int lane = opq(F.tid) & 63;
    const int gw = F.vcu * NWAVES + F.wave, NGW = F.G * NWAVES;
    const float* X = WSP(float, WS_X1); bf16* H = WSP(bf16, WS_H); float* aff = WSP(float, WS_AFF);
    const float* mod = WSP(float, WS_MOD) + (size_t)layer * 3 * 6 * DM; const float* g = arg_in(6) + (size_t)(layer * 2 + 1) * DM;
    LAS float* wr = (LAS float*)F.lds;
    __syncthreads();
    { const float* W = arg_in(26) + (size_t)layer * DM * NE;
      for (int i = F.tid; i < DM * NE / 4; i += 512) { const int c = i >> 2, q = i & 3; *(LAS f32x4*)(wr + c * 16 + (c >> 2) * 4 + q * 4) = *(const f32x4*)(W + (size_t)i * 4); } }
    __syncthreads();
    for (int row = gw; row < MX; row += NGW) {
        const int b = row >> 12, t = row & 4095; const float* xr = X + (size_t)row * DM; const float* shift = mod + (size_t)b * 6 * DM + 3 * DM; const float* scale = shift + DM;
        f32x4 v[8]; float s = 0.f;
#pragma unroll
        for (int j = 0; j < 8; ++j) { v[j] = *(const f32x4*)(xr + 4 * (64 * j + lane)); s += (v[j][0] * v[j][0] + v[j][1] * v[j][1]) + (v[j][2] * v[j][2] + v[j][3] * v[j][3]); }
        const float rstd = 1.0f / sqrtf(wave_sum(s) * (1.0f / DM) + EPS);
        f32x4 lg[4] = {{0.f, 0.f, 0.f, 0.f}, {0.f, 0.f, 0.f, 0.f}, {0.f, 0.f, 0.f, 0.f}, {0.f, 0.f, 0.f, 0.f}};
#pragma unroll
        for (int j = 0; j < 8; ++j) { const int c = 4 * (64 * j + lane); const f32x4 g4 = *(const f32x4*)(g + c), sh = *(const f32x4*)(shift + c), sc = *(const f32x4*)(scale + c);
            const f32x4 y = v[j] * rstd * g4 * (1.0f + sc) + sh; v2u o; o.x = pk2(y[0], y[1]); o.y = pk2(y[2], y[3]); *(v2u*)(H + (size_t)row * DM + c) = o;
            const LAS float* wp = wr + c * 16 + (c >> 2) * 4;
#pragma unroll
            for (int q = 0; q < 4; ++q) {
#pragma unroll
                for (int e4 = 0; e4 < 4; ++e4) lg[e4] += y[q] * *(const LAS f32x4*)(wp + q * 16 + e4 * 4); } }
        float lv[16];
#pragma unroll
        for (int e = 0; e < 16; ++e) lv[e] = wave_sum(lg[e >> 2][e & 3]);
        float mx = lv[0];
#pragma unroll
        for (int e = 1; e < 16; ++e) mx = fmaxf(mx, lv[e]);
        float den = 0.f;
#pragma unroll
        for (int e = 0; e < 16; ++e) { lv[e] = __expf(lv[e] - mx); den += lv[e]; }
        float mine = 0.f;
#pragma unroll
        for (int e = 0; e < 16; ++e) mine = (lane == e) ? lv[e] : mine;
        if (lane < 16) aff[((size_t)b * NE + lane) * SEQ + t] = mine / den;
    }
    __syncthreads();
}
__device__ __forceinline__ void p9_select_gather(Frame& F) {
    const int lane = opq(F.tid) & 63;
    const float* aff = WSP(float, WS_AFF); int* tok = WSP(int, WS_TOK); const bf16* H = WSP(bf16, WS_H); bf16* XG = WSP(bf16, WS_XG);
    LAS int* red = (LAS int*)F.lds;
    LAS int* sel = (LAS int*)(F.lds + 256);
    for (int un = F.vcu; un < NB * NE * 8; un += F.G) {
        const int be = un >> 3, part = un & 7, b = be >> 4, e = be & 15;
        const float* ar = aff + (size_t)be * SEQ + 8 * F.tid;
        const f32x4 a0 = *(const f32x4*)ar, a1 = *(const f32x4*)(ar + 4);
        unsigned key[8] = {__float_as_uint(a0[0]), __float_as_uint(a0[1]), __float_as_uint(a0[2]), __float_as_uint(a0[3]), __float_as_uint(a1[0]), __float_as_uint(a1[1]), __float_as_uint(a1[2]), __float_as_uint(a1[3])};
        __syncthreads();
        unsigned prefix = 0u;
        for (int bit = 30; bit >= 0; --bit) {
            const unsigned cand = prefix | (1u << bit); int c = 0;
#pragma unroll
            for (int i = 0; i < 8; ++i) c += (key[i] >= cand) ? 1 : 0;
            c = wave_sum_i(c);
            LAS int* slot = red + (bit & 1) * 8;
            if (lane == 0) slot[F.wave] = c;
            __syncthreads();
            int tot = 0;
#pragma unroll
            for (int w = 0; w < 8; ++w) tot += slot[w];
            if (tot >= CAP) prefix = cand;
        }
        int cgt = 0, ceq = 0;
#pragma unroll
        for (int i = 0; i < 8; ++i) { cgt += (key[i] > prefix) ? 1 : 0; ceq += (key[i] == prefix) ? 1 : 0; }
        int pk = (ceq << 16) | cgt, inc = pk;
#pragma unroll
        for (int o = 1; o < 64; o <<= 1) { const int y = __shfl_up(inc, o); if (lane >= o) inc += y; }
        __syncthreads();
        if (lane == 63) red[16 + F.wave] = inc;
        __syncthreads();
        int wpre = 0, total = 0;
#pragma unroll
        for (int w = 0; w < 8; ++w) { const int x = red[16 + w]; if (w < F.wave) wpre += x; total += x; }
        const int exc = wpre + inc - pk;
        const int need = CAP - (total & 0xffff);
        int eqb = exc >> 16, gtb = exc & 0xffff;
        int slotv[8];
#pragma unroll
        for (int i = 0; i < 8; ++i) { const bool gt = key[i] > prefix, eq = key[i] == prefix; const bool s = gt || (eq && eqb < need);
            const int before = gtb + (eqb < need ? eqb : need);
            slotv[i] = s ? before : -1; gtb += gt ? 1 : 0; eqb += eq ? 1 : 0; }
#pragma unroll
        for (int i = 0; i < 8; ++i) if (slotv[i] >= 0) sel[slotv[i]] = 8 * F.tid + i;
        if (part == 0) { int* tr = tok + (size_t)be * SEQ + 8 * F.tid; *(int4*)tr = make_int4(slotv[0], slotv[1], slotv[2], slotv[3]); *(int4*)(tr + 4) = make_int4(slotv[4], slotv[5], slotv[6], slotv[7]); }
        __syncthreads();
        if (part == 0) WSP(int, WS_SELROW)[e * 1024 + b * CAP + F.tid] = b * SEQ + sel[F.tid];
        if (F.G != 256) { v4u rr[8][4];
#pragma unroll
        for (int i = 0; i < 8; ++i) { const int sl = part * 64 + F.wave * 8 + i; const int t = sel[sl];
            const v4u* src = (const v4u*)(H + ((size_t)b * SEQ + t) * DM) + lane;
#pragma unroll
            for (int q = 0; q < 4; ++q) rr[i][q] = src[64 * q]; }
#pragma unroll
        for (int i = 0; i < 8; ++i) { const int sl = part * 64 + F.wave * 8 + i; v4u* dst = (v4u*)(XG + ((size_t)e * 1024 + b * CAP + sl) * DM) + lane;
#pragma unroll
            for (int q = 0; q < 4; ++q) dst[64 * q] = rr[i][q]; } }
        __syncthreads();
    }
}
template <bool FINAL>
__device__ __forceinline__ void p12_combine_norm(Frame& F, int layer) {
    const int lane = opq(F.tid) & 63;
    const int gw = F.vcu * NWAVES + F.wave, NGW = F.G * NWAVES;
    float* X = WSP(float, WS_X1); bf16* H = WSP(bf16, WS_H); const float* aff = WSP(float, WS_AFF); const int* tok = WSP(int, WS_TOK); const bf16* Y = WSP(bf16, WS_Y);
    const float* modl = WSP(float, WS_MOD) + (size_t)layer * 3 * 6 * DM; const float* gfin = FINAL ? arg_in(7) : arg_in(6) + (size_t)((layer + 1) * 2) * DM;
    for (int row = gw; row < MX; row += NGW) {
        const int b = row >> 12, t = row & 4095; float* xr = X + (size_t)row * DM; const float* g5 = modl + (size_t)b * 6 * DM + 5 * DM;
        f32x4 v[8], acc[8];
#pragma unroll
        for (int j = 0; j < 8; ++j) { v[j] = *(const f32x4*)(xr + 4 * (64 * j + lane)); acc[j] = (f32x4){0.f, 0.f, 0.f, 0.f}; }
        int sv = -1; float av = 0.f;
        if (lane < 16) { sv = tok[((size_t)b * NE + lane) * SEQ + t]; av = aff[((size_t)b * NE + lane) * SEQ + t]; }
#pragma unroll
        for (int e = 0; e < 16; ++e) { const int s = __builtin_amdgcn_readlane(sv, e); const float a = __builtin_bit_cast(float, __builtin_amdgcn_readlane(__builtin_bit_cast(int, av), e));
            if (s >= 0) { const bf16* yr = Y + ((size_t)e * 1024 + b * CAP + s) * DM;
#pragma unroll
                for (int j = 0; j < 8; ++j) { const v2u w = *(const v2u*)(yr + 4 * (64 * j + lane)); acc[j] += a * (f32x4){bf_lo(w.x), bf_hi(w.x), bf_lo(w.y), bf_hi(w.y)}; } } }
        float s2 = 0.f;
#pragma unroll
        for (int j = 0; j < 8; ++j) { const f32x4 g4 = *(const f32x4*)(g5 + 4 * (64 * j + lane)); v[j] += g4 * acc[j]; s2 += (v[j][0] * v[j][0] + v[j][1] * v[j][1]) + (v[j][2] * v[j][2] + v[j][3] * v[j][3]); }
        const float rstd = 1.0f / sqrtf(wave_sum(s2) * (1.0f / DM) + EPS);
        if constexpr (FINAL) {
#pragma unroll
            for (int j = 0; j < 8; ++j) { const int c = 4 * (64 * j + lane); __builtin_nontemporal_store(v[j] * rstd * *(const f32x4*)(gfin + c), (f32x4*)(F.out + (size_t)row * DM + c)); }
        } else {
#pragma unroll
            for (int j = 0; j < 8; ++j) *(f32x4*)(xr + 4 * (64 * j + lane)) = v[j];
            const float* m1 = WSP(float, WS_MOD) + (size_t)(layer + 1) * 3 * 6 * DM + (size_t)b * 6 * DM;
            norm_store(v, rstd, gfin, m1, m1 + DM, H + (size_t)row * DM, lane);
        }
    }
}
__device__ __forceinline__ void p15_transpose(Frame& F) {
    const int lane = opq(F.tid) & 63;
    const int gw = F.vcu * NWAVES + F.wave, NGW = F.G * NWAVES;
    const bf16* ZT = WSP(bf16, WS_ZT); bf16* Z = WSP(bf16, WS_Z);
    LAS bf16* scr = (LAS bf16*)(F.lds + F.wave * 8704);
    for (int tl = gw; tl < (DM / 64) * (MX / 64); tl += NGW) {
        const int dt = tl & 31, tt = tl >> 5;
#pragma unroll
        for (int i = 0; i < 8; ++i) { const int d = 8 * i + (lane >> 3); const v4u w = *(const v4u*)(ZT + (size_t)(dt * 64 + d) * MX + tt * 64 + (lane & 7) * 8);
            LAS bf16* p = scr + d * 68 + (lane & 7) * 8; *(LAS v2u*)p = (v2u){w.x, w.y}; *(LAS v2u*)(p + 4) = (v2u){w.z, w.w}; }
        LDS_WAIT(); asm volatile("" ::: "memory");
#pragma unroll
        for (int i = 0; i < 8; ++i) { const int tk = 8 * i + (lane >> 3), d0 = (lane & 7) * 8; unsigned short h[8];
#pragma unroll
            for (int q = 0; q < 8; ++q) h[q] = scr[(d0 + q) * 68 + tk];
            v4u o; o.x = h[0] | ((unsigned)h[1] << 16); o.y = h[2] | ((unsigned)h[3] << 16); o.z = h[4] | ((unsigned)h[5] << 16); o.w = h[6] | ((unsigned)h[7] << 16);
            *(v4u*)(Z + (size_t)(tt * 64 + tk) * DM + dt * 64 + d0) = o; }
        LDS_WAIT(); asm volatile("" ::: "memory");
    }
}

namespace att {
constexpr int NW = 8, QBLK = 32, KVBLK = 64, KROW = 384  ;
constexpr float SCALE = 0.07216878364870322f;
constexpr float THR = 8.f;
#ifndef ATT_SDEPTH
#define ATT_SDEPTH 1
#endif
constexpr int SDEPTH = ATT_SDEPTH;
constexpr int SHM_V = KVBLK * 128 * 2, SHM_K = KVBLK * KROW, SHM_QR = 2 * SHM_V + 2 * SHM_K + NW * 64 * 4  , SHM_ATTN = SHM_QR + NW * 4096;
#define KSWZ(row, colB) ((row) * 384 + ((colB) ^ ((((row) ^ (((row) >> 3) & 3)) & 7) << 4)))
#define SBAR() __builtin_amdgcn_sched_barrier(0)
__device__ __forceinline__ int crow(int r, int hi) { return (r & 3) + 8 * (r >> 2) + 4 * hi; }
__device__ __forceinline__ void partialSM(f32x16& p0, f32x16& p1, float& m_reg, float& mn, float& alpha) {
  constexpr float C = SCALE * 1.4426950408889634f;
  float pmax = p0[0];
#pragma unroll
  for (int r = 1; r < 16; ++r) pmax = fmaxf(pmax, p0[r]);
#pragma unroll
  for (int r = 0; r < 16; ++r) pmax = fmaxf(pmax, p1[r]);
  { auto rr = __builtin_amdgcn_permlane32_swap(__float_as_uint(pmax), __float_as_uint(pmax), false, false);
    pmax = fmaxf(__uint_as_float(rr[0]), __uint_as_float(rr[1])); }
  if (__builtin_expect(__all(pmax - m_reg <= THR / SCALE), 1)) { mn = m_reg; alpha = 1.f; }
  else { mn = fmaxf(m_reg, pmax); alpha = __builtin_amdgcn_exp2f((m_reg - mn) * C); m_reg = mn; }
  const float mnC = -mn * C;
#pragma unroll
  for (int r = 0; r < 16; ++r) p0[r] = fmaf(p0[r], C, mnC);
#pragma unroll
  for (int r = 0; r < 16; ++r) p1[r] = fmaf(p1[r], C, mnC);
#pragma unroll
  for (int r = 0; r < 16; ++r) p0[r] = __builtin_amdgcn_exp2f(p0[r]);
}
__device__ __forceinline__ void finishSM(f32x16& p0, f32x16& p1, float alpha, float& l_reg, bf16x8& pa0, bf16x8& pa1, bf16x8& pa2, bf16x8& pa3) {
#pragma unroll
  for (int r = 0; r < 16; ++r) p1[r] = __builtin_amdgcn_exp2f(p1[r]);
  float ps = 0;
#pragma unroll
  for (int r = 0; r < 16; ++r) ps += p0[r];
#pragma unroll
  for (int r = 0; r < 16; ++r) ps += p1[r];
  { auto rr = __builtin_amdgcn_permlane32_swap(__float_as_uint(ps), __float_as_uint(ps), false, false);
    ps = __uint_as_float(rr[0]) + __uint_as_float(rr[1]); }
  l_reg = l_reg * alpha + ps;
#define PK4(P, BASE, OUT) do { unsigned a0 = pk2(P[BASE + 0], P[BASE + 1]), a1 = pk2(P[BASE + 2], P[BASE + 3]);   \
    unsigned b0 = pk2(P[BASE + 4], P[BASE + 5]), b1 = pk2(P[BASE + 6], P[BASE + 7]);                              \
    auto r0 = __builtin_amdgcn_permlane32_swap(a0, b0, false, false); auto r1 = __builtin_amdgcn_permlane32_swap(a1, b1, false, false); \
    v4u w = {r0[0], r1[0], r0[1], r1[1]}; OUT = *reinterpret_cast<bf16x8*>(&w); } while (0)
  PK4(p0, 0, pa0); PK4(p0, 8, pa1); PK4(p1, 0, pa2); PK4(p1, 8, pa3);
#undef PK4
}
__device__ __forceinline__ void qkt(f32x16& p0, f32x16& p1, const char* Ks, const bf16x8* qr, const char* qL, const int (&kb)[4]) {
  p0 = f32x16{}; p1 = f32x16{};
#pragma unroll
  for (int d0 = 0; d0 < 12; ++d0) {
    const bf16x8 qf = d0 < 8 ? qr[d0 < 8 ? d0 : 0] : *reinterpret_cast<const bf16x8*>(qL + (d0 - 8) * 1024);
    const bf16x8 b0 = *reinterpret_cast<const bf16x8*>(Ks + kb[d0 & 3] + (d0 >> 2) * 128);
    const bf16x8 b1 = *reinterpret_cast<const bf16x8*>(Ks + kb[d0 & 3] + (d0 >> 2) * 128 + 32 * 384);
    p0 = __builtin_amdgcn_mfma_f32_32x32x16_bf16(b0, qf, p0, 0, 0, 0);
    p1 = __builtin_amdgcn_mfma_f32_32x32x16_bf16(b1, qf, p1, 0, 0, 0); }
}
__device__ __forceinline__ int v_st(int k, int c) { const int kk = (k & ~0xC) | ((k & 4) << 1) | ((k & 8) >> 1); return ((kk >> 3) * 4 + (c >> 5)) * 512 + ((kk & 7) * 32 + (c & 31)) * 2; }
__device__ __forceinline__ int v_rd_base(int lane) { return ((lane & 3) << 3) | (((lane >> 2) & 3) << 6) | (((lane >> 4) & 1) << 5) | (((lane >> 5) & 1) << 8); }
constexpr int v_rd_off(int d0, int ks, int half) { return d0 * 512 + ks * 4096 + half * 2048; }
template <int OFF> __device__ __forceinline__ s16x4 tr_read(int vb) {
  s16x4 r; asm volatile("ds_read_b64_tr_b16 %0, %1 offset:%2" : "=&v"(r) : "v"(vb), "i"(OFF) : "memory"); return r;
}
template <int D0> __device__ __forceinline__ void pv_one(f32x16& od, int vb, bf16x8 pa0, bf16x8 pa1, bf16x8 pa2, bf16x8 pa3) {
  const s16x4 l0 = tr_read<v_rd_off(D0, 0, 0)>(vb), h0 = tr_read<v_rd_off(D0, 0, 1)>(vb), l1 = tr_read<v_rd_off(D0, 1, 0)>(vb), h1 = tr_read<v_rd_off(D0, 1, 1)>(vb);
  const s16x4 l2 = tr_read<v_rd_off(D0, 2, 0)>(vb), h2 = tr_read<v_rd_off(D0, 2, 1)>(vb), l3 = tr_read<v_rd_off(D0, 3, 0)>(vb), h3 = tr_read<v_rd_off(D0, 3, 1)>(vb);
  asm volatile("s_waitcnt lgkmcnt(0)" ::: "memory"); SBAR();
#define PKV(L, H) (bf16x8){L[0], L[1], L[2], L[3], H[0], H[1], H[2], H[3]}
  od = __builtin_amdgcn_mfma_f32_32x32x16_bf16(pa0, PKV(l0, h0), od, 0, 0, 0);
  od = __builtin_amdgcn_mfma_f32_32x32x16_bf16(pa1, PKV(l1, h1), od, 0, 0, 0);
  od = __builtin_amdgcn_mfma_f32_32x32x16_bf16(pa2, PKV(l2, h2), od, 0, 0, 0);
  od = __builtin_amdgcn_mfma_f32_32x32x16_bf16(pa3, PKV(l3, h3), od, 0, 0, 0);
#undef PKV
}
__device__ __forceinline__ void pv_d0(f32x16* o, int vb, bf16x8 pa0, bf16x8 pa1, bf16x8 pa2, bf16x8 pa3) {
  pv_one<0>(o[0], vb, pa0, pa1, pa2, pa3); pv_one<1>(o[1], vb, pa0, pa1, pa2, pa3); pv_one<2>(o[2], vb, pa0, pa1, pa2, pa3); pv_one<3>(o[3], vb, pa0, pa1, pa2, pa3);
}
__device__ __forceinline__ void attn_body(const bf16* __restrict__ Qb, const bf16* __restrict__ Kn, const bf16* __restrict__ Kr, const bf16* __restrict__ Vh, bf16* __restrict__ Ob, int seq, char* lds) {
  constexpr int LDQ = 3072, LDK = 4096, LDR = 64, LDO = 2048;
  const int tid = threadIdx.x, wid = tid >> 6, lane = tid & 63, r32 = lane & 31, hi = lane >> 5;
  char* V_lds = lds; char* K_lds = lds + 2 * SHM_V;
  float* ws = (float*)(lds + 2 * SHM_V + 2 * SHM_K) + wid * 64; float* li_l = ws; float* al_l = ws + 32;
  float m_reg = -1e30f, l_reg = 0; f32x16 o[4] = {}; bf16x8 qr[8];
  char* qL = lds + SHM_QR + wid * 4096 + lane * 16;
  const bf16* Qw = Qb + (unsigned)((wid * QBLK + r32) * LDQ + hi * 8);
#pragma unroll
  for (int d0 = 0; d0 < 8; ++d0) qr[d0] = *reinterpret_cast<const bf16x8*>(Qw + d0 * 16);
#pragma unroll
  for (int d0 = 8; d0 < 12; ++d0) *reinterpret_cast<bf16x8*>(qL + (d0 - 8) * 1024) = *reinterpret_cast<const bf16x8*>(Qw + d0 * 16);
  const int sr = tid >> 4, sc = (tid & 15) * 8, vst0 = v_st(sr, sc), vst1 = v_st(32 + sr, sc);
  const int rr = tid >> 3, rc = (tid & 7) * 8;
  const unsigned o_s0 = (unsigned)(sr * LDK + sc), o_s1 = (unsigned)((32 + sr) * LDK + sc), o_r = (unsigned)(rr * LDR + rc);
  int kb[4];
#pragma unroll
  for (int q = 0; q < 4; ++q) kb[q] = KSWZ(r32, q * 32 + hi * 16);
  const int vb0 = (int)(uintptr_t)V_lds + v_rd_base(lane);
  struct { bf16x8 vs0, vs1, ks0, ks1, kr0; } sr_[SDEPTH];
#define SLOAD(i, k0) do { const bf16* Vt = Vh + (size_t)(k0) * LDK; const bf16* Kt = Kn + (size_t)(k0) * LDK; const bf16* Rt = Kr + (size_t)(k0) * LDR; \
    sr_[i].vs0 = *(const bf16x8*)(Vt + o_s0); sr_[i].vs1 = *(const bf16x8*)(Vt + o_s1); sr_[i].ks0 = *(const bf16x8*)(Kt + o_s0); sr_[i].ks1 = *(const bf16x8*)(Kt + o_s1); \
    sr_[i].kr0 = *(const bf16x8*)(Rt + o_r); } while (0)
#define SWRITE(b, i) do { *(bf16x8*)(V_lds + (b) * SHM_V + vst0) = sr_[i].vs0; *(bf16x8*)(V_lds + (b) * SHM_V + vst1) = sr_[i].vs1; const int kc = sc * 2;               \
    *(bf16x8*)(K_lds + (b) * SHM_K + KSWZ(sr, kc)) = sr_[i].ks0; *(bf16x8*)(K_lds + (b) * SHM_K + KSWZ(32 + sr, kc)) = sr_[i].ks1;                       \
    *(bf16x8*)(K_lds + (b) * SHM_K + KSWZ(rr, 256 + rc * 2)) = sr_[i].kr0; } while (0)
#define SWAIT() do { if constexpr (SDEPTH == 2) asm volatile("s_waitcnt vmcnt(5)" ::: "memory"); else asm volatile("s_waitcnt vmcnt(0)" ::: "memory"); } while (0)
#define RESC(a) do { if (__any((a) < 1.f)) { if (hi == 0) al_l[r32] = (a); asm volatile("s_waitcnt lgkmcnt(0)" ::: "memory"); \
    _Pragma("unroll") for (int d = 0; d < 4; ++d) _Pragma("unroll") for (int r = 0; r < 16; ++r) o[d][r] *= al_l[crow(r, hi)]; } } while (0)
  f32x16 pA0, pA1, pB0, pB1; float mnA, mnB, alA, alB; bf16x8 pa0, pa1, pa2, pa3; const int NT = seq / KVBLK;
  constexpr int SE = 0, SO = SDEPTH - 1;
  SLOAD(SE, 0); asm volatile("s_waitcnt vmcnt(0)" ::: "memory"); SWRITE(0, SE); __syncthreads();
  qkt(pA0, pA1, K_lds, qr, qL, kb); partialSM(pA0, pA1, m_reg, mnA, alA);
  SLOAD(SO, KVBLK); if constexpr (SDEPTH == 2) { if (2 < NT) SLOAD(SE, 2 * KVBLK); }
  SWAIT(); SWRITE(1, SO); __syncthreads();
  for (int j = 1; j + 1 < NT; j += 2) {
    SBAR(); qkt(pB0, pB1, K_lds + SHM_K, qr, qL, kb);
    finishSM(pA0, pA1, alA, l_reg, pa0, pa1, pa2, pa3); SBAR();
    SLOAD(SO, (j + SDEPTH) * KVBLK); SBAR();
    pv_d0(o, vb0, pa0, pa1, pa2, pa3); partialSM(pB0, pB1, m_reg, mnB, alB);
    __syncthreads(); SWAIT(); SWRITE(0, SE);
    RESC(alB); __syncthreads();
    SBAR(); qkt(pA0, pA1, K_lds, qr, qL, kb);
    finishSM(pB0, pB1, alB, l_reg, pa0, pa1, pa2, pa3); SBAR();
    if (SDEPTH == 1 || j + 3 < NT) SLOAD(SE, (j + 1 + SDEPTH) * KVBLK); SBAR();
    pv_d0(o, vb0 + SHM_V, pa0, pa1, pa2, pa3); partialSM(pA0, pA1, m_reg, mnA, alA);
    __syncthreads(); SWAIT(); SWRITE(1, SO);
    RESC(alA); __syncthreads();
  }
  SBAR(); qkt(pB0, pB1, K_lds + SHM_K, qr, qL, kb);
  finishSM(pA0, pA1, alA, l_reg, pa0, pa1, pa2, pa3); SBAR();
  pv_d0(o, vb0, pa0, pa1, pa2, pa3); partialSM(pB0, pB1, m_reg, mnB, alB);
  __syncthreads(); RESC(alB);
  finishSM(pB0, pB1, alB, l_reg, pa0, pa1, pa2, pa3); SBAR();
  pv_d0(o, vb0 + SHM_V, pa0, pa1, pa2, pa3);
  if (hi == 0) li_l[r32] = l_reg; asm volatile("s_waitcnt lgkmcnt(0)" ::: "memory");
  float rli[16];
#pragma unroll
  for (int r = 0; r < 16; ++r) rli[r] = __builtin_amdgcn_rcpf(li_l[crow(r, hi)]);
  bf16* Ow = Ob + (size_t)(wid * QBLK) * LDO;
#pragma unroll
  for (int r = 0; r < 16; ++r) { const int orow = crow(r, hi);
#pragma unroll
    for (int d0 = 0; d0 < 4; ++d0) Ow[(unsigned)(orow * LDO + d0 * 32 + r32)] = (bf16)(pk2(o[d0][r] * rli[r], 0.f) & 0xffffu); }
#undef SLOAD
#undef SWRITE
#undef SWAIT
#undef RESC
}
}
__device__ __forceinline__ void p6_attention(Frame& F) {
    const bf16* Q = WSP(bf16, WS_Q); const bf16* KV = WSP(bf16, WS_KV); const bf16* KR = WSP(bf16, WS_KROPE); bf16* O = WSP(bf16, WS_O);
    const int cslot = (int)(((blockIdx.x >> 7) * 8u + (blockIdx.x & 7u)) % 3u);
    if (cslot == 0) convert_late(F);
    const int nun = NB * NH * (SEQ / 256);
    for (int i = 0; ; ++i) {
        int bh, qb;
        if (F.G == 256) { if (i >= 2) break; const int x = blockIdx.x & 7, j = blockIdx.x >> 3; bh = (i * 8 + x) * 2 + (j >> 4); qb = j & 15; }
        else { const int L = i * F.G + (int)blockIdx.x; if (L >= nun) break; bh = L >> 4; qb = L & 15; }
        const int b = bh >> 4, h = bh & 15;
        if (i == 1 && cslot == 1) convert_late(F);
        __syncthreads();
        att::attn_body(Q + ((size_t)b * LT + qb * 256) * QW + h * 192, KV + (size_t)b * LT * KVW + h * 256, KR + (size_t)b * LT * 64, KV + (size_t)b * LT * KVW + h * 256 + 128,
                       O + ((size_t)b * SEQ + qb * 256) * DM + h * 128, LT, (char*)F.ldsg);
    }
    __syncthreads();
    if (cslot == 2) convert_late(F);
}

namespace hy {
typedef float cpx __attribute__((ext_vector_type(2)));
__device__ __forceinline__ cpx cmul(cpx a, cpx b) { return (cpx){a.x * b.x - a.y * b.y, a.x * b.y + a.y * b.x}; }
__device__ __forceinline__ cpx cmulc(cpx a, cpx b) { return (cpx){a.x * b.x + a.y * b.y, a.y * b.x - a.x * b.y}; }
__device__ __forceinline__ float f_mul(float a, float b) { float r; asm("v_mul_f32 %0, %1, %2" : "=v"(r) : "v"(a), "v"(b)); return r; }
__device__ __forceinline__ float f_fma(float a, float b, float c) { float r; asm("v_fma_f32 %0, %1, %2, %3" : "=v"(r) : "v"(a), "v"(b), "v"(c)); return r; }
__device__ __forceinline__ float f_fms(float a, float b, float c) { float r; asm("v_fma_f32 %0, %1, %2, -%3" : "=v"(r) : "v"(a), "v"(b), "v"(c)); return r; }
__device__ __forceinline__ cpx cmul_s(cpx a, cpx b) { const float t = f_mul(a.y, b.y), u = f_mul(a.y, b.x); return (cpx){f_fms(a.x, b.x, t), f_fma(a.x, b.y, u)}; }
__device__ __forceinline__ cpx cmulc_s(cpx a, cpx b) { const float t = f_mul(a.y, b.y), u = f_mul(a.x, b.y); return (cpx){f_fma(a.x, b.x, t), f_fms(a.y, b.x, u)}; }
__device__ __forceinline__ cpx cadd(cpx a, cpx b) { return a + b; }
__device__ __forceinline__ cpx csub(cpx a, cpx b) { return a - b; }
template <int S> __device__ __forceinline__ cpx mul_i(cpx a) { return S < 0 ? (cpx){a.y, -a.x} : (cpx){-a.y, a.x}; }
template <int S> __device__ __forceinline__ void dft4(cpx& x0, cpx& x1, cpx& x2, cpx& x3) {
    const cpx t0 = cadd(x0, x2), t1 = csub(x0, x2), t2 = cadd(x1, x3), t3 = mul_i<S>(csub(x1, x3));
    x0 = cadd(t0, t2); x2 = csub(t0, t2); x1 = cadd(t1, t3); x3 = csub(t1, t3);
}
template <int S> __device__ __forceinline__ cpx tw16(cpx a, int m) {
    constexpr float C1 = 0.9238795325112867f, S1 = 0.3826834323650898f, R = 0.7071067811865476f;
    cpx w;
    switch (m) { case 0: return a; case 1: w = (cpx){C1, -S1}; break; case 2: w = (cpx){R, -R}; break; case 3: w = (cpx){S1, -C1}; break; case 4: w = (cpx){0.f, -1.f}; break; case 6: w = (cpx){-R, -R}; break; default: w = (cpx){-C1, S1}; break; }
    if (S > 0) w.y = -w.y;
    return cmul(a, w);
}
template <int S> __device__ __forceinline__ void dft16(cpx (&v)[16]) {
#pragma unroll
    for (int a = 0; a < 4; ++a) { dft4<S>(v[a], v[a + 4], v[a + 8], v[a + 12]);
#pragma unroll
        for (int d = 1; d < 4; ++d) v[a + 4 * d] = tw16<S>(v[a + 4 * d], a * d); }
#pragma unroll
    for (int d = 0; d < 4; ++d) dft4<S>(v[4 * d], v[4 * d + 1], v[4 * d + 2], v[4 * d + 3]);
}
__device__ __forceinline__ constexpr int SL(int k) { return 4 * (k & 3) + (k >> 2); }
template <int S> __device__ __forceinline__ void dft16p(cpx (&v)[16]) {
#pragma unroll
    for (int a = 0; a < 4; ++a) { dft4<S>(v[4 * a], v[4 * a + 1], v[4 * a + 2], v[4 * a + 3]);
#pragma unroll
        for (int d = 1; d < 4; ++d) v[4 * a + d] = tw16<S>(v[4 * a + d], a * d); }
#pragma unroll
    for (int d = 0; d < 4; ++d) dft4<S>(v[d], v[4 + d], v[8 + d], v[12 + d]);
}
__device__ __forceinline__ int PI(int i) { return i + (i >> 4); }
typedef LAS cpx* lbuf;
typedef const LAS cpx* ltab;
__device__ __forceinline__ cpx tw_lookup(ltab T, int m) { return cmul(T[64 + (m >> 6)], T[m & 63]); }
__device__ __forceinline__ void tw_powers(cpx b, cpx (&p)[16]) {
    p[0] = (cpx){1.f, 0.f}; p[1] = b; p[2] = cmul(b, b); p[3] = cmul(p[2], b); p[4] = cmul(p[2], p[2]); p[5] = cmul(p[4], b); p[6] = cmul(p[4], p[2]); p[7] = cmul(p[4], p[3]); p[8] = cmul(p[4], p[4]);
    p[9] = cmul(p[8], b); p[10] = cmul(p[8], p[2]); p[11] = cmul(p[8], p[3]); p[12] = cmul(p[8], p[4]); p[13] = cmul(p[8], p[5]); p[14] = cmul(p[8], p[6]); p[15] = cmul(p[8], p[7]);
}
struct Addr { int a1, a2, a3; };
__device__ __forceinline__ void fwd12(lbuf buf, Addr A, const cpx (&pw1)[16], cpx b2) {
    cpx v[16], pw2[16];
    { lbuf b = buf + A.a1;
#pragma unroll
      for (int n = 0; n < 16; ++n) v[n] = b[n * 272];
      dft16<-1>(v);
#pragma unroll
      for (int k = 0; k < 16; ++k) b[k * 272] = k ? cmul_s(v[SL(k)], pw1[k]) : v[SL(k)]; }
    __syncthreads();
    { lbuf b = buf + A.a2;
#pragma unroll
      for (int n = 0; n < 16; ++n) v[n] = b[n * 17];
      tw_powers(b2, pw2);
      dft16<-1>(v);
#pragma unroll
      for (int k = 0; k < 16; ++k) b[k * 17] = k ? cmul(v[SL(k)], pw2[k]) : v[SL(k)]; }
    __syncthreads();
}
__device__ __forceinline__ void inv21(lbuf buf, Addr A, const cpx (&pw1)[16], cpx b2) {
    cpx v[16], pw2[16];
    { lbuf b = buf + A.a2; tw_powers(b2, pw2);
#pragma unroll
      for (int k = 0; k < 16; ++k) { const cpx x = b[k * 17]; v[k] = k ? cmulc(x, pw2[k]) : x; }
      dft16<1>(v);
#pragma unroll
      for (int n = 0; n < 16; ++n) b[n * 17] = v[SL(n)]; }
    __syncthreads();
    { lbuf b = buf + A.a1;
#pragma unroll
      for (int k = 0; k < 16; ++k) { const cpx x = b[k * 272]; v[k] = k ? cmulc_s(x, pw1[k]) : x; }
      dft16<1>(v);
#pragma unroll
      for (int n = 0; n < 16; ++n) b[n * 272] = v[SL(n)]; }
    __syncthreads();
}
}

__device__ __forceinline__ void p14_hyena_conv(Frame& F) {
    const int lane = opq(F.tid) & 63;
    using namespace hy;
    lbuf bufX = (lbuf)F.lds; lbuf bufW = (lbuf)(F.lds + 69632);
    LAS float* red = (LAS float*)(F.lds + 139264);
    LAS cpx* tab = (LAS cpx*)(F.lds + 139264 + 64);
    const float* HF = WSP(float, WS_HF);
    const bf16* U = WSP(bf16, WS_U); bf16* ZT = WSP(bf16, WS_ZT);
    const float* b3 = arg_in(22); const float* cw = arg_in(15); const float* cb = arg_in(16); const float* skip = arg_in(24);
    __syncthreads();
    if (F.tid < 256) { const f32x2* twg = WSP(f32x2, WS_TW); const int q = F.tid >> 6, i = F.tid & 63; tab[F.tid] = twg[(q >> 1) * 4096 + ((q & 1) ? 64 * i : i)]; }
    __syncthreads();
    const int t0_ = F.tid, e = t0_ >> 8, j = t0_ & 255;
    cpx pw1[16];
    tw_powers(tw_lookup(tab, j), pw1); const cpx b2 = tw_lookup(tab, 16 * (j & 15));
    Addr A; A.a1 = j + (j >> 4); A.a2 = (j >> 4) * 272 + (j & 15); A.a3 = j * 17;
    const int k1 = j >> 4, k2 = j & 15; const bool special = (e == 0 && j == 0);
    const int ap = e ? (15 - k1) * 272 + (15 - k2) * 17 : (k1 ? (16 - k1) * 272 + (15 - k2) * 17 : (k2 ? (16 - k2) * 17 : 1));
    lbuf bx = bufX + e * 4352; lbuf bw = bufW + e * 4352;
#define HY_ISSUE(T, raw) do { const int ch = (T) * DM + d; \
        _Pragma("unroll") for (int b = 0; b < 2; ++b) { const bf16* pr = U + (size_t)ch * MX + b * SEQ + n0; raw.m[b] = *(const v4u*)pr; raw.l[b] = t > 0 ? pr[-1] : (bf16)0; raw.r[b] = t < 511 ? pr[8] : (bf16)0; } } while (0)
#define HY_CONV(T, raw, dst) do { const int ch = (T) * DM + d; const float w0 = cw[ch], w1 = cw[3 * DM + ch], w2 = cw[6 * DM + ch], bs = cb[ch]; \
        _Pragma("unroll") for (int b = 0; b < 2; ++b) { const v4u m = raw.m[b]; \
            const float p[10] = {bf1(raw.l[b]), bf_lo(m.x), bf_hi(m.x), bf_lo(m.y), bf_hi(m.y), bf_lo(m.z), bf_hi(m.z), bf_lo(m.w), bf_hi(m.w), bf1(raw.r[b])}; \
            _Pragma("unroll") for (int i = 0; i < 8; ++i) { const float uu = w0 * p[i] + w1 * p[i + 1] + w2 * p[i + 2] + bs; if (b == 0) dst[i].x = uu; else dst[i].y = uu; } } } while (0)
    struct Raw { v4u m[2]; bf16 l[2], r[2]; };
#define HY_TW8() cpx tw8[8]; { const cpx th = tab[192 + (t >> 3)]; _Pragma("unroll") for (int i = 0; i < 8; ++i) tw8[i] = cmul(th, tab[128 + 8 * (t & 7) + i]); }
#pragma unroll 1
    for (int d = F.vcu; d < DM; d += F.G) {
        const float sk0 = skip[d], sk1 = skip[DM + d];
        float rs0 = 0.f, rs1 = 0.f; cpx vv[8];
#pragma unroll 1
        for (int c = 0; c < 3; ++c) {
            int t = F.tid; asm volatile("" : "+v"(t));
            const int n0 = 8 * t, p0 = n0 + (t >> 1);
            lbuf bb = c ? bx : bw;
            if (c == 0) {
                __syncthreads();
                const float* h00 = HF + (size_t)d * SEQ + n0; const float* h10 = h00 + (size_t)2048 * SEQ; const float* h01 = h00 + (size_t)4096 * SEQ; const float* h11 = h01 + (size_t)2048 * SEQ;
                #define NTL(p) __builtin_nontemporal_load((const f32x4*)(p))
                const f32x4 a00 = NTL(h00), b00 = NTL(h00 + 4), a10 = NTL(h10), b10 = NTL(h10 + 4);
                const f32x4 a01 = NTL(h01), b01 = NTL(h01 + 4), a11 = NTL(h11), b11 = NTL(h11 + 4);
#undef NTL
                const float bb00 = b3[d], bb01 = b3[2048 + d], bb10 = b3[4096 + d], bb11 = b3[6144 + d];
                const float adel = 3.0701134573253944f + (float)d * ((15.350567286626972f - 3.0701134573253944f) / 2047.0f);
                float ss0 = 0.f, ss1 = 0.f; HY_TW8();
#pragma unroll
                for (int i = 0; i < 8; ++i) { const int n = n0 + i; const float df = __expf(-((float)n * (1.0f / 4096.0f)) * adel), db = __expf(-((float)(4096 - n) * (1.0f / 4096.0f)) * adel);
                    const float f00 = (i < 4 ? a00[i & 3] : b00[i & 3]) + bb00, f10 = (i < 4 ? a10[i & 3] : b10[i & 3]) + bb10, f01 = (i < 4 ? a01[i & 3] : b01[i & 3]) + bb01, f11 = (i < 4 ? a11[i & 3] : b11[i & 3]) + bb11;
                    const float a0 = f00 * df, a1 = f10 * df;
                    const float c0 = n ? f01 * db : 0.f, c1 = n ? f11 * db : 0.f;
                    ss0 += a0 * a0 + c0 * c0; ss1 += a1 * a1 + c1 * c1;
                    bufW[p0 + i] = (cpx){a0 + c0, a1 + c1};
                    bufW[4352 + p0 + i] = cmul((cpx){a0 - c0, a1 - c1}, tw8[i]); }
                ss0 = wave_sum(ss0); ss1 = wave_sum(ss1);
                if (lane == 0) { red[F.wave * 2] = ss0; red[F.wave * 2 + 1] = ss1; }
            } else if (c == 1) {
                Raw rv; HY_ISSUE(0, rv); HY_CONV(0, rv, vv); HY_TW8();
#pragma unroll
                for (int i = 0; i < 8; ++i) { bufX[p0 + i] = vv[i]; bufX[4352 + p0 + i] = cmul(vv[i], tw8[i]); }
            }
            __syncthreads();
            if (c == 0) {
#pragma unroll
                for (int w = 0; w < 8; ++w) { rs0 += red[w * 2]; rs1 += red[w * 2 + 1]; }
                rs0 = (1.0f / sqrtf(rs0 + EPS)) * (1.0f / 8192.0f); rs1 = (1.0f / sqrtf(rs1 + EPS)) * (1.0f / 8192.0f);
            }
            fwd12(bb, A, pw1, b2);
            cpx v[16];
            { lbuf q = bb + A.a3;
#pragma unroll
              for (int n = 0; n < 16; ++n) v[n] = q[n]; }
            dft16<-1>(v);
            if (c == 0) {
                lbuf q = bb + A.a3;
#pragma unroll
                for (int k = 0; k < 16; ++k) q[k] = v[SL(k)];
            } else {
                const float hs = 0.5f * (c == 1 ? rs0 : rs1); const bool o1 = c == 2;
                { lbuf bo = bw + A.a3; lbuf bp = bw + ap;
#pragma unroll
                  for (int k3 = 0; k3 < 16; ++k3) {
                    const cpx wf = bo[k3]; const cpx wp = (k3 == 0) ? bw[special ? ap - 1 : ap + 15] : bp[15 - k3];
                    const cpx K = o1 ? (cpx){(wf.y + wp.y) * hs, -(wf.x - wp.x) * hs} : (cpx){(wf.x + wp.x) * hs, (wf.y - wp.y) * hs};
                    v[SL(k3)] = cmul(v[SL(k3)], K); } }
                dft16p<1>(v);
                { lbuf q = bb + A.a3;
#pragma unroll
                  for (int n = 0; n < 16; ++n) q[n] = v[n]; }
                __syncthreads();
                inv21(bb, A, pw1, b2);
                if (c == 1) {
                    Raw r1; HY_ISSUE(1, r1); cpx x1c[8]; HY_CONV(1, r1, x1c); HY_TW8();
#pragma unroll
                    for (int i = 0; i < 8; ++i) { const cpx ye = bufX[p0 + i], yo = bufX[4352 + p0 + i]; const cpx y = cadd(ye, cmulc(yo, tw8[i]));
                        vv[i] = (cpx){x1c[i].x * (y.x + sk0 * vv[i].x), x1c[i].y * (y.y + sk0 * vv[i].y)};
                        bufX[p0 + i] = vv[i]; bufX[4352 + p0 + i] = cmul(vv[i], tw8[i]); }
                } else {
                    Raw r2; HY_ISSUE(2, r2); cpx x2c[8]; HY_CONV(2, r2, x2c); HY_TW8();
                    unsigned ob0[4], ob1[4];
#pragma unroll
                    for (int i = 0; i < 8; i += 2) { float z0[2], z1[2];
#pragma unroll
                        for (int q = 0; q < 2; ++q) { const cpx ye = bufX[p0 + i + q], yo = bufX[4352 + p0 + i + q]; const cpx y = cadd(ye, cmulc(yo, tw8[i + q]));
                            z0[q] = x2c[i + q].x * (y.x + sk1 * vv[i + q].x); z1[q] = x2c[i + q].y * (y.y + sk1 * vv[i + q].y); }
                        ob0[i >> 1] = pk2(z0[0], z0[1]); ob1[i >> 1] = pk2(z1[0], z1[1]); }
                    *(v4u*)(ZT + (size_t)d * MX + n0) = (v4u){ob0[0], ob0[1], ob0[2], ob0[3]};
                    *(v4u*)(ZT + (size_t)d * MX + SEQ + n0) = (v4u){ob1[0], ob1[1], ob1[2], ob1[3]};
                }
            }
        }
    }
    __syncthreads();
#undef HY_ISSUE
#undef HY_CONV
#undef HY_TW8
}

#ifndef MK_SINGLE
#define MK_SINGLE 1
#endif
struct Args { const float* in[30]; float* out; unsigned char* ws; int ph_lo, ph_hi; };
__global__ void __launch_bounds__(NWAVES * 64, 2) mk_fwd(Args args) {
    extern __shared__ __attribute__((aligned(16))) unsigned char lds[];
    Frame F;
    F.lds = (LAS unsigned char*)lds; F.ldsg = lds;
    F.tid = threadIdx.x; F.wave = __builtin_amdgcn_readfirstlane(F.tid >> 6);
    F.G = gridDim.x; { const int bx = blockIdx.x; F.vcu = (F.G % 8 == 0) ? (bx % 8) * (F.G / 8) + bx / 8 : bx; }
    F.out = args.out; F.ws = args.ws;
    volatile LAS unsigned* MISC = (volatile LAS unsigned*)(F.lds + MISC_OFF);
    if (F.tid < 32) MISC[F.tid] = 0u;
    __syncthreads();
    unsigned* ctl = (unsigned*)(F.ws + WS_CTL);
    XcdBarrier bar; bar.bar = ctl + CW_BAR; bar.x = 0; bar.st = nullptr;
    if (MK_SINGLE) bar = xcd_barrier_post(ctl + CW_BAR, MISC + 8);
    const int lo = args.ph_lo, hi = args.ph_hi;
#ifndef PH_MASK
#define PH_MASK 0x1fffff
#endif
#ifndef PROBE_DUP
#define PROBE_DUP 0
#endif
#define IN(k) (((PH_MASK >> (k)) & 1) && lo <= (k) && (k) < hi)
#define REP(k) for (int rep_ = 0; rep_ < (((PROBE_DUP >> (k)) & 1) ? 2 : 1); ++rep_)
#ifndef PROBE_XBAR
#define PROBE_XBAR 0
#endif
#define SEAM(k) do { if (MK_SINGLE && IN(k) && IN((k) + 1)) { xcd_barrier(bar); if (PROBE_XBAR) xcd_barrier(bar); } } while (0)
    using namespace pg8;
    const bf16_t* Hb = WSP(bf16_t, WS_H);
    float* mod = WSP(float, WS_MOD);

    if (IN(0)) REP(0) { p0_prologue(F); } SEAM(0);
    if (IN(1)) REP(1) { p1_norm0(F); } SEAM(1);
    if (IN(2)) REP(2) {
        Gemm g{Hb, WSP(bf16_t, WS_WIN), MT, INPAD, DM}; StaticOrder S; S.init(MT, INPAD, F.G, (int)blockIdx.x);
        EpiF32Plain E{WSP(float, WS_PROJ), INPAD, 0x7fffffff, false};
        gemm_phase<EpiF32Plain, StaticOrder, true, true>(F.lds, g, S, E);
        {
            __syncthreads();
            Gemm g2{WSP(bf16_t, WS_W3S), WSP(bf16_t, WS_A2S), 8192, 4096, 256}; HfOrder S2{F.G, (int)blockIdx.x, 136};
            EpiF32Plain E2{WSP(float, WS_HF), 4096, 15, true};
            gemm_phase<EpiF32Plain, HfOrder, true, true>(F.lds, g2, S2, E2);
        }
    } SEAM(2);
    if (IN(3)) REP(3) { p3_latent(F); } SEAM(3);
    if (IN(4)) REP(4) {
        { Gemm g{WSP(bf16_t, WS_CQN), WSP(bf16_t, WS_WUQ), MT, QW, QRANK}; StaticOrder S; S.init(MT, QW, F.G, (int)blockIdx.x);
          EpiQRope E{WSP(bf16_t, WS_Q), WSP(float, WS_CS)};
          gemm_phase<EpiQRope, StaticOrder, true, true>(F.lds, g, S, E); }
        __syncthreads();
        { Gemm g{WSP(bf16_t, WS_CKVN), WSP(bf16_t, WS_WUKV), MT, KVW, KVRANK}; StaticOrder S; S.init(MT, KVW, F.G, (int)(F.G - 1 - blockIdx.x));
          EpiBf16Plain E{WSP(bf16_t, WS_KV), KVW, 0x7fffffff};
          gemm_phase<EpiBf16Plain, StaticOrder, true, true>(F.lds, g, S, E); }
    } SEAM(4);
    if (IN(5)) REP(5) { p6_attention(F); } SEAM(5);
    if (IN(6)) REP(6) {
        Gemm g{WSP(bf16_t, WS_O), WSP(bf16_t, WS_WO), MX, DM, DM}; StaticOrder S; S.init(MX, DM, F.G, (int)blockIdx.x);
        EpiResid E{arg_in(0), WSP(float, WS_X1), mod + 2 * DM, 6 * DM, true};
        gemm_phase<EpiResid, StaticOrder, true, true>(F.lds, g, S, E);
    } SEAM(6);
#define MOE_PHASES(layer, pb) \
    if (IN(pb)) REP(pb) { p8_norm_router(F, layer); } SEAM(pb); \
    if (IN((pb) + 1)) REP((pb) + 1) { p9_select_gather(F); } SEAM((pb) + 1); \
    if (IN((pb) + 2)) REP((pb) + 2) {     \
        MoeOrder S{F.G, (int)blockIdx.x}; EpiSwiGLU E{WSP(bf16_t, WS_ACT)}; \
        if (F.G == 256) { Gemm g{Hb, WSP(bf16_t, WS_WGU) + (size_t)(layer) * NE * 2048 * DM, MROWS, 2048, DM, WSP(int, WS_SELROW)}; gemm_phase<EpiSwiGLU, MoeOrder, true, true, true>(F.lds, g, S, E); }     \
        else { Gemm g{WSP(bf16_t, WS_XG), WSP(bf16_t, WS_WGU) + (size_t)(layer) * NE * 2048 * DM, MROWS, 2048, DM}; gemm_phase<EpiSwiGLU, MoeOrder, true, true>(F.lds, g, S, E); } \
    } SEAM((pb) + 2); \
    if (IN((pb) + 3)) REP((pb) + 3) {     \
        Gemm g{WSP(bf16_t, WS_ACT), WSP(bf16_t, WS_WD) + (size_t)(layer) * NE * 2048 * FFD, MROWS, 2048, FFD}; MoeOrder S{F.G, (int)blockIdx.x}; \
        EpiBf16Plain E{WSP(bf16_t, WS_Y), DM, 7}; \
        gemm_phase<EpiBf16Plain, MoeOrder, true, true>(F.lds, g, S, E); \
    } SEAM((pb) + 3);
    MOE_PHASES(0, 7)
    if (IN(11)) REP(11) { p12_combine_norm<false>(F, 0); } SEAM(11);
    if (IN(12)) REP(12) {
        Gemm g{WSP(bf16_t, WS_HYWIN), Hb, 3 * DM, MX, DM}; StaticOrder S; S.init(3 * DM, MX, F.G, (int)blockIdx.x);
        EpiBf16Plain E{WSP(bf16_t, WS_U), MX, 0x7fffffff};
        gemm_phase<EpiBf16Plain, StaticOrder, true, true>(F.lds, g, S, E);
    } SEAM(12);
    if (IN(13)) REP(13) { p14_hyena_conv(F); } SEAM(13);
    if (IN(14)) REP(14) { p15_transpose(F); } SEAM(14);
    if (IN(15)) REP(15) {
        Gemm g{WSP(bf16_t, WS_Z), WSP(bf16_t, WS_HYWOUT), MX, DM, DM}; StaticOrder S; S.init(MX, DM, F.G, (int)blockIdx.x);
        EpiResid E{WSP(float, WS_X1), WSP(float, WS_X1), mod + 3 * 6 * DM + 2 * DM, 6 * DM, true};
        gemm_phase<EpiResid, StaticOrder, true, true>(F.lds, g, S, E);
    } SEAM(15);
    MOE_PHASES(1, 16)
    if (IN(20)) REP(20) { p12_combine_norm<true>(F, 1); }
#undef MOE_PHASES
#undef IN
#undef SEAM
}

extern "C" void kernel_launch(void* const* d_in, const int* in_sizes, int n_in, void* d_out, int out_size, void* d_ws, size_t ws_size, hipStream_t stream) {
    static int grid = 0;
    if (grid == 0) {
        if (n_in != 30 || out_size != MX * DM || ws_size < WS_END) { fprintf(stderr, "kernel_launch: shape/workspace mismatch: n_in %d out %d ws %zu (need %zu)\n", n_in, out_size, ws_size, (size_t)WS_END); grid = -1; return; }
        int dev = 0, cus = 0, per_cu = 0;
        if (hipGetDevice(&dev) != hipSuccess || hipDeviceGetAttribute(&cus, hipDeviceAttributeMultiprocessorCount, dev) != hipSuccess) { grid = -1; return; }
        if (hipFuncSetAttribute((const void*)mk_fwd, hipFuncAttributeMaxDynamicSharedMemorySize, LDS_BYTES) != hipSuccess) { fprintf(stderr, "kernel_launch: hipFuncSetAttribute failed\n"); grid = -1; return; }
        if (hipOccupancyMaxActiveBlocksPerMultiprocessor(&per_cu, (const void*)mk_fwd, NWAVES * 64, LDS_BYTES) != hipSuccess || per_cu < 1) { fprintf(stderr, "kernel_launch: occupancy query says %d blocks per CU\n", per_cu); }
        (void)hipGetLastError();
        grid = cus;
    }
    if (grid < 0) return;
    if (hipMemsetAsync((char*)d_ws + WS_CTL, 0, CTL_ZERO_BYTES, stream) != hipSuccess) return;
    Args a{};
    for (int i = 0; i < 30; ++i) a.in[i] = (const float*)d_in[i];
    a.out = (float*)d_out; a.ws = (unsigned char*)d_ws;
#if MK_SINGLE
    a.ph_lo = 0; a.ph_hi = NPHASE;
    hipLaunchKernelGGL(mk_fwd, dim3(grid), dim3(NWAVES * 64), LDS_BYTES, stream, a);
#else
    for (int p = 0; p < NPHASE; ++p) { a.ph_lo = p; a.ph_hi = p + 1; hipLaunchKernelGGL(mk_fwd, dim3(grid), dim3(NWAVES * 64), LDS_BYTES, stream, a); }
#endif
    const hipError_t le = hipPeekAtLastError();
    if (le != hipSuccess) fprintf(stderr, "kernel_launch: launch failed: %s\n", hipGetErrorName(le));
}
```
